# Optimizing an MI355X kernel written in HIP

```python
import math
import jax, jax.numpy as jnp
from jax import lax
import numpy as np

D_MODEL = 2048
BATCH = 8
SEQ = 4096
DEPTH = 4

GRID_W = 64
CTX_LEN = 256
EPS = 1e-6
ROPE_BASE = 10000.0
NEG_BIG = -1e30

N_BRANCH = 3
BRANCH_W = D_MODEL // 2

A_HEADS = 8
A_DK = 128
A_DV = BRANCH_W // A_HEADS
A_KW = A_HEADS * A_DK
A_CHUNK = 64

B_HEADS = 8
B_DH = BRANCH_W // (2 * B_HEADS)
B_QBLOCK = 128

C_Q_HEADS = 8
C_KV_HEADS = 2
C_GROUP = C_Q_HEADS // C_KV_HEADS
C_DH = BRANCH_W // C_Q_HEADS
C_WINDOW = 128
C_BLOCK = 128

D_FF = 5632

IN_SIZES = (A_KW, A_KW, A_KW, BRANCH_W, BRANCH_W,
            2 * B_HEADS * B_DH, 2 * B_HEADS * B_DH, 2 * B_HEADS * B_DH,
            C_Q_HEADS * C_DH, C_KV_HEADS * C_DH, C_KV_HEADS * C_DH,
            N_BRANCH * D_MODEL)
N_IN = sum(IN_SIZES)

kernel_name = 'hybrid_gated_merge_dit_block'


def rms_norm(x, g):
    xf = x.astype(jnp.float32)
    xf = xf * lax.rsqrt(jnp.mean(jnp.square(xf), axis=-1, keepdims=True) + EPS)
    return (xf * g.astype(jnp.float32)).astype(x.dtype)


def modulate(h, shift, scale):
    return h * (1 + scale) + shift


def axial_angles(n_tok, head_dim):
    rows = n_tok // GRID_W
    pos = jnp.arange(rows * GRID_W, dtype=jnp.int32)
    row = (pos // GRID_W).astype(jnp.float32)
    col = (pos % GRID_W).astype(jnp.float32)
    quarter = head_dim // 4
    inv = jnp.power(ROPE_BASE, -jnp.arange(quarter, dtype=jnp.float32) / quarter)
    return row[:, None] * inv, col[:, None] * inv


def rope_1d(x, ang):
    x1, x2 = jnp.split(x, 2, axis=-1)
    cos, sin = jnp.cos(ang).astype(x.dtype), jnp.sin(ang).astype(x.dtype)
    return jnp.concatenate([x1 * cos - x2 * sin, x2 * cos + x1 * sin], axis=-1)


def axial_rope(x, angles):
    row_ang, col_ang = angles
    shape = (x.shape[1],) + (1,) * (x.ndim - 3) + (x.shape[-1] // 4,)
    xr, xc = jnp.split(x, 2, axis=-1)
    return jnp.concatenate([rope_1d(xr, row_ang.reshape(shape)), rope_1d(xc, col_ang.reshape(shape))], axis=-1)


def sink_softmax(logits, sink):
    full = jnp.concatenate([logits, jnp.broadcast_to(sink, logits.shape[:-1] + (1,))], axis=-1)
    return jax.nn.softmax(full, axis=-1)[..., :-1]


def hgrn_lower_bounds(logits):
    p = jax.nn.softmax(logits.astype(jnp.float32), axis=1)
    return jnp.cumsum(p, axis=1) - p[:, :1]


def hgrn2_chunk_scan(q, k, v, log_f, s0):
    bsz, n_tok = q.shape[:2]
    n_chunk = n_tok // A_CHUNK

    def chunks(t):
        return jnp.moveaxis(t.reshape(bsz, n_chunk, A_CHUNK, A_HEADS, t.shape[-1]), 1, 0)

    incl = jnp.tril(jnp.ones((A_CHUNK, A_CHUNK), dtype=bool))[None, :, :, None, None]

    def step(state, inp):
        qc, kc, vc, gc = inp
        b = jnp.cumsum(gc, axis=1)
        rel = jnp.where(incl, b[:, :, None] - b[:, None, :], 0.0)
        decay = jnp.where(incl, jnp.exp(rel), 0.0)
        scores = jnp.einsum('bthd,bshd,btshd->bhts', qc, kc, decay)
        o = (jnp.einsum('bhts,bshe->bthe', scores, vc)
             + jnp.einsum('bthd,bhde->bthe', qc * jnp.exp(b), state))
        b_end = b[:, -1]
        state = (jnp.exp(b_end)[..., None] * state
                 + jnp.einsum('bshd,bshe->bhde', kc * jnp.exp(b_end[:, None] - b), vc))
        return state, o

    s_fin, o = lax.scan(step, s0, (chunks(q), chunks(k), chunks(v), chunks(log_f)))
    return jnp.moveaxis(o, 0, 1).reshape(bsz, n_tok, A_HEADS, A_DV), s_fin


def hgrn2_branch(lat_parts, ctx_parts, lb_fwd, lb_bwd, norm_g, need_ctx):
    flip = lambda t: jnp.flip(t, axis=1)

    def forget(z, lb):
        zf = z.astype(jnp.float32).reshape(z.shape[0], z.shape[1], A_HEADS, A_DK)
        lbh = lb.reshape(A_HEADS, A_DK)
        f = lbh + (1 - lbh) * jax.nn.sigmoid(zf)
        k = (1 - lbh) * jax.nn.sigmoid(-zf)
        return k, jnp.log(f)

    def bidir(parts, s_fwd0, s_bwd0):
        q, f_fwd, f_bwd, i, _ = parts
        bsz, n_tok = q.shape[:2]
        qh = jax.nn.silu(q.astype(jnp.float32)).reshape(bsz, n_tok, A_HEADS, A_DK)
        vh = i.astype(jnp.float32).reshape(bsz, n_tok, A_HEADS, A_DV)
        k_f, g_f = forget(f_fwd, lb_fwd)
        k_b, g_b = forget(f_bwd, lb_bwd)
        o_f, s_f = hgrn2_chunk_scan(qh, k_f, vh, g_f, s_fwd0)
        o_b, s_b = hgrn2_chunk_scan(flip(qh), flip(k_b), flip(vh), flip(g_b), s_bwd0)
        return o_f + flip(o_b), s_f, s_b

    def finish(o, g):
        bsz, n_tok = o.shape[:2]
        o = rms_norm(o, norm_g).reshape(bsz, n_tok, BRANCH_W)
        return (o * jax.nn.silu(g.astype(jnp.float32))).astype(g.dtype)

    bsz = lat_parts[0].shape[0]
    zero = jnp.zeros((bsz, A_HEADS, A_DK, A_DV), jnp.float32)
    o_ctx, s_f, s_b = bidir(ctx_parts, zero, zero)
    o_lat, _, _ = bidir(lat_parts, s_f, s_b)
    out_ctx = finish(o_ctx, ctx_parts[4]) if need_ctx else None
    return finish(o_lat, lat_parts[4]), out_ctx


def diff_attention(q, k, v, lam):
    s = jnp.einsum('bqhcd,bkhcd->bhcqk', q, k).astype(jnp.float32) * (B_DH ** -0.5)
    p = jax.nn.softmax(s, axis=-1)
    w = (p[:, :, 0] - lam * p[:, :, 1]).astype(v.dtype)
    return jnp.einsum('bhqk,bkhe->bqhe', w, v)


def diff_attn_branch(lat_parts, ctx_parts, lam_vecs, subln_g, lambda_init, rope, need_ctx):
    def heads(q, k, v):
        bsz, n_tok = q.shape[:2]
        return (q.reshape(bsz, n_tok, B_HEADS, 2, B_DH),
                k.reshape(bsz, n_tok, B_HEADS, 2, B_DH),
                v.reshape(bsz, n_tok, B_HEADS, 2 * B_DH))

    ql, kl, vl = heads(*lat_parts)
    qc, kc, vc = heads(*ctx_parts)
    ql, kl = axial_rope(ql, rope), axial_rope(kl, rope)
    lv = lam_vecs.astype(jnp.float32)
    lam = jnp.exp(jnp.sum(lv[0] * lv[1])) - jnp.exp(jnp.sum(lv[2] * lv[3])) + lambda_init

    def finish(o):
        bsz, n_tok = o.shape[:2]
        return (rms_norm(o, subln_g) * (1 - lambda_init)).reshape(bsz, n_tok, BRANCH_W)

    k_all = jnp.concatenate([kc, kl], axis=1)
    v_all = jnp.concatenate([vc, vl], axis=1)
    bsz, n_tok = ql.shape[:2]
    n_blk = n_tok // B_QBLOCK
    qb = jnp.moveaxis(ql.reshape(bsz, n_blk, B_QBLOCK, B_HEADS, 2, B_DH), 1, 0)
    ob = lax.map(lambda q_blk: diff_attention(q_blk, k_all, v_all, lam), qb)
    o_lat = jnp.moveaxis(ob, 0, 1).reshape(bsz, n_tok, B_HEADS, 2 * B_DH)
    out_ctx = finish(diff_attention(qc, kc, vc, lam)) if need_ctx else None
    return finish(o_lat), out_ctx


def window_attn_branch(lat_parts, ctx_parts, sink, rope, need_ctx):
    def heads(q, k, v):
        bsz, n_tok = q.shape[:2]
        return (q.reshape(bsz, n_tok, C_KV_HEADS, C_GROUP, C_DH),
                k.reshape(bsz, n_tok, C_KV_HEADS, C_DH),
                v.reshape(bsz, n_tok, C_KV_HEADS, C_DH))

    ql, kl, vl = heads(*lat_parts)
    qc, kc, vc = heads(*ctx_parts)
    ql, kl = axial_rope(ql, rope), axial_rope(kl, rope)
    sink_gr = sink.astype(jnp.float32).reshape(C_KV_HEADS, C_GROUP)
    scale = C_DH ** -0.5
    bsz, n_tok = ql.shape[:2]
    n_ctx = kc.shape[1]
    n_blk = n_tok // C_BLOCK
    qb = ql.reshape(bsz, n_blk, C_BLOCK, C_KV_HEADS, C_GROUP, C_DH)

    def band(t):
        tb = jnp.pad(t.reshape(bsz, n_blk, C_BLOCK, C_KV_HEADS, C_DH), ((0, 0), (1, 1), (0, 0), (0, 0), (0, 0)))
        return jnp.concatenate([tb[:, :-2], tb[:, 1:-1], tb[:, 2:]], axis=2)

    kb, vb = band(kl), band(vl)
    qi = jnp.arange(C_BLOCK)[:, None]
    kj = jnp.arange(3 * C_BLOCK)[None, :]
    in_window = jnp.abs(kj - C_BLOCK - qi) <= C_WINDOW
    k_pos = (jnp.arange(n_blk)[:, None] - 1) * C_BLOCK + kj
    in_range = (k_pos >= 0) & (k_pos < n_tok)
    mask = in_window[None] & in_range[:, None, :]
    s_loc = jnp.einsum('bnqgrd,bnkgd->bngrqk', qb, kb).astype(jnp.float32) * scale
    s_loc = jnp.where(mask[None, :, None, None], s_loc, NEG_BIG)
    s_ctx = jnp.einsum('bnqgrd,blgd->bngrql', qb, kc).astype(jnp.float32) * scale
    p = sink_softmax(jnp.concatenate([s_ctx, s_loc], axis=-1),
                     sink_gr[None, None, :, :, None, None]).astype(vl.dtype)
    o = (jnp.einsum('bngrql,blgd->bnqgrd', p[..., :n_ctx], vc)
         + jnp.einsum('bngrqk,bnkgd->bnqgrd', p[..., n_ctx:], vb))
    out_lat = o.reshape(bsz, n_tok, BRANCH_W)
    out_ctx = None
    if need_ctx:
        s = jnp.einsum('blgrd,bmgd->bgrlm', qc, kc).astype(jnp.float32) * scale
        pc = sink_softmax(s, sink_gr[None, :, :, None, None]).astype(vc.dtype)
        out_ctx = jnp.einsum('bgrlm,bmgd->blgrd', pc, vc).reshape(bsz, n_ctx, BRANCH_W)
    return out_lat, out_ctx


def merge_branches(o_a, o_b, o_c, z_gate, w_branch_l, w_out_l):
    bsz, n_tok = o_a.shape[:2]
    br = jnp.stack([o_a, o_b, o_c], axis=2)
    proj = jnp.einsum('btnw,nwd->btnd', br, w_branch_l)
    gates = jax.nn.sigmoid(z_gate.reshape(bsz, n_tok, N_BRANCH, D_MODEL))
    return jnp.einsum('btnd,btnd->btd', gates, proj) @ w_out_l


def mixing_sublayer(h_lat, h_ctx, w_in_l, lb_fwd, lb_bwd, a_norm_g_l, b_lam_l, b_subln_g_l,
                    lambda_init, c_sink_l, w_branch_l, w_out_l, rope_b, rope_c, need_ctx):
    cuts = np.cumsum(IN_SIZES)[:-1].tolist()
    zl = jnp.split(h_lat @ w_in_l, cuts, axis=-1)
    zc = jnp.split(h_ctx @ w_in_l, cuts, axis=-1)
    a_lat, a_ctx = hgrn2_branch(zl[0:5], zc[0:5], lb_fwd, lb_bwd, a_norm_g_l, need_ctx)
    b_lat, b_ctx = diff_attn_branch(zl[5:8], zc[5:8], b_lam_l, b_subln_g_l, lambda_init, rope_b, need_ctx)
    c_lat, c_ctx = window_attn_branch(zl[8:11], zc[8:11], c_sink_l, rope_c, need_ctx)
    out_lat = merge_branches(a_lat, b_lat, c_lat, zl[11], w_branch_l, w_out_l)
    out_ctx = merge_branches(a_ctx, b_ctx, c_ctx, zc[11], w_branch_l, w_out_l) if need_ctx else None
    return out_lat, out_ctx


def dwconv3(u, w, b):
    up = jnp.pad(u, ((0, 0), (1, 1), (0, 0)))
    return up[:, :-2] * w[0] + up[:, 1:-1] * w[1] + up[:, 2:] * w[2] + b


def conv_ffn(h, w_up_l, conv_w_l, conv_b_l, w_down_l):
    u = dwconv3(h @ w_up_l, conv_w_l, conv_b_l)
    a, v = jnp.split(u, 2, axis=-1)
    return (jax.nn.silu(a) * v) @ w_down_l


def setup_inputs(seed: int = 0) -> dict:
    key = jax.random.key(seed)
    ks = jax.random.split(key, 22)

    def nrm(k, shape, scale):
        return jax.random.normal(k, shape, jnp.float32) * scale

    def gain(k, shape):
        return 1.0 + nrm(k, shape, 0.05)

    return {
        'x': nrm(ks[0], (BATCH, SEQ, D_MODEL), 1.0),
        'c': nrm(ks[1], (BATCH, D_MODEL), 1.0),
        'ctx': nrm(ks[2], (BATCH, CTX_LEN, D_MODEL), 1.0),
        'c_ctx': nrm(ks[3], (D_MODEL,), 1.0),
        'w_ada': nrm(ks[4], (DEPTH, D_MODEL, 6 * D_MODEL), 0.5 * D_MODEL ** -0.5),
        'b_ada': nrm(ks[5], (DEPTH, 6 * D_MODEL), 0.02),
        'g_pre_mix': gain(ks[6], (DEPTH, D_MODEL)),
        'g_post_mix': gain(ks[7], (DEPTH, D_MODEL)),
        'g_pre_ffn': gain(ks[8], (DEPTH, D_MODEL)),
        'g_post_ffn': gain(ks[9], (DEPTH, D_MODEL)),
        'w_in': nrm(ks[10], (DEPTH, D_MODEL, N_IN), D_MODEL ** -0.5),
        'a_lb_logits': nrm(ks[11], (2, DEPTH, A_KW), 0.5),
        'a_norm_g': gain(ks[12], (DEPTH, A_DV)),
        'b_lambda': nrm(ks[13], (DEPTH, 4, B_DH), 0.1),
        'b_subln_g': gain(ks[14], (DEPTH, 2 * B_DH)),
        'c_sink': nrm(ks[15], (DEPTH, C_Q_HEADS), 0.5),
        'w_branch': nrm(ks[16], (DEPTH, N_BRANCH, BRANCH_W, D_MODEL), BRANCH_W ** -0.5),
        'w_out': nrm(ks[17], (DEPTH, D_MODEL, D_MODEL), D_MODEL ** -0.5),
        'w_up': nrm(ks[18], (DEPTH, D_MODEL, 2 * D_FF), D_MODEL ** -0.5),
        'conv_w': nrm(ks[19], (DEPTH, 3, 2 * D_FF), 3 ** -0.5),
        'conv_b': nrm(ks[20], (DEPTH, 2 * D_FF), 0.02),
        'w_down': nrm(ks[21], (DEPTH, D_FF, D_MODEL), D_FF ** -0.5),
    }


def reference(x, c, ctx, c_ctx, w_ada, b_ada, g_pre_mix, g_post_mix, g_pre_ffn, g_post_ffn,
              w_in, a_lb_logits, a_norm_g, b_lambda, b_subln_g, c_sink, w_branch, w_out,
              w_up, conv_w, conv_b, w_down):
    n_tok = x.shape[1]
    rope_b = axial_angles(n_tok, B_DH)
    rope_c = axial_angles(n_tok, C_DH)
    lower = hgrn_lower_bounds(a_lb_logits)
    silu_c = jax.nn.silu(c)
    silu_cc = jax.nn.silu(c_ctx)
    for l in range(DEPTH):
        need_ctx = l < DEPTH - 1
        mod_lat = [m[:, None, :] for m in jnp.split(silu_c @ w_ada[l] + b_ada[l], 6, axis=-1)]
        mod_ctx = jnp.split(silu_cc @ w_ada[l] + b_ada[l], 6, axis=-1)
        lambda_init = 0.8 - 0.6 * math.exp(-0.3 * l)
        h_lat = modulate(rms_norm(x, g_pre_mix[l]), mod_lat[0], mod_lat[1])
        h_ctx = modulate(rms_norm(ctx, g_pre_mix[l]), mod_ctx[0], mod_ctx[1])
        m_lat, m_ctx = mixing_sublayer(h_lat, h_ctx, w_in[l], lower[0, l], lower[1, l], a_norm_g[l],
                                       b_lambda[l], b_subln_g[l], lambda_init, c_sink[l],
                                       w_branch[l], w_out[l], rope_b, rope_c, need_ctx)
        x = x + mod_lat[2] * rms_norm(m_lat, g_post_mix[l])
        f_lat = conv_ffn(modulate(rms_norm(x, g_pre_ffn[l]), mod_lat[3], mod_lat[4]),
                         w_up[l], conv_w[l], conv_b[l], w_down[l])
        x = x + mod_lat[5] * rms_norm(f_lat, g_post_ffn[l])
        if need_ctx:
            ctx = ctx + mod_ctx[2] * rms_norm(m_ctx, g_post_mix[l])
            f_ctx = conv_ffn(modulate(rms_norm(ctx, g_pre_ffn[l]), mod_ctx[3], mod_ctx[4]),
                             w_up[l], conv_w[l], conv_b[l], w_down[l])
            ctx = ctx + mod_ctx[5] * rms_norm(f_ctx, g_post_ffn[l])
    return x
```

```cpp
#include <hip/hip_runtime.h>
#include <cstdio>
#include <cstdint>
#ifndef DBG_NO_MIX
#define DBG_NO_MIX 0
#endif
#ifndef DBG_NO_HGRN
#define DBG_NO_HGRN 0
#endif
#ifndef DBG_NO_ATTN
#define DBG_NO_ATTN 0
#endif
#ifndef DBG_NO_FFN
#define DBG_NO_FFN 0
#endif
namespace pg8 {
#define PG8_LAS __attribute__((address_space(3)))
typedef unsigned short bf16_t;
typedef short bf16x8 __attribute__((ext_vector_type(8)));
typedef float f32x4 __attribute__((ext_vector_type(4)));
typedef unsigned u32x4 __attribute__((ext_vector_type(4)));
constexpr int BM = 256, BK = 64, HALF = 128, HTB = HALF * BK * 2  , STAGE_BYTES = 8 * HTB, NXCD = 8, WGM = 8;

__host__ __device__ __forceinline__ int lds_byte(int r, int c) { const int st = (r >> 4) * 2 + (c >> 5), rr = r & 15, cc = c & 31, ob = rr * 64 + cc * 2; return st * 1024 + (ob ^ (((ob >> 9) & 1) << 5)); }
__host__ __device__ __forceinline__ void stage_rc(int b, int& R, int& C) { const int st = b / 1024, sb = b % 1024, swz = sb ^ (((sb >> 9) & 1) << 5); R = (st >> 1) * 16 + swz / 64; C = (st & 1) * 32 + (swz % 64) / 2; }
__host__ __device__ __forceinline__ int perm32(int rho) { const int n = rho >> 4, i = rho & 15; return 8 * (i >> 2) + 4 * n + (i & 3); }

struct Unit { int pm, pn, kz; };
struct Gemm { const bf16_t* A; const bf16_t* Bt; int M, N, K; size_t kzA, kzB; };

struct StaticOrder {
    int nM, nN, nwg, G, c;
    __host__ __device__ void init(int M, int N, int G_, int c_) { nM = M / BM; nN = N / BM; nwg = nM * nN; G = G_; c = c_; }
    __host__ __device__ bool next(int i, Unit& u) const {
        const long L = (long)i * G + c; if (L >= nwg) return false;
        int wgid = (int)L; { const int q = nwg / NXCD, r = nwg % NXCD, xcd = wgid % NXCD, off = wgid / NXCD; wgid = (xcd < r ? xcd * (q + 1) : r * (q + 1) + (xcd - r) * q) + off; }
        const int nig = WGM * nN, gid = wgid / nig, fm = gid * WGM, gsz = (nM - fm) < WGM ? (nM - fm) : WGM;
        u.pm = fm + ((wgid % nig) % gsz); u.pn = (wgid % nig) / gsz; u.kz = 0; return true;
    }
    __device__ __forceinline__ void a_ready(const Unit&) const {}
    __device__ __forceinline__ void done(const Unit&) const {}
};

typedef float f32x2c_t __attribute__((ext_vector_type(2))); typedef __bf16 bf16x2c_t __attribute__((ext_vector_type(2)));
__device__ __forceinline__ unsigned cvt_pk_bf16(float lo, float hi) { f32x2c_t v = {lo, hi}; bf16x2c_t b = __builtin_convertvector(v, bf16x2c_t); return __builtin_bit_cast(unsigned, b); }
typedef float f32x2 __attribute__((ext_vector_type(2)));
__device__ __forceinline__ f32x2 gelu_pk(f32x2 v) {
    const f32x2 av = __builtin_elementwise_abs(v), d = av * 0.2316418882f + 1.0f;
    f32x2 t; t.x = __builtin_amdgcn_rcpf(d.x); t.y = __builtin_amdgcn_rcpf(d.y);
    f32x2 q = t * 0.5307027145f + (-0.7265760135f); q = q * t + 0.7107068705f; q = q * t + (-0.142248368f); q = q * t + 0.127414796f; q = q * t;
    const f32x2 s = (v * v) * (-0.72134752044f);
    f32x2 e; e.x = __builtin_amdgcn_exp2f(s.x); e.y = __builtin_amdgcn_exp2f(s.y);
    const f32x2 m = v * (q * e), r = v - m;
    f32x2 o; o.x = v.x < 0.f ? m.x : r.x; o.y = v.y < 0.f ? m.y : r.y; return o;
}

template <int ACT  > struct EpiBf16 {
    static constexpr bool PERM = true, AFTER_DRAIN = false; static_assert(ACT == 0 || ACT == 1, "EpiBf16: ACT is 0 (none) or 1 (gelu_pk)");
    bf16_t* O; int ldc; const float* bias; int split_cols; size_t split_stride; float scale0;
    __device__ __forceinline__ void operator()(const f32x4 (&acc)[2][2][4][2], const Unit& u, int wr, int wc, int fr, int fq) const {
        const int row0 = u.pm * BM + wr * 64 + fr; int colt = u.pn * BM; bf16_t* base = O;
        float sc = 1.f; if (split_cols) { const int t = colt / split_cols; base += (size_t)t * split_stride; colt -= t * split_cols; if (t == 0) sc = scale0; }
        const int col0 = colt + wc * 32 + 8 * fq, bcol0 = u.pn * BM + wc * 32 + 8 * fq;
        f32x4 bv[2][2];
#pragma unroll
        for (int bj = 0; bj < 2; ++bj)
#pragma unroll
            for (int n = 0; n < 2; ++n) bv[bj][n] = bias ? *(const f32x4*)(bias + bcol0 + bj * HALF + 4 * n) : (f32x4){0.f, 0.f, 0.f, 0.f};
#pragma unroll
        for (int ai = 0; ai < 2; ++ai)
#pragma unroll
            for (int m = 0; m < 4; ++m) { bf16_t* rowp = base + (size_t)(row0 + ai * HALF + m * 16) * ldc + col0;
#pragma unroll
                for (int bj = 0; bj < 2; ++bj) { f32x4 v0 = acc[ai][bj][m][0] + bv[bj][0], v1 = acc[ai][bj][m][1] + bv[bj][1];
                    if (ACT == 1) { f32x2 a = gelu_pk((f32x2){v0[0], v0[1]}), b = gelu_pk((f32x2){v0[2], v0[3]}), c = gelu_pk((f32x2){v1[0], v1[1]}), d = gelu_pk((f32x2){v1[2], v1[3]});
                        v0 = (f32x4){a.x, a.y, b.x, b.y}; v1 = (f32x4){c.x, c.y, d.x, d.y}; }
                    v0 = v0 * sc; v1 = v1 * sc; u32x4 w; w.x = cvt_pk_bf16(v0[0], v0[1]); w.y = cvt_pk_bf16(v0[2], v0[3]); w.z = cvt_pk_bf16(v1[0], v1[1]); w.w = cvt_pk_bf16(v1[2], v1[3]);
                    *(u32x4*)(rowp + bj * HALF) = w; } }
    }
};


__device__ __forceinline__ float sigmoid_f(float x) { return __builtin_amdgcn_rcpf(1.0f + __expf(-x)); }
__device__ __forceinline__ f32x4 ld_sc1_f32x4(const float* p) { f32x4 v; asm volatile("global_load_dwordx4 %0, %1, off sc1\n\ts_waitcnt vmcnt(0)" : "=v"(v) : "v"(p) : "memory"); return v; }
struct EpiZ {
    static constexpr bool PERM = true, AFTER_DRAIN = false;
    bf16_t* Zm; bf16_t* Zg;
    __device__ __forceinline__ void operator()(const f32x4 (&acc)[2][2][4][2], const Unit& u, int wr, int wc, int fr, int fq) const {
        const int row0 = u.pm * BM + wr * 64 + fr;
        const bool mainz = u.pn < 38; bf16_t* base = mainz ? Zm : Zg; const int ldc = mainz ? 9728 : 6144; const int colt = (mainz ? u.pn : u.pn - 38) * BM;
        const int col0 = colt + wc * 32 + 8 * fq;
#pragma unroll
        for (int ai = 0; ai < 2; ++ai)
#pragma unroll
            for (int m = 0; m < 4; ++m) { bf16_t* rowp = base + (size_t)(row0 + ai * HALF + m * 16) * ldc + col0;
#pragma unroll
                for (int bj = 0; bj < 2; ++bj) { const f32x4 v0 = acc[ai][bj][m][0], v1 = acc[ai][bj][m][1];
                    u32x4 w; w.x = cvt_pk_bf16(v0[0], v0[1]); w.y = cvt_pk_bf16(v0[2], v0[3]); w.z = cvt_pk_bf16(v1[0], v1[1]); w.w = cvt_pk_bf16(v1[2], v1[3]);
                    *(u32x4*)(rowp + bj * HALF) = w; } }
    }
};
struct EpiMerge {
    static constexpr bool PERM = true, AFTER_DRAIN = false;
    const bf16_t* Zg; float* mix; bf16_t* out;
    __device__ __forceinline__ void operator()(const f32x4 (&acc)[2][2][4][2], const Unit& u, int wr, int wc, int fr, int fq) const {
        const int row0 = u.pm * BM + wr * 64 + fr, col0 = u.pn * BM + wc * 32 + 8 * fq, n = u.kz;
#pragma unroll
        for (int ai = 0; ai < 2; ++ai)
#pragma unroll
            for (int m = 0; m < 4; ++m) { const size_t row = (size_t)(row0 + ai * HALF + m * 16);
#pragma unroll
                for (int bj = 0; bj < 2; ++bj) { const int col = col0 + bj * HALF;
                    const u32x4 gw = *(const u32x4*)(Zg + row * 6144 + (size_t)n * 2048 + col);
                    f32x4 g0, g1;
                    g0[0] = sigmoid_f(__uint_as_float(gw.x << 16)); g0[1] = sigmoid_f(__uint_as_float(gw.x & 0xffff0000u));
                    g0[2] = sigmoid_f(__uint_as_float(gw.y << 16)); g0[3] = sigmoid_f(__uint_as_float(gw.y & 0xffff0000u));
                    g1[0] = sigmoid_f(__uint_as_float(gw.z << 16)); g1[1] = sigmoid_f(__uint_as_float(gw.z & 0xffff0000u));
                    g1[2] = sigmoid_f(__uint_as_float(gw.w << 16)); g1[3] = sigmoid_f(__uint_as_float(gw.w & 0xffff0000u));
                    f32x4 v0 = acc[ai][bj][m][0] * g0, v1 = acc[ai][bj][m][1] * g1;
                    float* mp = mix + row * 2048 + col;
                    if (n > 0) { v0 += ld_sc1_f32x4(mp); v1 += ld_sc1_f32x4(mp + 4); }
                    if (n < 2) { *(f32x4*)mp = v0; *(f32x4*)(mp + 4) = v1; }
                    else { u32x4 w; w.x = cvt_pk_bf16(v0[0], v0[1]); w.y = cvt_pk_bf16(v0[2], v0[3]); w.z = cvt_pk_bf16(v1[0], v1[1]); w.w = cvt_pk_bf16(v1[2], v1[3]);
                        *(u32x4*)(out + row * 2048 + col) = w; } } }
    }
};
struct MergeOrder {
    StaticOrder base;
    __device__ __forceinline__ bool next(int i, Unit& u) const { const int ti = i / 3; if (!base.next(ti, u)) return false; u.kz = i - 3 * ti; return true; }
    __device__ __forceinline__ void a_ready(const Unit&) const {}
    __device__ __forceinline__ void done(const Unit&) const {}
};


template <class Epi, class Sched, bool ALIGN_EPI = false, bool SP2 = false>
__device__ __forceinline__ void gemm_phase(PG8_LAS unsigned char* lds, const Gemm g, const Sched& S, const Epi& E) {
    int tid = threadIdx.x; asm volatile("" : "+v"(tid));
    const int wid = __builtin_amdgcn_readfirstlane(tid >> 6), lane = tid & 63, wr = wid >> 2, wc = wid & 3, fr = lane & 15, fq = lane >> 4;
    const int K = g.K, nt = K / BK;
    unsigned voffA[2], voffB[2];
#pragma unroll
    for (int i = 0; i < 2; ++i) { int R, C; stage_rc(tid * 16 + i * 8192, R, C); const int Rb = Epi::PERM ? ((R & ~31) + perm32(R & 31)) : R;
        voffA[i] = (unsigned)(R * K + C) * 2u; voffB[i] = (unsigned)(Rb * K + C) * 2u; }
    const size_t kstep = (size_t)(BK * 2);
    const size_t hstep = (size_t)HALF * K * 2;
    const size_t tstep = 2 * hstep;
    const unsigned ldsw = (unsigned)wid * 1024u;
    const int aoff = lds_byte(wr * 64 + fr, fq * 8), boff = lds_byte(wc * 32 + fr, fq * 8);
#define PG8_SA(b, h) (((b) * 2 + (h)) * HTB)
#define PG8_SB(b, h) ((4 + (b) * 2 + (h)) * HTB)
#define PG8_STAGE(bufoff, gbase, voff) do { _Pragma("unroll") for (int _i = 0; _i < 2; ++_i) \
        __builtin_amdgcn_global_load_lds((const unsigned*)((const char*)(gbase) + (voff)[_i]), (PG8_LAS unsigned*)(lds + (bufoff) + ldsw + _i * 8192), 16, 0, 0); } while (0)
#define PG8_LDA(dst, b, h) do { _Pragma("unroll") for (int m = 0; m < 4; ++m) _Pragma("unroll") for (int k = 0; k < 2; ++k) dst[m][k] = *(const PG8_LAS bf16x8*)(lds + PG8_SA(b, h) + aoff + m * 2048 + k * 1024); } while (0)
#define PG8_LDB(dst, b, h) do { _Pragma("unroll") for (int n = 0; n < 2; ++n) _Pragma("unroll") for (int k = 0; k < 2; ++k) dst[n][k] = *(const PG8_LAS bf16x8*)(lds + PG8_SB(b, h) + boff + n * 2048 + k * 1024); } while (0)
#define PG8_MMA(ai, bj, At, Bt) do { __builtin_amdgcn_s_setprio(1); _Pragma("unroll") for (int m = 0; m < 4; ++m) _Pragma("unroll") for (int n = 0; n < 2; ++n) _Pragma("unroll") for (int k = 0; k < 2; ++k) \
        acc[ai][bj][m][n] = __builtin_amdgcn_mfma_f32_16x16x32_bf16(Bt[n][k], At[m][k], acc[ai][bj][m][n], 0, 0, 0); __builtin_amdgcn_s_setprio(0); } while (0)
#define PG8_WAIT_V(n) asm volatile("s_waitcnt vmcnt(" #n ")" ::: "memory")
#define PG8_WAIT_L(n) asm volatile("s_waitcnt lgkmcnt(" #n ")" ::: "memory")
#define PG8_BAR __builtin_amdgcn_s_barrier()
#define PG8_SCHED __builtin_amdgcn_sched_barrier(0)
    Unit cur, nxt; int ui = 0;
    if (!S.next(0, cur)) return;
    f32x4 acc[2][2][4][2];
#pragma unroll
    for (int a = 0; a < 2; ++a)
#pragma unroll
        for (int b = 0; b < 2; ++b)
#pragma unroll
            for (int m = 0; m < 4; ++m)
#pragma unroll
                for (int n = 0; n < 2; ++n) acc[a][b][m][n] = (f32x4){0.f, 0.f, 0.f, 0.f};
    bf16x8 At[4][2], B0[2][2], B1[2][2];
    const char* cA = (const char*)g.A + (size_t)cur.pm * tstep + (size_t)cur.kz * g.kzA; const char* cB = (const char*)g.Bt + (size_t)cur.pn * tstep + (size_t)cur.kz * g.kzB;
    S.a_ready(cur);
    if constexpr (SP2) {
        PG8_STAGE(PG8_SB(0, 0), cB, voffB); PG8_STAGE(PG8_SB(0, 1), cB + hstep, voffB); PG8_STAGE(PG8_SA(0, 0), cA, voffA); PG8_STAGE(PG8_SA(0, 1), cA + hstep, voffA);
        if (wr == 1) PG8_BAR;
        PG8_WAIT_V(2); PG8_BAR;
        PG8_STAGE(PG8_SB(1, 0), cB + kstep, voffB); PG8_STAGE(PG8_SA(1, 0), cA + kstep, voffA); PG8_STAGE(PG8_SB(1, 1), cB + hstep + kstep, voffB);
        PG8_WAIT_V(6); PG8_BAR;
    } else {
        PG8_STAGE(PG8_SB(0, 0), cB, voffB); PG8_STAGE(PG8_SA(0, 0), cA, voffA); PG8_STAGE(PG8_SB(0, 1), cB + hstep, voffB); PG8_STAGE(PG8_SA(0, 1), cA + hstep, voffA);
        if (wr == 1) PG8_BAR;
        PG8_WAIT_V(4); PG8_BAR;
        PG8_STAGE(PG8_SB(1, 0), cB + kstep, voffB); PG8_STAGE(PG8_SA(1, 0), cA + kstep, voffA); PG8_STAGE(PG8_SB(1, 1), cB + hstep + kstep, voffB);
        PG8_WAIT_V(6); PG8_BAR;
    }
    for (;;) {
        const bool has_next = S.next(ui + 1, nxt);
        const char* nA = has_next ? (const char*)g.A + (size_t)nxt.pm * tstep + (size_t)nxt.kz * g.kzA : cA; const char* nB = has_next ? (const char*)g.Bt + (size_t)nxt.pn * tstep + (size_t)nxt.kz * g.kzB : cB;
        for (int t = 0; t < nt; t += 2) {
            const bool last = (t == nt - 2);
            const char* a1 = cA + (size_t)(t + 1) * kstep;
            const char* a2 = last ? nA : cA + (size_t)(t + 2) * kstep; const char* b2 = last ? nB : cB + (size_t)(t + 2) * kstep;
            const char* a3 = a2 + kstep; const char* b3 = b2 + kstep;
            if (last && has_next) S.a_ready(nxt);
            if constexpr (SP2) {
            PG8_LDB(B0, 0, 0); PG8_LDB(B1, 0, 1); PG8_SCHED; PG8_LDA(At, 0, 0); PG8_STAGE(PG8_SA(1, 1), a1 + hstep, voffA);
            PG8_WAIT_V(8); PG8_WAIT_L(0); PG8_BAR; PG8_MMA(0, 0, At, B0); PG8_MMA(0, 1, At, B1); PG8_BAR; PG8_SCHED;
            PG8_LDA(At, 0, 1); PG8_STAGE(PG8_SB(0, 0), b2, voffB); PG8_STAGE(PG8_SB(0, 1), b2 + hstep, voffB); PG8_STAGE(PG8_SA(0, 0), a2, voffA);
            PG8_WAIT_V(8); PG8_WAIT_L(0); PG8_BAR; PG8_MMA(1, 0, At, B0); PG8_MMA(1, 1, At, B1); PG8_BAR; PG8_SCHED;
            PG8_LDB(B0, 1, 0); PG8_LDB(B1, 1, 1); PG8_SCHED; PG8_LDA(At, 1, 0); PG8_STAGE(PG8_SA(0, 1), a2 + hstep, voffA);
            PG8_WAIT_V(8); PG8_WAIT_L(0); PG8_BAR; PG8_MMA(0, 0, At, B0); PG8_MMA(0, 1, At, B1); PG8_BAR; PG8_SCHED;
            PG8_LDA(At, 1, 1); PG8_STAGE(PG8_SB(1, 0), b3, voffB); PG8_STAGE(PG8_SB(1, 1), b3 + hstep, voffB); PG8_STAGE(PG8_SA(1, 0), a3, voffA);
            PG8_WAIT_V(8); PG8_WAIT_L(0); PG8_BAR; PG8_MMA(1, 0, At, B0); PG8_MMA(1, 1, At, B1); PG8_BAR; PG8_SCHED;
            } else {
            PG8_LDB(B0, 0, 0); PG8_SCHED; PG8_LDA(At, 0, 0); PG8_STAGE(PG8_SA(1, 1), a1 + hstep, voffA);
            PG8_WAIT_L(8); PG8_BAR; PG8_WAIT_L(0); PG8_MMA(0, 0, At, B0); PG8_BAR; PG8_SCHED;
            PG8_LDB(B1, 0, 1); PG8_STAGE(PG8_SB(0, 0), b2, voffB);
            PG8_BAR; PG8_WAIT_L(0); PG8_MMA(0, 1, At, B1); PG8_BAR;
            PG8_LDA(At, 0, 1); PG8_STAGE(PG8_SA(0, 0), a2, voffA);
            PG8_BAR; PG8_WAIT_L(0); PG8_MMA(1, 0, At, B0); PG8_BAR; PG8_SCHED;
            PG8_STAGE(PG8_SB(0, 1), b2 + hstep, voffB);
            PG8_WAIT_V(6); PG8_BAR; PG8_MMA(1, 1, At, B1); PG8_BAR;
            PG8_LDB(B0, 1, 0); PG8_SCHED; PG8_LDA(At, 1, 0); PG8_STAGE(PG8_SA(0, 1), a2 + hstep, voffA);
            PG8_WAIT_L(8); PG8_BAR; PG8_WAIT_L(0); PG8_MMA(0, 0, At, B0); PG8_BAR; PG8_SCHED;
            PG8_LDB(B1, 1, 1); PG8_STAGE(PG8_SB(1, 0), b3, voffB);
            PG8_BAR; PG8_WAIT_L(0); PG8_MMA(0, 1, At, B1); PG8_BAR;
            PG8_LDA(At, 1, 1); PG8_STAGE(PG8_SA(1, 0), a3, voffA);
            PG8_BAR; PG8_WAIT_L(0); PG8_MMA(1, 0, At, B0); PG8_BAR; PG8_SCHED;
            PG8_STAGE(PG8_SB(1, 1), b3 + hstep, voffB);
            PG8_WAIT_V(6); PG8_BAR; PG8_MMA(1, 1, At, B1); PG8_BAR;
            }
        }
        if constexpr (ALIGN_EPI) { if (wr == 0) PG8_BAR; }
        if constexpr (!Epi::AFTER_DRAIN) { E(acc, cur, wr, wc, fr, fq); S.done(cur); }
        if (!has_next) break;
#pragma unroll
        for (int a = 0; a < 2; ++a)
#pragma unroll
            for (int b = 0; b < 2; ++b)
#pragma unroll
                for (int m = 0; m < 4; ++m)
#pragma unroll
                    for (int n = 0; n < 2; ++n) acc[a][b][m][n] = (f32x4){0.f, 0.f, 0.f, 0.f};
        cur = nxt; cA = nA; cB = nB; ++ui;
        if constexpr (ALIGN_EPI) { if (wr == 1) PG8_BAR; }
    }
    PG8_WAIT_V(0);
    if constexpr (!ALIGN_EPI) { if (wr == 0) PG8_BAR; }
    PG8_BAR;
    if constexpr (Epi::AFTER_DRAIN) { E.fused(acc, cur, wr, wc, fr, fq, lds, wid, lane); S.done(cur); }
#undef PG8_SA
#undef PG8_SB
#undef PG8_STAGE
#undef PG8_LDA
#undef PG8_LDB
#undef PG8_MMA
#undef PG8_WAIT_V
#undef PG8_WAIT_L
#undef PG8_BAR
#undef PG8_SCHED
}
}


#define GAS __attribute__((address_space(1)))
#define LAS __attribute__((address_space(3)))
typedef unsigned short bf16;
typedef unsigned v4u __attribute__((ext_vector_type(4)));
typedef float f32x4 __attribute__((ext_vector_type(4)));
typedef short bf16x8 __attribute__((ext_vector_type(8)));
typedef GAS unsigned gu32;
typedef GAS unsigned long long gu64;
#define RLX_AGENT __ATOMIC_RELAXED, __HIP_MEMORY_SCOPE_AGENT
#define LDS_WAIT() asm volatile("s_waitcnt lgkmcnt(0)" ::: "memory")
#define VM_WAIT() asm volatile("s_waitcnt vmcnt(0)" ::: "memory")
__device__ __forceinline__ unsigned long long rt() { return __builtin_amdgcn_s_memrealtime(); }
__device__ __forceinline__ unsigned f2bf(float f) { unsigned u = __builtin_bit_cast(unsigned, f); return (u + 0x7fffu + ((u >> 16) & 1u)) >> 16; }
__device__ __forceinline__ unsigned pk2(float lo, float hi) { return f2bf(lo) | (f2bf(hi) << 16); }

#define XB_TMO      128
#define XB_XCNT(j)  (256  + 64 * (j))
#define XB_XSUB(j)  (1280 + 64 * (j))
#define XB_XGEN(j)  (2304 + 64 * (j))
#define XB_TOP      3328
#define XB_TOPGEN   3392
#define XCD_BAR_WORDS 3456
#define XB_SPIN_CAP (1u << 18)

__device__ __forceinline__ unsigned xb_ld(unsigned* p)              { return __hip_atomic_load(p, __ATOMIC_RELAXED, __HIP_MEMORY_SCOPE_AGENT); }
__device__ __forceinline__ unsigned xb_add(unsigned* p, unsigned v) { return __hip_atomic_fetch_add(p, v, __ATOMIC_RELAXED, __HIP_MEMORY_SCOPE_AGENT); }
__device__ __forceinline__ unsigned xb_xcc_id() { return (unsigned)__builtin_amdgcn_s_getreg((3 << 11) | 20) & 0xFu; }
#define XB_SPIN(cond, bar) do { unsigned _sp = 0; while (cond) { __builtin_amdgcn_s_sleep(1); \
    if ((++_sp & 255u) == 0u) { if (xb_ld(&(bar)[XB_TMO])) break; if (_sp > XB_SPIN_CAP) { atomicAdd(&(bar)[XB_TMO], 1u); break; } } } } while (0)

struct XcdBarrier {
    unsigned* bar; unsigned x;
    volatile LAS unsigned* st;
};

__device__ __forceinline__ XcdBarrier xcd_barrier_post(unsigned* bar, volatile LAS unsigned* st) {
    XcdBarrier b; b.bar = bar; b.x = xb_xcc_id(); b.st = st;
    if (threadIdx.x == 0) (void)xb_add(&bar[XB_XCNT(b.x)], 1u);
    return b;
}
__device__ __forceinline__ void xcd_barrier_complete(unsigned* bar, unsigned x, unsigned& nloc, unsigned& nx) {
    const unsigned G = gridDim.x * gridDim.y * gridDim.z;
    unsigned sum, cnt, mine, sp = 0u;
    for (;;) {
        sum = 0u; cnt = 0u; mine = 0u;
#pragma unroll
        for (unsigned j = 0; j < 16; ++j) { const unsigned c = xb_ld(&bar[XB_XCNT(j)]); sum += c; cnt += (c > 0u) ? 1u : 0u; mine = (j == x) ? c : mine; }
        if (sum == G) break;
        __builtin_amdgcn_s_sleep(1);
        if ((++sp & 255u) == 0u) { if (xb_ld(&bar[XB_TMO])) break; if (sp > XB_SPIN_CAP) { atomicAdd(&bar[XB_TMO], 1u); break; } }
    }
    nloc = mine > 0u ? mine : 1u; nx = cnt > 0u ? cnt : 1u;
}

__device__ __forceinline__ void xcd_barrier(const XcdBarrier& b) {
    asm volatile("s_waitcnt vmcnt(0)" ::: "memory");
    __syncthreads();
    if (threadIdx.x == 0) {
        unsigned* bar = b.bar;
        __builtin_amdgcn_s_waitcnt(0);
        unsigned nloc = b.st[0], nx = b.st[1];
        if (nloc == 0u) { xcd_barrier_complete(bar, b.x, nloc, nx); b.st[0] = nloc; b.st[1] = nx; }
        const unsigned old = xb_add(&bar[XB_XSUB(b.x)], 1u);
        const unsigned gen = old / nloc;
        if (old + 1u == (gen + 1u) * nloc) {
            __builtin_amdgcn_fence(__ATOMIC_RELEASE, "agent");
            asm volatile("s_waitcnt vmcnt(0)" ::: "memory");
            const unsigned og = xb_add(&bar[XB_TOP], 1u);
            const unsigned tg = og / nx;
            if (og + 1u == (tg + 1u) * nx) xb_add(&bar[XB_TOPGEN], 1u);
            else XB_SPIN(xb_ld(&bar[XB_TOPGEN]) == tg, bar);
            __builtin_amdgcn_fence(__ATOMIC_ACQUIRE, "agent");
            xb_add(&bar[XB_XGEN(b.x)], 1u);
            asm volatile("s_waitcnt vmcnt(0)" ::: "memory");
        } else {
            XB_SPIN(xb_ld(&bar[XB_XGEN(b.x)]) == gen, bar);
            __builtin_amdgcn_fence(__ATOMIC_ACQUIRE, "agent");
            asm volatile("s_waitcnt vmcnt(0)" ::: "memory");
        }
    }
    __syncthreads();
}


typedef unsigned u32x4v __attribute__((ext_vector_type(4)));
constexpr int NWAVES = 8;
constexpr int NB = 8, SEQ = 4096, CTXL = 256, TOK = SEQ + CTXL, M = NB * TOK, DM = 2048, NL = 4;
constexpr int ZM_LD = 9728, ZG_LD = 6144, NIN = 15872, DFF = 5632, UP_LD = 2 * DFF, BW = 1024;
constexpr int ZA_Q = 0, ZA_FF = 1024, ZA_FB = 2048, ZA_V = 3072, ZA_G = 4096, ZB_Q = 5120, ZB_K = 6144, ZB_V = 7168, ZC_Q = 8192, ZC_K = 9216, ZC_V = 9472;
constexpr float EPS = 1e-6f, LOG2E = 1.4426950408889634f;
constexpr size_t MiB = 1u << 20;
constexpr size_t WS_CTL = 0, CTL_ZERO_BYTES = 1 * MiB;
constexpr size_t WS_MOD = 1 * MiB;
constexpr size_t WS_LB = 3 * MiB;
constexpr size_t WS_LAM = 3 * MiB + 65536;
constexpr size_t WS_ROPE = 3 * MiB + 131072;
constexpr size_t WS_W = 5 * MiB;
constexpr size_t W_IN = 0, W_BR = 62 * MiB, W_OUT = 74 * MiB, W_UP = 82 * MiB, W_DN = 126 * MiB;
constexpr size_t WS_Z = 153 * MiB;
constexpr size_t WS_ZG = WS_Z + 646 * MiB;
constexpr size_t WS_H = 1207 * MiB;
constexpr size_t WS_A = 1343 * MiB;
constexpr size_t WS_KP = WS_A + 204 * MiB;
constexpr size_t WS_M2 = 1717 * MiB;
constexpr size_t WS_CX = 1853 * MiB;
constexpr size_t WS_END = 1869 * MiB;
static_assert((size_t)M * ZM_LD * 2 == 646 * MiB && (size_t)M * ZG_LD * 2 == 408 * MiB && (size_t)M * DM * 2 == 136 * MiB && (size_t)3 * M * BW * 2 == 204 * MiB && (size_t)M * DFF * 2 == 374 * MiB, "ws map");
static_assert((size_t)NIN * DM * 2 == 62 * MiB && (size_t)UP_LD * DM * 2 == 44 * MiB && (size_t)DM * DFF * 2 == 22 * MiB, "w map");
constexpr int CW_BAR = 4096;

constexpr int RING_BYTES = 139264;
constexpr int LDSCTL_OFF = RING_BYTES, MISC_OFF = LDSCTL_OFF + 320;
constexpr int LDS_BYTES = 147456;

struct Frame {
    LAS unsigned char* lds;
    volatile LAS unsigned* MISC;
    int tid, lane, wave, vcu, G;
};
typedef __attribute__((address_space(4))) const unsigned char kchar_t;
__device__ __forceinline__ kchar_t* kargs() { kchar_t* k = (kchar_t*)__builtin_amdgcn_kernarg_segment_ptr(); asm volatile("" : "+s"(k)); return k; }
__device__ __forceinline__ const float* inptr(int i) { return *(const float* __attribute__((address_space(4)))*)(kargs() + 8 * i); }
__device__ __forceinline__ float* outptr() { return *(float* __attribute__((address_space(4)))*)(kargs() + 176); }
__device__ __forceinline__ unsigned char* wsptr() { return *(unsigned char* __attribute__((address_space(4)))*)(kargs() + 184); }
constexpr int GRID = 256;
__device__ __forceinline__ Frame mkframe(LAS unsigned char* lds) {
    Frame F; int t = threadIdx.x; asm volatile("" : "+v"(t)); int bx = blockIdx.x; asm volatile("" : "+s"(bx));
    F.lds = lds; F.MISC = (volatile LAS unsigned*)(lds + MISC_OFF);
    F.tid = t; F.lane = t & 63; F.wave = __builtin_amdgcn_readfirstlane(t >> 6); F.G = GRID; F.vcu = (bx & 7) * (GRID / 8) + (bx >> 3);
    return F;
}
__device__ __forceinline__ float wave_sum(float v) {
#pragma unroll
    for (int o = 1; o < 64; o <<= 1) v += __shfl_xor(v, o);
    return v;
}
__device__ __forceinline__ float bf2f(unsigned short b) { return __uint_as_float(((unsigned)b) << 16); }
__device__ __forceinline__ float bflo(unsigned w) { return __uint_as_float(w << 16); }
__device__ __forceinline__ float bfhi(unsigned w) { return __uint_as_float(w & 0xffff0000u); }
__device__ __forceinline__ unsigned pkbf(float lo, float hi) { return pg8::cvt_pk_bf16(lo, hi); }
__device__ __forceinline__ float silu_f(float x) { return x * __builtin_amdgcn_rcpf(1.0f + __expf(-x)); }

__device__ __forceinline__ void transpose_item(const float* W, int K, int N, bf16* WT, LAS float* scr, int item, int lane) {
    const int nblk = N / 32, kb = item / nblk, nb = item % nblk, k0 = 64 * kb, n0 = 32 * nb;
#pragma unroll 8
    for (int i = 0; i < 32; ++i) { const int kk = 2 * i + (lane >> 5); scr[kk * 33 + (lane & 31)] = W[(size_t)(k0 + kk) * N + n0 + (lane & 31)]; }
    LDS_WAIT(); asm volatile("" ::: "memory");
    const int c = lane & 7;
#pragma unroll
    for (int j = 0; j < 4; ++j) { const int n = (lane >> 3) + 8 * j; const LAS float* s = scr + (8 * c) * 33 + n;
        v4u o; o.x = pkbf(s[0 * 33], s[1 * 33]); o.y = pkbf(s[2 * 33], s[3 * 33]); o.z = pkbf(s[4 * 33], s[5 * 33]); o.w = pkbf(s[6 * 33], s[7 * 33]);
        *(GAS v4u*)(WT + (size_t)(n0 + n) * K + k0 + 8 * c) = o; }
    LDS_WAIT(); asm volatile("" ::: "memory");
}
__device__ __forceinline__ void convert_weights(Frame& F, int l) {
    LAS float* scr = (LAS float*)(F.lds + F.wave * 16384);
    const int gw = F.vcu * NWAVES + F.wave, NGW = F.G * NWAVES;
    constexpr int I_IN = (DM / 64) * (NIN / 32), I_BR = (BW / 64) * (DM / 32), I_OUT = (DM / 64) * (DM / 32), I_UP = (DM / 64) * (UP_LD / 32), I_DN = (DFF / 64) * (DM / 32);
    constexpr int NITEMS = I_IN + 3 * I_BR + I_OUT + I_UP + I_DN;
    unsigned char* wb = wsptr() + WS_W;
    for (int it = gw; it < NITEMS; it += NGW) {
        int r = it;
        if (r < I_IN) { transpose_item(inptr(10) + (size_t)l * DM * NIN, DM, NIN, (bf16*)(wb + W_IN), scr, r, F.lane); continue; } r -= I_IN;
        if (r < 3 * I_BR) { const int n = r / I_BR; transpose_item(inptr(16) + ((size_t)l * 3 + n) * BW * DM, BW, DM, (bf16*)(wb + W_BR) + (size_t)n * DM * BW, scr, r - n * I_BR, F.lane); continue; } r -= 3 * I_BR;
        if (r < I_OUT) { transpose_item(inptr(17) + (size_t)l * DM * DM, DM, DM, (bf16*)(wb + W_OUT), scr, r, F.lane); continue; } r -= I_OUT;
        if (r < I_UP) { transpose_item(inptr(18) + (size_t)l * DM * UP_LD, DM, UP_LD, (bf16*)(wb + W_UP), scr, r, F.lane); continue; } r -= I_UP;
        transpose_item(inptr(21) + (size_t)l * DFF * DM, DFF, DM, (bf16*)(wb + W_DN), scr, r, F.lane);
    }
}
__device__ __forceinline__ void prologue_small(Frame& F) {
    LAS float* sv = (LAS float*)F.lds;
    LAS float* red = (LAS float*)(F.lds + 9 * 2048 * 4);
    for (int i = F.tid; i < 9 * 2048; i += NWAVES * 64) { const int j = i >> 11, k = i & 2047; const float c = j < 8 ? inptr(1)[j * DM + k] : inptr(3)[k]; sv[i] = silu_f(c); }
    __syncthreads();
    float* mod = (float*)(wsptr() + WS_MOD);
    for (int it = F.vcu; it < NL * 192; it += F.G) {
        const int l = it / 192, cg = it - l * 192, n = cg * 64 + F.lane;
        const float* W = inptr(4) + (size_t)l * DM * (6 * DM) + n;
        float a[9];
#pragma unroll
        for (int j = 0; j < 9; ++j) a[j] = 0.f;
        const int kb = F.wave * 256;
#pragma unroll 4
        for (int k = 0; k < 256; ++k) { const float w = W[(size_t)(kb + k) * (6 * DM)];
#pragma unroll
            for (int j = 0; j < 9; ++j) a[j] += sv[j * 2048 + kb + k] * w; }
#pragma unroll
        for (int j = 0; j < 9; ++j) red[(F.wave * 9 + j) * 64 + F.lane] = a[j];
        __syncthreads();
        for (int o = F.tid; o < 9 * 64; o += NWAVES * 64) { const int j = o >> 6, ln = o & 63; float s = 0.f;
#pragma unroll
            for (int w = 0; w < 8; ++w) s += red[(w * 9 + j) * 64 + ln];
            const int nn = cg * 64 + ln; mod[((size_t)l * 9 + j) * (6 * DM) + nn] = s + inptr(5)[(size_t)l * (6 * DM) + nn]; }
        __syncthreads();
    }
    const int gt = F.vcu * NWAVES * 64 + F.tid, NGT = F.G * NWAVES * 64;
    float* lb = (float*)(wsptr() + WS_LB);
    for (int i = gt; i < 2 * 1024; i += NGT) { const int dir = i >> 10, c = i & 1023; float lg[NL], mx = -1e30f;
#pragma unroll
        for (int l = 0; l < NL; ++l) { lg[l] = inptr(11)[((size_t)dir * NL + l) * 1024 + c]; mx = fmaxf(mx, lg[l]); }
        float s = 0.f;
#pragma unroll
        for (int l = 0; l < NL; ++l) { lg[l] = expf(lg[l] - mx); s += lg[l]; }
        float cum = 0.f;
#pragma unroll
        for (int l = 0; l < NL; ++l) { if (l > 0) cum += lg[l] / s; lb[((size_t)dir * NL + l) * 1024 + c] = cum; } }
    if (gt < NL) { const float* lv = inptr(13) + (size_t)gt * 4 * 64; float s1 = 0.f, s2 = 0.f;
        for (int i = 0; i < 64; ++i) { s1 += lv[i] * lv[64 + i]; s2 += lv[128 + i] * lv[192 + i]; }
        ((float*)(wsptr() + WS_LAM))[gt] = expf(s1) - expf(s2) + (0.8f - 0.6f * expf(-0.3f * (float)gt)); }
    float* rp = (float*)(wsptr() + WS_ROPE);
    for (int i = gt; i < 64 * 16; i += NGT) { const int pos = i >> 4, k = i & 15; const float inv = powf(10000.0f, -(float)k / 16.0f), ang = (float)pos * inv; rp[i] = cosf(ang); rp[1024 + i] = sinf(ang); }
    for (int i = gt; i < 64 * 32; i += NGT) { const int pos = i >> 5, k = i & 31; const float inv = powf(10000.0f, -(float)k / 32.0f), ang = (float)pos * inv; rp[2048 + i] = cosf(ang); rp[4096 + i] = sinf(ang); }
}
__device__ __forceinline__ const float* row_src(int b, int p, const float* lat, const float* ctx) { return p < CTXL ? ctx + (size_t)(b * CTXL + p) * DM : lat + (size_t)(b * SEQ + p - CTXL) * DM; }

__device__ __forceinline__ void prenorm_phase(Frame& F, int l, const float* xlat, const float* xctx) {
    const int gw = F.vcu * NWAVES + F.wave, NGW = F.G * NWAVES;
    const float* mod = (const float*)(wsptr() + WS_MOD) + (size_t)l * 9 * (6 * DM);
    const float* g = inptr(6) + (size_t)l * DM;
    bf16* H = (bf16*)(wsptr() + WS_H);
    for (int r = gw; r < M; r += NGW) {
        const int b = r / TOK, p = r - b * TOK; const float* xr = row_src(b, p, xlat, xctx); const float* mr = mod + (size_t)(p < CTXL ? 8 : b) * (6 * DM);
        f32x4 v[8]; float ss = 0.f;
#pragma unroll
        for (int j = 0; j < 8; ++j) { v[j] = *(const f32x4*)(xr + 4 * (64 * j + F.lane)); ss += (v[j].x * v[j].x + v[j].y * v[j].y) + (v[j].z * v[j].z + v[j].w * v[j].w); }
        const float rstd = rsqrtf(wave_sum(ss) * (1.f / DM) + EPS);
#pragma unroll
        for (int j = 0; j < 8; ++j) { const int c = 4 * (64 * j + F.lane); const f32x4 gg = *(const f32x4*)(g + c), sh = *(const f32x4*)(mr + c), sc = *(const f32x4*)(mr + DM + c);
            const f32x4 hv = (v[j] * rstd * gg) * (1.0f + sc) + sh;
            *(unsigned long long*)(H + (size_t)r * DM + c) = (unsigned long long)pkbf(hv.x, hv.y) | ((unsigned long long)pkbf(hv.z, hv.w) << 32); }
    }
}
__device__ __forceinline__ void post_pre_phase(Frame& F, const bf16* mm, const float* slat, const float* sctx, float* dlat, float* dctx,
                                               const float* modg  , const float* gpost, bool do_pre, bool skip_add, const float* modp  , const float* gpre) {
    const int gw = F.vcu * NWAVES + F.wave, NGW = F.G * NWAVES;
    bf16* H = (bf16*)(wsptr() + WS_H);
    for (int r = gw; r < M; r += NGW) {
        const int b = r / TOK, p = r - b * TOK, mrow = (p < CTXL ? 8 : b); const float* xr = row_src(b, p, slat, sctx); float* xw = (float*)row_src(b, p, dlat, dctx);
        f32x4 mv[8]; float ss = 0.f;
#pragma unroll
        for (int j = 0; j < 8; ++j) { const int c = 4 * (64 * j + F.lane); const unsigned long long w = *(const unsigned long long*)(mm + (size_t)r * DM + c); const unsigned lo = (unsigned)w, hi = (unsigned)(w >> 32);
            mv[j] = (f32x4){bflo(lo), bfhi(lo), bflo(hi), bfhi(hi)}; ss += (mv[j].x * mv[j].x + mv[j].y * mv[j].y) + (mv[j].z * mv[j].z + mv[j].w * mv[j].w); }
        const float rstd = rsqrtf(wave_sum(ss) * (1.f / DM) + EPS);
        float sx = 0.f;
#pragma unroll
        for (int j = 0; j < 8; ++j) { const int c = 4 * (64 * j + F.lane); const f32x4 xv = *(const f32x4*)(xr + c), gg = *(const f32x4*)(gpost + c), gt = *(const f32x4*)(modg + (size_t)mrow * (6 * DM) + c);
            const f32x4 xn = skip_add ? xv : xv + gt * (mv[j] * rstd * gg); *(f32x4*)(xw + c) = xn; mv[j] = xn; sx += (xn.x * xn.x + xn.y * xn.y) + (xn.z * xn.z + xn.w * xn.w); }
        if (do_pre) {
            const float rs2 = rsqrtf(wave_sum(sx) * (1.f / DM) + EPS);
#pragma unroll
            for (int j = 0; j < 8; ++j) { const int c = 4 * (64 * j + F.lane); const f32x4 gg = *(const f32x4*)(gpre + c), sh = *(const f32x4*)(modp + (size_t)mrow * (6 * DM) + c), sc = *(const f32x4*)(modp + (size_t)mrow * (6 * DM) + DM + c);
                const f32x4 hv = (mv[j] * rs2 * gg) * (1.0f + sc) + sh;
                *(unsigned long long*)(H + (size_t)r * DM + c) = (unsigned long long)pkbf(hv.x, hv.y) | ((unsigned long long)pkbf(hv.z, hv.w) << 32); }
        }
    }
}

__device__ __forceinline__ void rope8(const u32x4v a, const u32x4v b, const float* cs, const float* sn, u32x4v& oa, u32x4v& ob) {
    const f32x4 c0 = *(const f32x4*)cs, c1 = *(const f32x4*)(cs + 4), s0 = *(const f32x4*)sn, s1 = *(const f32x4*)(sn + 4);
    const float x1[8] = {bflo(a.x), bfhi(a.x), bflo(a.y), bfhi(a.y), bflo(a.z), bfhi(a.z), bflo(a.w), bfhi(a.w)};
    const float x2[8] = {bflo(b.x), bfhi(b.x), bflo(b.y), bfhi(b.y), bflo(b.z), bfhi(b.z), bflo(b.w), bfhi(b.w)};
    const float cc[8] = {c0.x, c0.y, c0.z, c0.w, c1.x, c1.y, c1.z, c1.w}, ss[8] = {s0.x, s0.y, s0.z, s0.w, s1.x, s1.y, s1.z, s1.w};
    float o1[8], o2[8];
#pragma unroll
    for (int j = 0; j < 8; ++j) { o1[j] = x1[j] * cc[j] - x2[j] * ss[j]; o2[j] = x2[j] * cc[j] + x1[j] * ss[j]; }
    oa.x = pkbf(o1[0], o1[1]); oa.y = pkbf(o1[2], o1[3]); oa.z = pkbf(o1[4], o1[5]); oa.w = pkbf(o1[6], o1[7]);
    ob.x = pkbf(o2[0], o2[1]); ob.y = pkbf(o2[2], o2[3]); ob.z = pkbf(o2[4], o2[5]); ob.w = pkbf(o2[6], o2[7]);
}
__device__ __forceinline__ void rope_prep_phase(Frame& F) {
    const int gw = F.vcu * NWAVES + F.wave, NGW = F.G * NWAVES, t = F.lane;
    bf16* Zm = (bf16*)(wsptr() + WS_Z); bf16* Kp = (bf16*)(wsptr() + WS_KP);
    const float* rp = (const float*)(wsptr() + WS_ROPE);
    for (int r = gw; r < M; r += NGW) {
        const int b = r / TOK, p = r - b * TOK; bf16* zr = Zm + (size_t)r * ZM_LD; bf16* kr = Kp + (size_t)r * 2048;
        const bool lat = p >= CTXL; const int n = p - CTXL, prow = lat ? (n >> 6) : 0, pcol = lat ? (n & 63) : 0;
        { const int hc = t >> 2, sub = t & 3, rc = sub >> 1, h8 = sub & 1, off = hc * 64 + rc * 32 + h8 * 8, pos = rc ? pcol : prow;
          const float* cs = rp + pos * 16 + h8 * 8; const float* sn = rp + 1024 + pos * 16 + h8 * 8;
          if (lat) { u32x4v a = *(const u32x4v*)(zr + ZB_Q + off), bb = *(const u32x4v*)(zr + ZB_Q + off + 16), oa, ob; rope8(a, bb, cs, sn, oa, ob);
              *(u32x4v*)(zr + ZB_Q + off) = oa; *(u32x4v*)(zr + ZB_Q + off + 16) = ob; }
          u32x4v ka = *(const u32x4v*)(zr + ZB_K + off), kb = *(const u32x4v*)(zr + ZB_K + off + 16), oa = ka, ob = kb;
          if (lat) rope8(ka, kb, cs, sn, oa, ob);
          const int comp = hc & 1, koff = hc * 128 + (comp ? 64 : 0) + rc * 32 + h8 * 8;
          *(u32x4v*)(kr + koff) = oa; *(u32x4v*)(kr + koff + 16) = ob;
          const u32x4v zz = {0u, 0u, 0u, 0u};
#pragma unroll
          for (int i = 0; i < 2; ++i) { const int q = t + 64 * i, hc2 = q >> 3, ch = q & 7; *(u32x4v*)(kr + hc2 * 128 + ((hc2 & 1) ? 0 : 64) + ch * 8) = zz; } }
        if (lat) {
            { const int hd = t >> 3, sub = t & 7, rc = sub >> 2, q8 = sub & 3, off = ZC_Q + hd * 128 + rc * 64 + q8 * 8, pos = rc ? pcol : prow;
              const float* cs = rp + 2048 + pos * 32 + q8 * 8; const float* sn = rp + 4096 + pos * 32 + q8 * 8;
              u32x4v a = *(const u32x4v*)(zr + off), bb = *(const u32x4v*)(zr + off + 32), oa, ob; rope8(a, bb, cs, sn, oa, ob);
              *(u32x4v*)(zr + off) = oa; *(u32x4v*)(zr + off + 32) = ob; }
            if (t < 16) { const int hd = t >> 3, sub = t & 7, rc = sub >> 2, q8 = sub & 3, off = ZC_K + hd * 128 + rc * 64 + q8 * 8, pos = rc ? pcol : prow;
              const float* cs = rp + 2048 + pos * 32 + q8 * 8; const float* sn = rp + 4096 + pos * 32 + q8 * 8;
              u32x4v a = *(const u32x4v*)(zr + off), bb = *(const u32x4v*)(zr + off + 32), oa, ob; rope8(a, bb, cs, sn, oa, ob);
              *(u32x4v*)(zr + off) = oa; *(u32x4v*)(zr + off + 32) = ob; }
        }
    }
}
__device__ __forceinline__ void finish_a_phase(Frame& F, int l) {
    const int gw = F.vcu * NWAVES + F.wave, NGW = F.G * NWAVES;
    const bf16* OF = (const bf16*)(wsptr() + WS_H); const bf16* OB = OF + (size_t)M * BW; const bf16* Zm = (const bf16*)(wsptr() + WS_Z); bf16* BR = (bf16*)(wsptr() + WS_A);
    const float* ng = inptr(12) + (size_t)l * 128;
    for (int it = gw; it < 2 * M; it += NGW) {
        const int r = it >> 1, hh = it & 1, col = (hh * 4 + (F.lane >> 4)) * 128 + (F.lane & 15) * 8, e0 = (F.lane & 15) * 8;
        const u32x4v a = *(const u32x4v*)(OF + (size_t)r * BW + col), bb = *(const u32x4v*)(OB + (size_t)r * BW + col), gz = *(const u32x4v*)(Zm + (size_t)r * ZM_LD + ZA_G + col);
        float o[8] = {bflo(a.x) + bflo(bb.x), bfhi(a.x) + bfhi(bb.x), bflo(a.y) + bflo(bb.y), bfhi(a.y) + bfhi(bb.y), bflo(a.z) + bflo(bb.z), bfhi(a.z) + bfhi(bb.z), bflo(a.w) + bflo(bb.w), bfhi(a.w) + bfhi(bb.w)};
        const float g[8] = {bflo(gz.x), bfhi(gz.x), bflo(gz.y), bfhi(gz.y), bflo(gz.z), bfhi(gz.z), bflo(gz.w), bfhi(gz.w)};
        float ss = 0.f;
#pragma unroll
        for (int j = 0; j < 8; ++j) ss += o[j] * o[j];
        ss += __shfl_xor(ss, 1); ss += __shfl_xor(ss, 2); ss += __shfl_xor(ss, 4); ss += __shfl_xor(ss, 8);
        const float rstd = rsqrtf(ss * (1.f / 128.f) + EPS);
        const f32x4 n0 = *(const f32x4*)(ng + e0), n1 = *(const f32x4*)(ng + e0 + 4); const float nn[8] = {n0.x, n0.y, n0.z, n0.w, n1.x, n1.y, n1.z, n1.w};
#pragma unroll
        for (int j = 0; j < 8; ++j) o[j] = o[j] * rstd * nn[j] * silu_f(g[j]);
        u32x4v w; w.x = pkbf(o[0], o[1]); w.y = pkbf(o[2], o[3]); w.z = pkbf(o[4], o[5]); w.w = pkbf(o[6], o[7]);
        *(u32x4v*)(BR + (size_t)r * BW + col) = w;
    }
}
__device__ __forceinline__ void unpack8(const u32x4v w, float (&f)[8]) { f[0] = bflo(w.x); f[1] = bfhi(w.x); f[2] = bflo(w.y); f[3] = bfhi(w.y); f[4] = bflo(w.z); f[5] = bfhi(w.z); f[6] = bflo(w.w); f[7] = bfhi(w.w); }
__device__ __forceinline__ void conv_act_phase(Frame& F, int l) {
    const bf16* U = (const bf16*)(wsptr() + WS_Z); bf16* ACT = (bf16*)(wsptr() + WS_A);
    const float* cw = inptr(19) + (size_t)l * 3 * UP_LD; const float* cb = inptr(20) + (size_t)l * UP_LD;
    constexpr int NCG = DFF / 8, NRS = M / 16;
    const int gt = F.vcu * NWAVES * 64 + F.tid, NGT = F.G * NWAVES * 64;
    for (int idx = gt; idx < NCG * NRS; idx += NGT) {
        const int rs = idx / NCG, cg = idx - rs * NCG, c = cg * 8, r0 = rs * 16, p0 = r0 % TOK;
        float wa[3][8], wv[3][8], ba[8], bv[8];
#pragma unroll
        for (int k = 0; k < 3; ++k)
#pragma unroll
            for (int h = 0; h < 2; ++h) { const f32x4 t0 = *(const f32x4*)(cw + (size_t)k * UP_LD + c + 4 * h), t1 = *(const f32x4*)(cw + (size_t)k * UP_LD + DFF + c + 4 * h);
                wa[k][4 * h] = t0.x; wa[k][4 * h + 1] = t0.y; wa[k][4 * h + 2] = t0.z; wa[k][4 * h + 3] = t0.w; wv[k][4 * h] = t1.x; wv[k][4 * h + 1] = t1.y; wv[k][4 * h + 2] = t1.z; wv[k][4 * h + 3] = t1.w; }
#pragma unroll
        for (int h = 0; h < 2; ++h) { const f32x4 t0 = *(const f32x4*)(cb + c + 4 * h), t1 = *(const f32x4*)(cb + DFF + c + 4 * h);
            ba[4 * h] = t0.x; ba[4 * h + 1] = t0.y; ba[4 * h + 2] = t0.z; ba[4 * h + 3] = t0.w; bv[4 * h] = t1.x; bv[4 * h + 1] = t1.y; bv[4 * h + 2] = t1.z; bv[4 * h + 3] = t1.w; }
        float pa[8], pv[8], ca[8], cv[8], na[8], nv[8];
        const u32x4v zz = {0u, 0u, 0u, 0u};
        { const bool ok = (p0 != 0) && (p0 != CTXL); const bf16* up = U + (size_t)(ok ? r0 - 1 : r0) * UP_LD + c; u32x4v x = *(const u32x4v*)up, y = *(const u32x4v*)(up + DFF); if (!ok) { x = zz; y = zz; } unpack8(x, pa); unpack8(y, pv); }
        { const bf16* up = U + (size_t)r0 * UP_LD + c; unpack8(*(const u32x4v*)up, ca); unpack8(*(const u32x4v*)(up + DFF), cv); }
        for (int i = 0; i < 16; ++i) {
            const int r = r0 + i, p = p0 + i; const bool ok = (p != CTXL - 1) && (p != TOK - 1);
            { const bf16* up = U + (size_t)(ok ? r + 1 : r) * UP_LD + c; u32x4v x = *(const u32x4v*)up, y = *(const u32x4v*)(up + DFF); if (!ok) { x = zz; y = zz; } unpack8(x, na); unpack8(y, nv); }
            float o[8];
#pragma unroll
            for (int j = 0; j < 8; ++j) { const float a = pa[j] * wa[0][j] + ca[j] * wa[1][j] + na[j] * wa[2][j] + ba[j], v = pv[j] * wv[0][j] + cv[j] * wv[1][j] + nv[j] * wv[2][j] + bv[j];
                o[j] = silu_f(a) * v; pa[j] = ca[j]; pv[j] = cv[j]; ca[j] = na[j]; cv[j] = nv[j]; }
            u32x4v w; w.x = pkbf(o[0], o[1]); w.y = pkbf(o[2], o[3]); w.z = pkbf(o[4], o[5]); w.w = pkbf(o[6], o[7]);
            *(u32x4v*)(ACT + (size_t)r * DFF + c) = w;
        }
    }
}

namespace hg {
constexpr int QT = 0, KT = 17408, QH = 34816, KHT = 52224, VT = 70656, PP = 79872, ST = 89088, SEG = 106496, DEC = 108544, END = 109056;
constexpr int LDR = 272, LDS_ = 144;
__device__ __forceinline__ int tok_of(int dir, int i) { return dir == 0 ? i : (i < CTXL ? (CTXL - 1 - i) : (TOK + CTXL - 1 - i)); }
}
__device__ __forceinline__ void hgrn_unit(Frame& F, int l, int unit) {
    using namespace hg;
    const int b = unit >> 5, h = (unit >> 2) & 7, dir = (unit >> 1) & 1, eh = unit & 1;
    LAS unsigned char* L = F.lds;
    const int tid = F.tid, lane = F.lane, w = F.wave, l15 = lane & 15, kq = lane >> 4;
    const int d = tid & 127, tq = tid >> 7;
    const bf16* Zb = (const bf16*)(wsptr() + WS_Z) + (size_t)b * TOK * ZM_LD;
    bf16* Od = (bf16*)(wsptr() + WS_H) + (size_t)dir * M * BW + (size_t)b * TOK * BW + h * 128 + eh * 64;
    const float lbv = ((const float*)(wsptr() + WS_LB))[((size_t)dir * NL + l) * 1024 + h * 128 + d], oml = 1.0f - lbv;
    const int cq = ZA_Q + h * 128 + d, cf = (dir ? ZA_FB : ZA_FF) + h * 128 + d;
    const int vs = tid >> 3, ve8 = (tid & 7) * 8, cv = ZA_V + h * 128 + eh * 64 + ve8;
    for (int i = tid; i < 64 * LDR / 4; i += NWAVES * 64) ((LAS unsigned*)(L + ST))[i] = 0u;
    f32x4 S[4];
#pragma unroll
    for (int j = 0; j < 4; ++j) S[j] = (f32x4){0.f, 0.f, 0.f, 0.f};
    unsigned short zq[16], zf[16]; u32x4v vv;
#define HG_LOAD(c) do { _Pragma("unroll") for (int i_ = 0; i_ < 16; ++i_) { const bf16* rp_ = Zb + (size_t)tok_of(dir, 64 * (c) + 16 * tq + i_) * ZM_LD; zq[i_] = rp_[cq]; zf[i_] = rp_[cf]; } \
        vv = *(const u32x4v*)(Zb + (size_t)tok_of(dir, 64 * (c) + vs) * ZM_LD + cv); } while (0)
    HG_LOAD(0);
    __syncthreads();
    for (int c = 0; c < TOK / 64; ++c) {
        float bl[16], qv[16], kv[16]; float gsum = 0.f;
#pragma unroll
        for (int i = 0; i < 16; ++i) { const float z = bf2f(zf[i]); const float sg = __builtin_amdgcn_rcpf(1.0f + __expf(-z)); const float f = lbv + oml * sg;
            gsum += __logf(f); bl[i] = gsum; kv[i] = oml * (1.0f - sg); qv[i] = silu_f(bf2f(zq[i])); }
        ((LAS float*)(L + SEG))[tq * 128 + d] = gsum;
        { const unsigned ww[4] = {vv.x, vv.y, vv.z, vv.w};
#pragma unroll
          for (int j = 0; j < 4; ++j) { *(LAS unsigned short*)(L + VT + (ve8 + 2 * j) * LDS_ + vs * 2) = (unsigned short)(ww[j] & 0xffffu); *(LAS unsigned short*)(L + VT + (ve8 + 2 * j + 1) * LDS_ + vs * 2) = (unsigned short)(ww[j] >> 16); } }
        __syncthreads();
        if (c + 1 < TOK / 64) HG_LOAD(c + 1);
        { const LAS float* sg = (const LAS float*)(L + SEG); const float s0 = sg[d], s1 = sg[128 + d], s2 = sg[256 + d], s3 = sg[384 + d];
          const float pre = (tq > 0 ? s0 : 0.f) + (tq > 1 ? s1 : 0.f) + (tq > 2 ? s2 : 0.f), bmid = s0 + s1, bend = (s0 + s1) + (s2 + s3);
          const float cmid = __expf(bmid), cend = __expf(bend - bmid);
          if (tq == 0) ((LAS float*)(L + DEC))[d] = cmid * cend;
          unsigned kh[8];
#pragma unroll
          for (int i = 0; i < 16; ++i) { const int t = 16 * tq + i; const float bb = bl[i] + pre, e1 = __expf(bb - bmid), r1 = __builtin_amdgcn_rcpf(e1);
              const float qt = qv[i] * e1, kt = kv[i] * r1, qh = qt * cmid, kh_ = kt * cend;
              const unsigned pq = pkbf(qt, qh), pk = pkbf(kt, kh_);
              *(LAS unsigned short*)(L + QT + t * LDR + d * 2) = (unsigned short)(pq & 0xffffu); *(LAS unsigned short*)(L + QH + t * LDR + d * 2) = (unsigned short)(pq >> 16);
              *(LAS unsigned short*)(L + KT + t * LDR + d * 2) = (unsigned short)(pk & 0xffffu);
              if (i & 1) kh[i >> 1] |= (pk & 0xffff0000u); else kh[i >> 1] = pk >> 16; }
          *(LAS u32x4v*)(L + KHT + d * LDS_ + tq * 32) = (u32x4v){kh[0], kh[1], kh[2], kh[3]}; *(LAS u32x4v*)(L + KHT + d * LDS_ + tq * 32 + 16) = (u32x4v){kh[4], kh[5], kh[6], kh[7]}; }
        __syncthreads();
        { const int st = w & 3, tt0 = (w >> 2) * 2; bf16x8 a[4];
#pragma unroll
          for (int k = 0; k < 4; ++k) a[k] = *(const LAS bf16x8*)(L + KT + (st * 16 + l15) * LDR + (k * 32 + kq * 8) * 2);
#pragma unroll
          for (int u = 0; u < 2; ++u) { const int tt = tt0 + u; f32x4 acc = (f32x4){0.f, 0.f, 0.f, 0.f};
#pragma unroll
              for (int k = 0; k < 4; ++k) { const bf16x8 bq = *(const LAS bf16x8*)(L + QT + (tt * 16 + l15) * LDR + (k * 32 + kq * 8) * 2); acc = __builtin_amdgcn_mfma_f32_16x16x32_bf16(a[k], bq, acc, 0, 0, 0); }
              const int tabs = tt * 16 + l15, s0 = st * 16 + 4 * kq;
              const float p0 = (s0 + 0 <= tabs) ? acc[0] : 0.f, p1 = (s0 + 1 <= tabs) ? acc[1] : 0.f, p2 = (s0 + 2 <= tabs) ? acc[2] : 0.f, p3 = (s0 + 3 <= tabs) ? acc[3] : 0.f;
              *(LAS unsigned long long*)(L + PP + tabs * LDS_ + s0 * 2) = (unsigned long long)pkbf(p0, p1) | ((unsigned long long)pkbf(p2, p3) << 32); } }
        __syncthreads();
        { const int tt = w & 3, et0 = (w >> 2) * 2;
          bf16x8 bp[2], bqh[4];
#pragma unroll
          for (int k = 0; k < 2; ++k) bp[k] = *(const LAS bf16x8*)(L + PP + (tt * 16 + l15) * LDS_ + (k * 32 + kq * 8) * 2);
#pragma unroll
          for (int k = 0; k < 4; ++k) bqh[k] = *(const LAS bf16x8*)(L + QH + (tt * 16 + l15) * LDR + (k * 32 + kq * 8) * 2);
          const int tproc = 64 * c + tt * 16 + l15; bf16* orow = Od + (size_t)tok_of(dir, tproc) * BW;
#pragma unroll
          for (int u = 0; u < 2; ++u) { const int et = et0 + u; f32x4 acc = (f32x4){0.f, 0.f, 0.f, 0.f};
#pragma unroll
              for (int k = 0; k < 2; ++k) { const bf16x8 av = *(const LAS bf16x8*)(L + VT + (et * 16 + l15) * LDS_ + (k * 32 + kq * 8) * 2); acc = __builtin_amdgcn_mfma_f32_16x16x32_bf16(av, bp[k], acc, 0, 0, 0); }
#pragma unroll
              for (int k = 0; k < 4; ++k) { const bf16x8 as = *(const LAS bf16x8*)(L + ST + (et * 16 + l15) * LDR + (k * 32 + kq * 8) * 2); acc = __builtin_amdgcn_mfma_f32_16x16x32_bf16(as, bqh[k], acc, 0, 0, 0); }
              *(unsigned long long*)(orow + et * 16 + 4 * kq) = (unsigned long long)pkbf(acc[0], acc[1]) | ((unsigned long long)pkbf(acc[2], acc[3]) << 32); } }
        __syncthreads();
        { const LAS float* dc = (const LAS float*)(L + DEC) + 16 * w + 4 * kq; const float d0 = dc[0], d1 = dc[1], d2 = dc[2], d3 = dc[3];
          bf16x8 ak[2];
#pragma unroll
          for (int k = 0; k < 2; ++k) ak[k] = *(const LAS bf16x8*)(L + KHT + (16 * w + l15) * LDS_ + (k * 32 + kq * 8) * 2);
#pragma unroll
          for (int et = 0; et < 4; ++et) { f32x4 acc = S[et]; acc[0] *= d0; acc[1] *= d1; acc[2] *= d2; acc[3] *= d3;
#pragma unroll
              for (int k = 0; k < 2; ++k) { const bf16x8 bv = *(const LAS bf16x8*)(L + VT + (et * 16 + l15) * LDS_ + (k * 32 + kq * 8) * 2); acc = __builtin_amdgcn_mfma_f32_16x16x32_bf16(ak[k], bv, acc, 0, 0, 0); }
              S[et] = acc;
              *(LAS unsigned long long*)(L + ST + (et * 16 + l15) * LDR + (16 * w + 4 * kq) * 2) = (unsigned long long)pkbf(acc[0], acc[1]) | ((unsigned long long)pkbf(acc[2], acc[3]) << 32); } }
        __syncthreads();
    }
#undef HG_LOAD
}

namespace att {
using s16x4  = __attribute__((ext_vector_type(4))) short;
using f32x16 = __attribute__((ext_vector_type(16))) float;
typedef LAS char lchar;
constexpr int SHM_V = 64 * 128 * 2, SHM_K = 64 * 128 * 2, SHM_ATTN = 2 * SHM_V + 2 * SHM_K + NWAVES * 64 * 4  , STASH_OFF = SHM_ATTN, STASH_BYTES = 32 * 512 * 4;
static_assert(STASH_OFF + STASH_BYTES <= RING_BYTES, "attention LDS");
#define KSWZ(row, colB) ((row) * 256 + ((colB) ^ (((row) & 7) << 4)))
#define SBAR() __builtin_amdgcn_sched_barrier(0)
__device__ __forceinline__ int crow(int r, int hi) { return (r & 3) + 8 * (r >> 2) + 4 * hi; }
__device__ __forceinline__ unsigned cvtpk(float lo, float hi) { return pg8::cvt_pk_bf16(lo, hi); }
__device__ __forceinline__ void partialSM(f32x16& p0, f32x16& p1, float& m_reg, float& mn, float& alpha, float C, float thr) {
  float pmax = p0[0];
#pragma unroll
  for (int r = 1; r < 16; ++r) pmax = fmaxf(pmax, p0[r]);
#pragma unroll
  for (int r = 0; r < 16; ++r) pmax = fmaxf(pmax, p1[r]);
  { auto rr = __builtin_amdgcn_permlane32_swap(__float_as_uint(pmax), __float_as_uint(pmax), false, false);
    pmax = fmaxf(__uint_as_float(rr[0]), __uint_as_float(rr[1])); }
  if (__builtin_expect(__all(pmax - m_reg <= thr), 1)) { mn = m_reg; alpha = 1.f; }
  else { mn = fmaxf(m_reg, pmax); alpha = __builtin_amdgcn_exp2f((m_reg - mn) * C); m_reg = mn; }
  float mnC = -mn * C;
#pragma unroll
  for (int r = 0; r < 16; ++r) p0[r] = fmaf(p0[r], C, mnC);
#pragma unroll
  for (int r = 0; r < 16; ++r) p1[r] = fmaf(p1[r], C, mnC);
#pragma unroll
  for (int r = 0; r < 16; ++r) p0[r] = __builtin_amdgcn_exp2f(p0[r]);
}
__device__ __forceinline__ void finishSM(f32x16& p0, f32x16& p1, float alpha, float& l_reg, bf16x8& pa0, bf16x8& pa1, bf16x8& pa2, bf16x8& pa3) {
#pragma unroll
  for (int r = 0; r < 16; ++r) p1[r] = __builtin_amdgcn_exp2f(p1[r]);
  float ps = 0;
#pragma unroll
  for (int r = 0; r < 16; ++r) ps += p0[r];
#pragma unroll
  for (int r = 0; r < 16; ++r) ps += p1[r];
  { auto rr = __builtin_amdgcn_permlane32_swap(__float_as_uint(ps), __float_as_uint(ps), false, false);
    ps = __uint_as_float(rr[0]) + __uint_as_float(rr[1]); }
  l_reg = l_reg * alpha + ps;
#define PK4(P, BASE, OUT) do { unsigned a0 = cvtpk(P[BASE + 0], P[BASE + 1]), a1 = cvtpk(P[BASE + 2], P[BASE + 3]);   \
    unsigned b0 = cvtpk(P[BASE + 4], P[BASE + 5]), b1 = cvtpk(P[BASE + 6], P[BASE + 7]);                              \
    auto r0 = __builtin_amdgcn_permlane32_swap(a0, b0, false, false); auto r1 = __builtin_amdgcn_permlane32_swap(a1, b1, false, false); \
    u32x4v w = {r0[0], r1[0], r0[1], r1[1]}; OUT = *reinterpret_cast<bf16x8*>(&w); } while (0)
  PK4(p0, 0, pa0); PK4(p0, 8, pa1); PK4(p1, 0, pa2); PK4(p1, 8, pa3);
#undef PK4
}
__device__ __forceinline__ void qkt(f32x16& p0, f32x16& p1, const lchar* Ks, const bf16x8* qr, int r32, int hi) {
  p0 = f32x16{}; p1 = f32x16{};
  int A = r32 * 256 + ((hi * 16) ^ ((r32 & 7) << 4)); asm volatile("" : "+v"(A));
#pragma unroll
  for (int d0 = 0; d0 < 8; ++d0) { const int off = A ^ (d0 * 32);
    bf16x8 b0 = *reinterpret_cast<const LAS bf16x8*>(Ks + off);
    bf16x8 b1 = *reinterpret_cast<const LAS bf16x8*>(Ks + off + 8192);
    p0 = __builtin_amdgcn_mfma_f32_32x32x16_bf16(b0, qr[d0], p0, 0, 0, 0);
    p1 = __builtin_amdgcn_mfma_f32_32x32x16_bf16(b1, qr[d0], p1, 0, 0, 0); }
}
__device__ __forceinline__ void mask_tile(f32x16& p0, f32x16& p1, int kp0, int qp, int hi) {
  const int dlt = kp0 - qp;
#pragma unroll
  for (int r = 0; r < 16; ++r) { const int k0 = dlt + crow(r, hi), k1 = k0 + 32;
    p0[r] = (k0 < -128 || k0 > 128) ? -1e30f : p0[r]; p1[r] = (k1 < -128 || k1 > 128) ? -1e30f : p1[r]; }
}
__device__ __forceinline__ int v_st(int k, int c) { const int kk = (k & ~0xC) | ((k & 4) << 1) | ((k & 8) >> 1); return ((kk >> 3) * 4 + (c >> 5)) * 512 + ((kk & 7) * 32 + (c & 31)) * 2; }
__device__ __forceinline__ int v_rd_base(int lane) { return ((lane & 3) << 3) | (((lane >> 2) & 3) << 6) | (((lane >> 4) & 1) << 5) | (((lane >> 5) & 1) << 8); }
constexpr int v_rd_off(int d0, int ks, int half) { return d0 * 512 + ks * 4096 + half * 2048; }
template <int OFF> __device__ __forceinline__ s16x4 tr_read(int vb) {
  s16x4 r; asm volatile("ds_read_b64_tr_b16 %0, %1 offset:%2" : "=&v"(r) : "v"(vb), "i"(OFF) : "memory"); return r;
}
template <int D0> __device__ __forceinline__ void pv_one(f32x16& od, int vb, bf16x8 pa0, bf16x8 pa1, bf16x8 pa2, bf16x8 pa3) {
  const s16x4 l0 = tr_read<v_rd_off(D0, 0, 0)>(vb), h0 = tr_read<v_rd_off(D0, 0, 1)>(vb), l1 = tr_read<v_rd_off(D0, 1, 0)>(vb), h1 = tr_read<v_rd_off(D0, 1, 1)>(vb);
  const s16x4 l2 = tr_read<v_rd_off(D0, 2, 0)>(vb), h2 = tr_read<v_rd_off(D0, 2, 1)>(vb), l3 = tr_read<v_rd_off(D0, 3, 0)>(vb), h3 = tr_read<v_rd_off(D0, 3, 1)>(vb);
  asm volatile("s_waitcnt lgkmcnt(0)" ::: "memory"); SBAR();
#define PK(L, H) (bf16x8){L[0], L[1], L[2], L[3], H[0], H[1], H[2], H[3]}
  od = __builtin_amdgcn_mfma_f32_32x32x16_bf16(pa0, PK(l0, h0), od, 0, 0, 0);
  od = __builtin_amdgcn_mfma_f32_32x32x16_bf16(pa1, PK(l1, h1), od, 0, 0, 0);
  od = __builtin_amdgcn_mfma_f32_32x32x16_bf16(pa2, PK(l2, h2), od, 0, 0, 0);
  od = __builtin_amdgcn_mfma_f32_32x32x16_bf16(pa3, PK(l3, h3), od, 0, 0, 0);
#undef PK
}
__device__ __forceinline__ void pv_d0(f32x16* o, int vb, bf16x8 pa0, bf16x8 pa1, bf16x8 pa2, bf16x8 pa3) {
  pv_one<0>(o[0], vb, pa0, pa1, pa2, pa3); pv_one<1>(o[1], vb, pa0, pa1, pa2, pa3); pv_one<2>(o[2], vb, pa0, pa1, pa2, pa3); pv_one<3>(o[3], vb, pa0, pa1, pa2, pa3);
}
template <int TYPE>
__device__ __forceinline__ void attn_run(const bf16* __restrict__ Qb, const bf16* __restrict__ Kh, const bf16* __restrict__ Vh,
                                         int NT, int gap, int qp, int bs, lchar* lds, f32x16 (&o)[4], float& m_reg, float& l_reg) {
  constexpr int ldq = ZM_LD, ldv = ZM_LD, ldk = TYPE == 0 ? 2048 : ZM_LD; constexpr bool mask = TYPE == 1;
  constexpr float C = (TYPE == 0 ? 0.125f : 0.08838834764831845f) * LOG2E, thr = 8.0f * LOG2E / C;
  int tid = threadIdx.x; asm volatile("" : "+v"(tid));
  const int wid = tid >> 6, lane = tid & 63, r32 = lane & 31, hi = lane >> 5;
  lchar* V_lds = lds; lchar* K_lds = lds + 2 * SHM_V;
  LAS float* wsf = (LAS float*)(lds + 2 * SHM_V + 2 * SHM_K) + wid * 64; LAS float* al_l = wsf + 32;
  m_reg = -1e30f; l_reg = 0.f;
#pragma unroll
  for (int d = 0; d < 4; ++d) o[d] = f32x16{};
  bf16x8 qr[8];
  const unsigned qro = (unsigned)((wid * 32 + r32) * ldq + hi * 8) * 2u;
#pragma unroll
  for (int d0 = 0; d0 < 8; ++d0) qr[d0] = *reinterpret_cast<const bf16x8*>((const char*)Qb + qro + d0 * 32);
  const int sr = tid >> 4, sc = (tid & 15) * 8, vst0 = v_st(sr, sc), kst0 = KSWZ(sr, sc * 2);
  const int vb0 = (int)(unsigned)(uintptr_t)V_lds + v_rd_base(lane);
  const unsigned vro = (unsigned)(sr * ldv + sc) * 2u, kro = (unsigned)(sr * ldk + sc) * 2u;
  bf16x8 vsA0, vsA1, ksA0, ksA1;
#define KOFF(j) (64 * (j) + ((j) >= 4 ? gap : 0))
#define SLOAD(S, j) do { const size_t k0_ = (size_t)KOFF(j); const char* vb_ = (const char*)Vh + k0_ * (size_t)(ldv * 2); const char* kb_ = (const char*)Kh + k0_ * (size_t)(ldk * 2); \
    vs##S##0 = *reinterpret_cast<const bf16x8*>(vb_ + vro); vs##S##1 = *reinterpret_cast<const bf16x8*>(vb_ + (size_t)(32 * ldv * 2) + vro); \
    ks##S##0 = *reinterpret_cast<const bf16x8*>(kb_ + kro); ks##S##1 = *reinterpret_cast<const bf16x8*>(kb_ + (size_t)(32 * ldk * 2) + kro); } while (0)
#define SWRITE(b, S) do { *(LAS bf16x8*)(V_lds + (b) * SHM_V + vst0) = vs##S##0; *(LAS bf16x8*)(V_lds + (b) * SHM_V + vst0 + 8192) = vs##S##1; \
    *(LAS bf16x8*)(K_lds + (b) * SHM_K + kst0) = ks##S##0; *(LAS bf16x8*)(K_lds + (b) * SHM_K + kst0 + 8192) = ks##S##1; } while (0)
#define SWAIT() asm volatile("s_waitcnt vmcnt(0)" ::: "memory")
#define RESC(a) do { if (__any((a) < 1.f)) { if (hi == 0) al_l[r32] = (a); asm volatile("s_waitcnt lgkmcnt(0)" ::: "memory"); \
    _Pragma("unroll") for (int d = 0; d < 4; ++d) _Pragma("unroll") for (int r = 0; r < 16; ++r) o[d][r] *= al_l[crow(r, hi)]; } } while (0)
#define MASKT(P0, P1, j) do { if (mask && (j) >= 4) mask_tile(P0, P1, bs + 64 * ((j) - 4), qp, hi); } while (0)
  f32x16 pA0, pA1, pB0, pB1; float mnA, mnB, alA, alB; bf16x8 pa0, pa1, pa2, pa3;
  SLOAD(A, 0); asm volatile("s_waitcnt vmcnt(0)" ::: "memory"); SWRITE(0, A); __syncthreads();
  qkt(pA0, pA1, K_lds, qr, r32, hi); partialSM(pA0, pA1, m_reg, mnA, alA, C, thr);
  SLOAD(A, 1);
  SWAIT(); SWRITE(1, A); __syncthreads();
  for (int j = 1; j + 1 < NT; j += 2) {
    SBAR(); qkt(pB0, pB1, K_lds + SHM_K, qr, r32, hi); MASKT(pB0, pB1, j);
    finishSM(pA0, pA1, alA, l_reg, pa0, pa1, pa2, pa3); SBAR();
    SLOAD(A, j + 1); SBAR();
    pv_d0(o, vb0, pa0, pa1, pa2, pa3); partialSM(pB0, pB1, m_reg, mnB, alB, C, thr);
    __syncthreads(); SWAIT(); SWRITE(0, A);
    RESC(alB); __syncthreads();
    SBAR(); qkt(pA0, pA1, K_lds, qr, r32, hi); MASKT(pA0, pA1, j + 1);
    finishSM(pB0, pB1, alB, l_reg, pa0, pa1, pa2, pa3); SBAR();
    SLOAD(A, j + 2); SBAR();
    pv_d0(o, vb0 + SHM_V, pa0, pa1, pa2, pa3); partialSM(pA0, pA1, m_reg, mnA, alA, C, thr);
    __syncthreads(); SWAIT(); SWRITE(1, A);
    RESC(alA); __syncthreads();
  }
  SBAR(); qkt(pB0, pB1, K_lds + SHM_K, qr, r32, hi); MASKT(pB0, pB1, NT - 1);
  finishSM(pA0, pA1, alA, l_reg, pa0, pa1, pa2, pa3); SBAR();
  pv_d0(o, vb0, pa0, pa1, pa2, pa3); partialSM(pB0, pB1, m_reg, mnB, alB, C, thr);
  __syncthreads(); RESC(alB);
  finishSM(pB0, pB1, alB, l_reg, pa0, pa1, pa2, pa3); SBAR();
  pv_d0(o, vb0 + SHM_V, pa0, pa1, pa2, pa3);
  (void)mnA; (void)mnB;
#undef KOFF
#undef SLOAD
#undef SWRITE
#undef SWAIT
#undef RESC
#undef MASKT
}
}

template <int TYPE>
__device__ __forceinline__ void attn_unit(Frame& F, int l, int bh, int qb) {
  using namespace att;
  lchar* lds = (lchar*)F.lds;
  const int tid = F.tid, wid = tid >> 6, lane = tid & 63, r32 = lane & 31, hi = lane >> 5;
  LAS float* li_l = (LAS float*)(lds + 2 * SHM_V + 2 * SHM_K) + wid * 64;
  LAS unsigned* stash = (LAS unsigned*)(lds + STASH_OFF);
  const int b = bh >> 3, hd = bh & 7;
  const size_t row0 = (size_t)b * TOK, rowq = row0 + (qb < 0 ? 0 : CTXL + 256 * qb);
  constexpr float C = (TYPE == 0 ? 0.125f : 0.08838834764831845f) * LOG2E;
#pragma unroll 1
  for (int pass = 0; pass < (TYPE == 0 ? 2 : 1); ++pass) {
    const bf16* Zm = (const bf16*)(wsptr() + WS_Z);
    const bf16 *Q, *K, *V; int NT, gap = 0, bs = 0;
    if (TYPE == 0) { Q = Zm + rowq * ZM_LD + ZB_Q + hd * 128; K = (const bf16*)(wsptr() + WS_KP) + row0 * 2048 + (hd * 2 + pass) * 128; V = Zm + row0 * ZM_LD + ZB_V + hd * 128; NT = qb < 0 ? 4 : TOK / 64; }
    else { const int g = hd >> 2; Q = Zm + rowq * ZM_LD + ZC_Q + hd * 128; K = Zm + row0 * ZM_LD + ZC_K + g * 128; V = Zm + row0 * ZM_LD + ZC_V + g * 128;
      if (qb < 0) NT = 4; else { bs = 256 * qb - 128; if (bs < 0) bs = 0; int be = 256 * qb + 384; if (be > SEQ) be = SEQ; NT = 4 + (be - bs) / 64; gap = bs; } }
    const int qp = 256 * qb + wid * 32 + r32;
    f32x16 o[4]; float m_reg, l_reg;
    attn_run<TYPE>(Q, K, V, NT, gap, qp, bs, lds, o, m_reg, l_reg);
    if (TYPE == 1) { const float sk = inptr(15)[l * 8 + hd]; l_reg += __builtin_amdgcn_exp2f(sk * LOG2E - m_reg * C); }
    if (hi == 0) li_l[r32] = l_reg;
    asm volatile("s_waitcnt lgkmcnt(0)" ::: "memory");
#pragma unroll
    for (int r = 0; r < 16; ++r) { const float rl = __builtin_amdgcn_rcpf(li_l[crow(r, hi)]);
#pragma unroll
      for (int d0 = 0; d0 < 4; ++d0) o[d0][r] *= rl; }
    if (TYPE == 0 && pass == 0) {
#pragma unroll
      for (int d0 = 0; d0 < 4; ++d0)
#pragma unroll
        for (int r = 0; r < 16; r += 2) stash[(d0 * 8 + (r >> 1)) * 512 + tid] = cvtpk(o[d0][r], o[d0][r + 1]);
    } else {
      __syncthreads();
      lchar* SG = lds + wid * 8192;
      if (TYPE == 0) { const float lam = ((const float*)(wsptr() + WS_LAM))[l];
#pragma unroll
        for (int d0 = 0; d0 < 4; ++d0)
#pragma unroll
          for (int r = 0; r < 16; r += 2) { const unsigned w = stash[(d0 * 8 + (r >> 1)) * 512 + tid]; o[d0][r] = bflo(w) - lam * o[d0][r]; o[d0][r + 1] = bfhi(w) - lam * o[d0][r + 1]; } }
#pragma unroll
      for (int r = 0; r < 16; ++r)
#pragma unroll
        for (int d0 = 0; d0 < 4; ++d0) *(LAS unsigned short*)(SG + crow(r, hi) * 256 + (d0 * 32 + r32) * 2) = (unsigned short)(cvtpk(o[d0][r], o[d0][r]) & 0xffffu);
      asm volatile("s_waitcnt lgkmcnt(0)" ::: "memory");
      const int cc = lane & 15;
      bf16* Ow = (bf16*)(wsptr() + WS_A) + (size_t)(TYPE == 0 ? 1 : 2) * M * BW + (rowq + wid * 32 + (lane >> 4)) * BW + hd * 128 + cc * 8;
      float gsc[8];
      if (TYPE == 0) { const float linit = 0.8f - 0.6f * __expf(-0.3f * (float)l); const float* sg = inptr(14) + (size_t)l * 128 + cc * 8;
#pragma unroll
        for (int j = 0; j < 8; ++j) gsc[j] = sg[j] * (1.0f - linit); }
#pragma unroll
      for (int i = 0; i < 8; ++i) {
        u32x4v v = *(const LAS u32x4v*)(SG + ((lane >> 4) + 4 * i) * 256 + cc * 16);
        if (TYPE == 0) { float f[8]; unpack8(v, f); float ss = 0.f;
#pragma unroll
          for (int j = 0; j < 8; ++j) ss += f[j] * f[j];
          ss += __shfl_xor(ss, 1); ss += __shfl_xor(ss, 2); ss += __shfl_xor(ss, 4); ss += __shfl_xor(ss, 8);
          const float rs = rsqrtf(ss * (1.f / 128.f) + EPS);
#pragma unroll
          for (int j = 0; j < 8; ++j) f[j] *= rs * gsc[j];
          v.x = cvtpk(f[0], f[1]); v.y = cvtpk(f[2], f[3]); v.z = cvtpk(f[4], f[5]); v.w = cvtpk(f[6], f[7]); }
        *(u32x4v*)(Ow + (size_t)(4 * i) * BW) = v;
      }
    }
    __syncthreads();
  }
}
__device__ __forceinline__ void attn_units(Frame& F, int l) {
#pragma unroll 1
  for (int k = 0; k < 5; ++k) {
    int bh, qb;
    if (k < 4) { const int U = k * 256 + F.vcu; bh = U >> 4; qb = U & 15; } else { if (F.vcu >= 64) break; bh = F.vcu; qb = -1; }
#ifndef NO_AT0
    attn_unit<0>(F, l, bh, qb);
#endif
  }
#pragma unroll 1
  for (int k = 0; k < 5; ++k) {
    int bh, qb;
    if (k < 4) { const int U = k * 256 + F.vcu; bh = U >> 4; qb = U & 15; } else { if (F.vcu < 64 || F.vcu >= 128) break; bh = F.vcu - 64; qb = -1; }
#ifndef NO_AT1
    attn_unit<1>(F, l, bh, qb);
#endif
  }
}

struct Args { const float* in[22]; float* out; unsigned char* ws; };
__global__ void __launch_bounds__(NWAVES * 64, 2) mk_fwd(Args args) {
    extern __shared__ __attribute__((aligned(16))) unsigned char lds[];
    LAS unsigned char* const ldsb = (LAS unsigned char*)lds;
    for (int u = threadIdx.x; u < (LDS_BYTES - LDSCTL_OFF) / 4; u += NWAVES * 64) ((LAS unsigned*)(ldsb + LDSCTL_OFF))[u] = 0u;
    __syncthreads();
    (void)xcd_barrier_post((unsigned*)(wsptr() + WS_CTL) + CW_BAR, (volatile LAS unsigned*)(ldsb + MISC_OFF) + 8);
#define GRID_BAR() do { XcdBarrier b_; b_.bar = (unsigned*)(wsptr() + WS_CTL) + CW_BAR; b_.x = xb_xcc_id(); b_.st = (volatile LAS unsigned*)(ldsb + MISC_OFF) + 8; xcd_barrier(b_); } while (0)
#define FRAME() Frame F = mkframe(ldsb)
#define H    ((bf16*)(wsptr() + WS_H))
#define Zm   ((bf16*)(wsptr() + WS_Z))
#define Zg   ((bf16*)(wsptr() + WS_ZG))
#define BR   ((bf16*)(wsptr() + WS_A))
#define M2   ((bf16*)(wsptr() + WS_M2))
#define CX   ((float*)(wsptr() + WS_CX))
#define MIX  ((float*)(wsptr() + WS_Z))
#define UP   ((bf16*)(wsptr() + WS_Z))
#define ACT  ((bf16*)(wsptr() + WS_A))
#define mod  ((const float*)(wsptr() + WS_MOD))
#define WinT ((bf16*)(wsptr() + WS_W + W_IN))
#define WbT  ((bf16*)(wsptr() + WS_W + W_BR))
#define WoT  ((bf16*)(wsptr() + WS_W + W_OUT))
#define WupT ((bf16*)(wsptr() + WS_W + W_UP))
#define WdT  ((bf16*)(wsptr() + WS_W + W_DN))

    #ifndef NO_PRO
    { FRAME(); prologue_small(F); __syncthreads(); convert_weights(F, 0); }
#endif
    GRID_BAR();
#ifndef NO_NORM
    { FRAME(); prenorm_phase(F, 0, inptr(0), inptr(2)); }
#endif
    GRID_BAR();

    for (int l = 0; l < NL; ++l) {
#if !DBG_NO_MIX
#ifndef NO_G0
        { FRAME(); pg8::Gemm g{H, WinT, M, NIN, DM, 0, 0}; pg8::StaticOrder S; S.init(M, NIN, F.G, (int)blockIdx.x);
          pg8::EpiZ E{Zm, Zg};
          pg8::gemm_phase<pg8::EpiZ, pg8::StaticOrder, true, true>(F.lds, g, S, E); }
#endif
        GRID_BAR();
#ifndef NO_ROPE
        { FRAME(); rope_prep_phase(F); }
#endif
        GRID_BAR();
#if !DBG_NO_HGRN
        { FRAME(); hgrn_unit(F, l, F.vcu); __syncthreads(); }
#else
        { FRAME(); const int gt = F.vcu * 512 + F.tid; u32x4v* p = (u32x4v*)(wsptr() + WS_H); for (size_t i = gt; i < (size_t)M * DM * 2 / 16; i += 256 * 512) p[i] = (u32x4v){0u, 0u, 0u, 0u}; }
#endif
#if !DBG_NO_ATTN
        { FRAME(); attn_units(F, l); }
#else
        { FRAME(); const int gt = F.vcu * 512 + F.tid; u32x4v* p = (u32x4v*)(wsptr() + WS_A + (size_t)M * BW * 2); for (size_t i = gt; i < (size_t)2 * M * BW * 2 / 16; i += 256 * 512) p[i] = (u32x4v){0u, 0u, 0u, 0u}; }
#endif
        GRID_BAR();
#ifndef NO_FINA
        { FRAME(); finish_a_phase(F, l); }
#endif
        GRID_BAR();
#ifndef NO_G1
        { FRAME(); pg8::Gemm g{BR, WbT, M, DM, BW, (size_t)M * BW * 2, (size_t)DM * BW * 2}; pg8::MergeOrder S; S.base.init(M, DM, F.G, (int)blockIdx.x);
          pg8::EpiMerge E{Zg, MIX, H};
          pg8::gemm_phase<pg8::EpiMerge, pg8::MergeOrder, true, true>(F.lds, g, S, E); }
#endif
        GRID_BAR();
#ifndef NO_G2
        { FRAME(); pg8::Gemm g{H, WoT, M, DM, DM, 0, 0}; pg8::StaticOrder S; S.init(M, DM, F.G, (int)blockIdx.x);
          pg8::EpiBf16<0> E{M2, DM, nullptr, 0, 0, 1.f};
          pg8::gemm_phase<pg8::EpiBf16<0>, pg8::StaticOrder, true, true>(F.lds, g, S, E); }
#endif
        GRID_BAR();
#endif
        { FRAME(); const float* ml = mod + (size_t)l * 9 * (6 * DM);
          post_pre_phase(F, M2, l == 0 ? inptr(0) : outptr(), l == 0 ? inptr(2) : CX, outptr(), CX, ml + 2 * DM, inptr(7) + (size_t)l * DM, true, DBG_NO_MIX != 0, ml + 3 * DM, inptr(8) + (size_t)l * DM); }
        GRID_BAR();
#ifndef NO_G3
        { FRAME(); pg8::Gemm g{H, WupT, M, UP_LD, DM, 0, 0}; pg8::StaticOrder S; S.init(M, UP_LD, F.G, (int)blockIdx.x);
          pg8::EpiBf16<0> E{UP, UP_LD, nullptr, 0, 0, 1.f};
          pg8::gemm_phase<pg8::EpiBf16<0>, pg8::StaticOrder, true, true>(F.lds, g, S, E); }
#endif
        GRID_BAR();
#ifndef NO_CONV
        { FRAME(); conv_act_phase(F, l); }
#endif
        GRID_BAR();
#ifndef NO_G4
        { FRAME(); pg8::Gemm g{ACT, WdT, M, DM, DFF, 0, 0}; pg8::StaticOrder S; S.init(M, DM, F.G, (int)blockIdx.x);
          pg8::EpiBf16<0> E{M2, DM, nullptr, 0, 0, 1.f};
          pg8::gemm_phase<pg8::EpiBf16<0>, pg8::StaticOrder, true, true>(F.lds, g, S, E); }
#endif
        GRID_BAR();
        { FRAME(); const float* ml = mod + (size_t)l * 9 * (6 * DM); const int ln = (l + 1 < NL) ? l + 1 : l; const float* mn = mod + (size_t)ln * 9 * (6 * DM);
          post_pre_phase(F, M2, outptr(), CX, outptr(), CX, ml + 5 * DM, inptr(9) + (size_t)l * DM, l + 1 < NL, DBG_NO_FFN != 0, mn, inptr(6) + (size_t)ln * DM);
          if (l + 1 < NL) { __syncthreads(); convert_weights(F, l + 1); } }
        GRID_BAR();
    }
#undef GRID_BAR
#undef FRAME
#undef H
#undef Zm
#undef Zg
#undef BR
#undef M2
#undef CX
#undef MIX
#undef UP
#undef ACT
#undef mod
#undef WinT
#undef WbT
#undef WoT
#undef WupT
#undef WdT
}

extern "C" void kernel_launch(void* const* d_in, const int* in_sizes, int n_in, void* d_out, int out_size, void* d_ws, size_t ws_size, hipStream_t stream) {
    static int grid = 0;
    if (grid == 0) {
        if (n_in != 22 || in_sizes[0] != NB * SEQ * DM || out_size != NB * SEQ * DM || ws_size < WS_END) {
            fprintf(stderr, "kernel_launch: shape mismatch: n_in %d in0 %d out %d ws %zu (need %zu); nothing launched\n", n_in, n_in > 0 ? in_sizes[0] : -1, out_size, ws_size, (size_t)WS_END); grid = -1; return; }
        int dev = 0, cus = 0;
        if (hipGetDevice(&dev) != hipSuccess || hipDeviceGetAttribute(&cus, hipDeviceAttributeMultiprocessorCount, dev) != hipSuccess) { fprintf(stderr, "kernel_launch: device query failed\n"); grid = -1; return; }
        if (hipFuncSetAttribute((const void*)mk_fwd, hipFuncAttributeMaxDynamicSharedMemorySize, LDS_BYTES) != hipSuccess) { fprintf(stderr, "kernel_launch: hipFuncSetAttribute failed\n"); grid = -1; return; }
        int per_cu = 0;
        if (hipOccupancyMaxActiveBlocksPerMultiprocessor(&per_cu, (const void*)mk_fwd, NWAVES * 64, LDS_BYTES) != hipSuccess || per_cu < 1)
            fprintf(stderr, "kernel_launch: note: occupancy query reports %d workgroups per CU\n", per_cu);
        (void)hipGetLastError();
        if (cus < 256) { fprintf(stderr, "kernel_launch: needs 256 CUs (one resident workgroup each), device has %d; nothing launched\n", cus); grid = -1; return; }
        grid = 256;
    }
    if (grid < 0) return;
    if (hipMemsetAsync((char*)d_ws + WS_CTL, 0, CTL_ZERO_BYTES, stream) != hipSuccess) { fprintf(stderr, "kernel_launch: memset failed\n"); return; }
    Args a{};
    for (int i = 0; i < 22; ++i) a.in[i] = (const float*)d_in[i];
    a.out = (float*)d_out; a.ws = (unsigned char*)d_ws;
    hipLaunchKernelGGL(mk_fwd, dim3(grid), dim3(NWAVES * 64), LDS_BYTES, stream, a);
    const hipError_t le = hipPeekAtLastError();
    if (le != hipSuccess) fprintf(stderr, "kernel_launch: launch failed: %s\n", hipGetErrorName(le));
}
```

```cpp
#include <hip/hip_runtime.h>
#include <cstdio>
#include <cstdint>
#ifndef PROBE_CLASS
#define PROBE_CLASS 0
#endif
#ifndef DBG_NO_MIX
#define DBG_NO_MIX 0
#endif
#ifndef DBG_NO_HGRN
#define DBG_NO_HGRN 0
#endif
#ifndef DBG_NO_ATTN
#define DBG_NO_ATTN 0
#endif
#ifndef DBG_NO_FFN
#define DBG_NO_FFN 0
#endif
namespace pg8 {
#define PG8_LAS __attribute__((address_space(3)))
typedef unsigned short bf16_t;
typedef short bf16x8 __attribute__((ext_vector_type(8)));
typedef float f32x4 __attribute__((ext_vector_type(4)));
typedef unsigned u32x4 __attribute__((ext_vector_type(4)));
typedef int i32x4 __attribute__((ext_vector_type(4)));
typedef int i32x8 __attribute__((ext_vector_type(8)));
constexpr int BM = 256, BK = 64, HALF = 128, HTB = HALF * BK * 2  , STAGE_BYTES = 8 * HTB, NXCD = 8;

__host__ __device__ __forceinline__ int lds_byte(int r, int c) { const int st = (r >> 4) * 2 + (c >> 5), rr = r & 15, cc = c & 31, ob = rr * 64 + cc * 2; return st * 1024 + (ob ^ (((ob >> 9) & 1) << 5)); }
__host__ __device__ __forceinline__ void stage_rc(int b, int& R, int& C) { const int st = b / 1024, sb = b % 1024, swz = sb ^ (((sb >> 9) & 1) << 5); R = (st >> 1) * 16 + swz / 64; C = (st & 1) * 32 + (swz % 64) / 2; }
__host__ __device__ __forceinline__ int perm32(int rho) { const int n = rho >> 4, i = rho & 15; return 8 * (i >> 2) + 4 * n + (i & 3); }

struct Unit { int pm, pn, kz; };
struct Gemm { const bf16_t* A; const bf16_t* Bt; int M, N, K; size_t kzA, kzB; };

struct StaticOrder {
    int nM, nN, nwg, G, c, WGM;
    __host__ __device__ void init(int M, int N, int G_, int c_, int wgm = 4) { nM = M / BM; nN = N / BM; nwg = nM * nN; G = G_; c = c_; WGM = wgm; }
    __host__ __device__ bool next(int i, Unit& u) const { return at((long)i * G + c, u); }
    __host__ __device__ bool at(long L, Unit& u) const {
        if (L >= nwg) return false;
        int wgid = (int)L; { const int q = nwg / NXCD, r = nwg % NXCD, xcd = wgid % NXCD, off = wgid / NXCD; wgid = (xcd < r ? xcd * (q + 1) : r * (q + 1) + (xcd - r) * q) + off; }
        const int nig = WGM * nN, gid = wgid / nig, fm = gid * WGM, gsz = (nM - fm) < WGM ? (nM - fm) : WGM;
        u.pm = fm + ((wgid % nig) % gsz); u.pn = (wgid % nig) / gsz; u.kz = 0; return true;
    }
    __device__ __forceinline__ void a_ready(const Unit&) const {}
    __device__ __forceinline__ void done(const Unit&) const {}
};

struct SubOrder {
    StaticOrder base; int lo, hi;
    __device__ __forceinline__ bool next(int i, Unit& u) const { const long L = (long)lo + (long)i * base.G + base.c; if (L >= hi) return false; return base.at(L, u); }
    __device__ __forceinline__ void a_ready(const Unit&) const {}
    __device__ __forceinline__ void done(const Unit&) const {}
};

typedef float f32x2c_t __attribute__((ext_vector_type(2))); typedef __bf16 bf16x2c_t __attribute__((ext_vector_type(2)));
__device__ __forceinline__ unsigned cvt_pk_bf16(float lo, float hi) { f32x2c_t v = {lo, hi}; bf16x2c_t b = __builtin_convertvector(v, bf16x2c_t); return __builtin_bit_cast(unsigned, b); }
typedef float f32x2 __attribute__((ext_vector_type(2)));
__device__ __forceinline__ f32x2 gelu_pk(f32x2 v) {
    const f32x2 av = __builtin_elementwise_abs(v), d = av * 0.2316418882f + 1.0f;
    f32x2 t; t.x = __builtin_amdgcn_rcpf(d.x); t.y = __builtin_amdgcn_rcpf(d.y);
    f32x2 q = t * 0.5307027145f + (-0.7265760135f); q = q * t + 0.7107068705f; q = q * t + (-0.142248368f); q = q * t + 0.127414796f; q = q * t;
    const f32x2 s = (v * v) * (-0.72134752044f);
    f32x2 e; e.x = __builtin_amdgcn_exp2f(s.x); e.y = __builtin_amdgcn_exp2f(s.y);
    const f32x2 m = v * (q * e), r = v - m;
    f32x2 o; o.x = v.x < 0.f ? m.x : r.x; o.y = v.y < 0.f ? m.y : r.y; return o;
}

template <int ACT  > struct EpiBf16 {
    static constexpr bool PERM = true, AFTER_DRAIN = false; static_assert(ACT == 0 || ACT == 1, "EpiBf16: ACT is 0 (none) or 1 (gelu_pk)");
    bf16_t* O; int ldc; const float* bias; int split_cols; size_t split_stride; float scale0;
    __device__ __forceinline__ void operator()(const f32x4 (&acc)[2][2][4][2], const Unit& u, int wr, int wc, int fr, int fq) const {
        const int row0 = u.pm * BM + wr * 64 + fr; int colt = u.pn * BM; bf16_t* base = O;
        float sc = 1.f; if (split_cols) { const int t = colt / split_cols; base += (size_t)t * split_stride; colt -= t * split_cols; if (t == 0) sc = scale0; }
        const int col0 = colt + wc * 32 + 8 * fq, bcol0 = u.pn * BM + wc * 32 + 8 * fq;
        f32x4 bv[2][2];
#pragma unroll
        for (int bj = 0; bj < 2; ++bj)
#pragma unroll
            for (int n = 0; n < 2; ++n) bv[bj][n] = bias ? *(const f32x4*)(bias + bcol0 + bj * HALF + 4 * n) : (f32x4){0.f, 0.f, 0.f, 0.f};
#pragma unroll
        for (int ai = 0; ai < 2; ++ai)
#pragma unroll
            for (int m = 0; m < 4; ++m) { bf16_t* rowp = base + (size_t)(row0 + ai * HALF + m * 16) * ldc + col0;
#pragma unroll
                for (int bj = 0; bj < 2; ++bj) { f32x4 v0 = acc[ai][bj][m][0] + bv[bj][0], v1 = acc[ai][bj][m][1] + bv[bj][1];
                    if (ACT == 1) { f32x2 a = gelu_pk((f32x2){v0[0], v0[1]}), b = gelu_pk((f32x2){v0[2], v0[3]}), c = gelu_pk((f32x2){v1[0], v1[1]}), d = gelu_pk((f32x2){v1[2], v1[3]});
                        v0 = (f32x4){a.x, a.y, b.x, b.y}; v1 = (f32x4){c.x, c.y, d.x, d.y}; }
                    v0 = v0 * sc; v1 = v1 * sc; u32x4 w; w.x = cvt_pk_bf16(v0[0], v0[1]); w.y = cvt_pk_bf16(v0[2], v0[3]); w.z = cvt_pk_bf16(v1[0], v1[1]); w.w = cvt_pk_bf16(v1[2], v1[3]);
                    *(u32x4*)(rowp + bj * HALF) = w; } }
    }
};


__device__ __forceinline__ float sigmoid_f(float x) { return __builtin_amdgcn_rcpf(1.0f + __expf(-x)); }
__device__ __forceinline__ f32x4 ld_sc1_f32x4(const float* p) { f32x4 v; asm volatile("global_load_dwordx4 %0, %1, off sc1\n\ts_waitcnt vmcnt(0)" : "=v"(v) : "v"(p) : "memory"); return v; }
struct EpiZ {
    static constexpr bool PERM = true, AFTER_DRAIN = false;
    bf16_t* Zm; bf16_t* Zg; const float* rp; const float* lbl;
    __device__ __forceinline__ void operator()(const f32x4 (&acc)[2][2][4][2], const Unit& u, int wr, int wc, int fr, int fq) const {
        const int row0 = u.pm * BM + wr * 64 + fr;
        const bool mainz = u.pn < 38; bf16_t* base = mainz ? Zm : Zg; const int ldc = mainz ? 9728 : 6144; const int colt = (mainz ? u.pn : u.pn - 38) * BM;
        const int col0 = colt + wc * 32 + 8 * fq;
        const bool ropeb = (u.pn >= 20) && (u.pn < 28), ropec = (u.pn >= 32) && (u.pn < 37), rope = ropeb || ropec;
        const float sgn = fq < 2 ? -1.0f : 1.0f;
        const int tab = ropeb ? 0 : 2048, tsn = ropeb ? 1024 : 2048, tpitch = ropeb ? 16 : 32, ti = (ropeb ? 0 : 16 * (wc & 1)) + 8 * (fq & 1);
        const bool colpart = ropeb ? (wc & 1) : (wc >> 1);
#pragma unroll
        for (int ai = 0; ai < 2; ++ai)
#pragma unroll
            for (int m = 0; m < 4; ++m) { const int r = row0 + ai * HALF + m * 16; bf16_t* rowp = base + (size_t)r * ldc + col0;
                f32x4 cs0 = {1.f, 1.f, 1.f, 1.f}, cs1 = cs0, sn0 = {0.f, 0.f, 0.f, 0.f}, sn1 = sn0;
                if (rope) { const int bb = r / 4352, p = r - bb * 4352;
                    if (p >= 256) { const int n = p - 256, pos = colpart ? (n & 63) : (n >> 6); const float* t = rp + tab + pos * tpitch + ti;
                        cs0 = *(const f32x4*)t; cs1 = *(const f32x4*)(t + 4); sn0 = *(const f32x4*)(t + tsn) * sgn; sn1 = *(const f32x4*)(t + tsn + 4) * sgn; } }
#pragma unroll
                for (int bj = 0; bj < 2; ++bj) { f32x4 v0 = acc[ai][bj][m][0], v1 = acc[ai][bj][m][1];
                    if (u.pn < 4) {
#pragma unroll
                        for (int j = 0; j < 4; ++j) { v0[j] = v0[j] * sigmoid_f(v0[j]); v1[j] = v1[j] * sigmoid_f(v1[j]); } }
                    if (u.pn >= 4 && u.pn < 12) {
                        const int cc = colt + wc * 32 + 8 * fq + bj * HALF - 1024, dir = cc >> 10; const float* lp = lbl + dir * (4 * 1024) + (cc & 1023);
                        const f32x4 l0 = *(const f32x4*)lp, l1 = *(const f32x4*)(lp + 4);
#pragma unroll
                        for (int j = 0; j < 4; ++j) { v0[j] = l0[j] + (1.0f - l0[j]) * sigmoid_f(v0[j]); v1[j] = l1[j] + (1.0f - l1[j]) * sigmoid_f(v1[j]); } }
                    if (rope) { f32x4 p0, p1;
#pragma unroll
                        for (int j = 0; j < 4; ++j) { p0[j] = __shfl_xor(v0[j], 32); p1[j] = __shfl_xor(v1[j], 32); }
                        v0 = v0 * cs0 + p0 * sn0; v1 = v1 * cs1 + p1 * sn1; }
                    u32x4 w; w.x = cvt_pk_bf16(v0[0], v0[1]); w.y = cvt_pk_bf16(v0[2], v0[3]); w.z = cvt_pk_bf16(v1[0], v1[1]); w.w = cvt_pk_bf16(v1[2], v1[3]);
                    *(u32x4*)(rowp + bj * HALF) = w; } }
    }
};
struct EpiG {
    static constexpr bool PERM = true, AFTER_DRAIN = false;
    bf16_t* Zg; float sc;
    __device__ __forceinline__ void operator()(const f32x4 (&acc)[2][2][4][2], const Unit& u, int wr, int wc, int fr, int fq) const {
        const int row0 = u.pm * BM + wr * 64 + fr, col0 = u.pn * BM + wc * 32 + 8 * fq;
#pragma unroll
        for (int ai = 0; ai < 2; ++ai)
#pragma unroll
            for (int m = 0; m < 4; ++m) { bf16_t* rowp = Zg + (size_t)(row0 + ai * HALF + m * 16) * 6144 + col0;
#pragma unroll
                for (int bj = 0; bj < 2; ++bj) { const f32x4 v0 = acc[ai][bj][m][0] * sc, v1 = acc[ai][bj][m][1] * sc;
                    u32x4 w; w.x = cvt_pk_bf16(v0[0], v0[1]); w.y = cvt_pk_bf16(v0[2], v0[3]); w.z = cvt_pk_bf16(v1[0], v1[1]); w.w = cvt_pk_bf16(v1[2], v1[3]);
                    *(u32x4*)(rowp + bj * HALF) = w; } }
    }
};
struct EpiMerge {
    static constexpr bool PERM = true, AFTER_DRAIN = false;
    const bf16_t* Zg; bf16_t* out;
    __device__ __forceinline__ void operator()(const f32x4 (&acc)[2][2][4][2], const Unit& u, int wr, int wc, int fr, int fq) const {
        const int row0 = u.pm * BM + wr * 64 + fr, col0 = u.pn * BM + wc * 32 + 8 * fq, n = u.kz;
        u32x4 gA0, gA1, pA0 = {0u, 0u, 0u, 0u}, pA1 = pA0, gB0, gB1, pB0 = pA0, pB1 = pA0;
#define EM_LOAD(HP, S, AI, MM) do { const size_t row_ = (size_t)(row0 + (AI) * HALF + (MM) * 16); const bf16_t* gp_ = Zg + row_ * 6144 + (size_t)n * 2048 + col0; const bf16_t* op_ = out + row_ * 2048 + col0; \
        asm volatile("global_load_dwordx4 %0, %1, off" : "=v"(g##S##0) : "v"(gp_) : "memory"); asm volatile("global_load_dwordx4 %0, %1, off offset:256" : "=v"(g##S##1) : "v"(gp_) : "memory"); \
        if (HP) { asm volatile("global_load_dwordx4 %0, %1, off sc1" : "=v"(p##S##0) : "v"(op_) : "memory"); asm volatile("global_load_dwordx4 %0, %1, off offset:256 sc1" : "=v"(p##S##1) : "v"(op_) : "memory"); } } while (0)
#define EM_WAIT(HP, S, LASTG) do { if (HP) { if (LASTG) asm volatile("s_waitcnt vmcnt(0)" : "+v"(g##S##0), "+v"(g##S##1), "+v"(p##S##0), "+v"(p##S##1) :: "memory"); \
                                              else asm volatile("s_waitcnt vmcnt(4)" : "+v"(g##S##0), "+v"(g##S##1), "+v"(p##S##0), "+v"(p##S##1) :: "memory"); } \
        else { if (LASTG) asm volatile("s_waitcnt vmcnt(0)" : "+v"(g##S##0), "+v"(g##S##1) :: "memory"); else asm volatile("s_waitcnt vmcnt(2)" : "+v"(g##S##0), "+v"(g##S##1) :: "memory"); } } while (0)
#define EM_PROC(HP, S, AI, MM) do { const size_t row_ = (size_t)(row0 + (AI) * HALF + (MM) * 16); bf16_t* op_ = out + row_ * 2048 + col0; \
        _Pragma("unroll") for (int bj = 0; bj < 2; ++bj) { const u32x4 gw = bj ? g##S##1 : g##S##0, pp = bj ? p##S##1 : p##S##0; \
            f32x4 g0, g1; \
            g0[0] = sigmoid_f(__uint_as_float(gw.x << 16)); g0[1] = sigmoid_f(__uint_as_float(gw.x & 0xffff0000u)); \
            g0[2] = sigmoid_f(__uint_as_float(gw.y << 16)); g0[3] = sigmoid_f(__uint_as_float(gw.y & 0xffff0000u)); \
            g1[0] = sigmoid_f(__uint_as_float(gw.z << 16)); g1[1] = sigmoid_f(__uint_as_float(gw.z & 0xffff0000u)); \
            g1[2] = sigmoid_f(__uint_as_float(gw.w << 16)); g1[3] = sigmoid_f(__uint_as_float(gw.w & 0xffff0000u)); \
            f32x4 v0 = acc[AI][bj][MM][0] * g0, v1 = acc[AI][bj][MM][1] * g1; \
            if (HP) { v0[0] += __uint_as_float(pp.x << 16); v0[1] += __uint_as_float(pp.x & 0xffff0000u); v0[2] += __uint_as_float(pp.y << 16); v0[3] += __uint_as_float(pp.y & 0xffff0000u); \
                      v1[0] += __uint_as_float(pp.z << 16); v1[1] += __uint_as_float(pp.z & 0xffff0000u); v1[2] += __uint_as_float(pp.w << 16); v1[3] += __uint_as_float(pp.w & 0xffff0000u); } \
            u32x4 w; w.x = cvt_pk_bf16(v0[0], v0[1]); w.y = cvt_pk_bf16(v0[2], v0[3]); w.z = cvt_pk_bf16(v1[0], v1[1]); w.w = cvt_pk_bf16(v1[2], v1[3]); \
            *(u32x4*)(op_ + bj * HALF) = w; } \
        asm volatile("" ::: "memory"); } while (0)
#define EM_SEQ(HP) do { \
        EM_LOAD(HP, A, 0, 0); \
        EM_LOAD(HP, B, 0, 1); EM_WAIT(HP, A, 0); EM_PROC(HP, A, 0, 0); \
        EM_LOAD(HP, A, 0, 2); EM_WAIT(HP, B, 0); EM_PROC(HP, B, 0, 1); \
        EM_LOAD(HP, B, 0, 3); EM_WAIT(HP, A, 0); EM_PROC(HP, A, 0, 2); \
        EM_LOAD(HP, A, 1, 0); EM_WAIT(HP, B, 0); EM_PROC(HP, B, 0, 3); \
        EM_LOAD(HP, B, 1, 1); EM_WAIT(HP, A, 0); EM_PROC(HP, A, 1, 0); \
        EM_LOAD(HP, A, 1, 2); EM_WAIT(HP, B, 0); EM_PROC(HP, B, 1, 1); \
        EM_LOAD(HP, B, 1, 3); EM_WAIT(HP, A, 0); EM_PROC(HP, A, 1, 2); \
        EM_WAIT(HP, B, 1); EM_PROC(HP, B, 1, 3); } while (0)
        if (n > 0) EM_SEQ(1); else EM_SEQ(0);
#undef EM_SEQ
#undef EM_LOAD
#undef EM_WAIT
#undef EM_PROC
    }
};
struct RowOrder {
    StaticOrder base; int lat;
    __device__ __forceinline__ void init(int N, int lat_, int G, int c, int wgm = 4) { lat = lat_; base.init(lat_ ? 32768 : 34816, N, G, c, wgm); }
    __device__ __forceinline__ bool next(int i, Unit& u) const { if (!base.next(i, u)) return false; if (lat) u.pm += u.pm / 16 + 1; return true; }
    __device__ __forceinline__ void a_ready(const Unit&) const {}
    __device__ __forceinline__ void done(const Unit&) const {}
};
struct MergeOrder {
    RowOrder base;
    __device__ __forceinline__ bool next(int i, Unit& u) const { const int ti = i / 3; if (!base.next(ti, u)) return false; u.kz = i - 3 * ti; return true; }
    __device__ __forceinline__ void a_ready(const Unit&) const {}
    __device__ __forceinline__ void done(const Unit&) const {}
};


template <int CTRL> __device__ __forceinline__ float dppf(float old, float src) { return __builtin_bit_cast(float, __builtin_amdgcn_update_dpp(__builtin_bit_cast(int, old), __builtin_bit_cast(int, src), CTRL, 0xf, 0xf, false)); }
__device__ __forceinline__ f32x4 row_next(const f32x4 cur, const f32x4 nreg) {
    f32x4 r;
#pragma unroll
    for (int e = 0; e < 4; ++e) { const float y = dppf<0x11F>(0.f, nreg[e]); r[e] = dppf<0x101>(y, cur[e]); }
    return r; }
__device__ __forceinline__ f32x4 row_prev(const f32x4 cur, const f32x4 preg) {
    f32x4 r;
#pragma unroll
    for (int e = 0; e < 4; ++e) { const float y = dppf<0x10F>(0.f, preg[e]); r[e] = dppf<0x111>(y, cur[e]); }
    return r; }
struct EpiConv {
    static constexpr bool PERM = true, AFTER_DRAIN = false;
    bf16_t* ACT; float* SB; const float* cw; const float* cb;
    __device__ __forceinline__ void operator()(const f32x4 (&acc)[2][2][4][2], const Unit& u, int wr, int wc, int fr, int fq) const {
        const int ch0 = u.pn * 128 + wc * 32 + 8 * fq; const f32x4 z4 = {0.f, 0.f, 0.f, 0.f};
#pragma unroll
        for (int n = 0; n < 2; ++n) { const int ch = ch0 + 4 * n;
            const f32x4 wa0 = *(const f32x4*)(cw + ch), wa1 = *(const f32x4*)(cw + 11264 + ch), wa2 = *(const f32x4*)(cw + 22528 + ch), ba = *(const f32x4*)(cb + ch);
            const f32x4 wv0 = *(const f32x4*)(cw + 5632 + ch), wv1 = *(const f32x4*)(cw + 11264 + 5632 + ch), wv2 = *(const f32x4*)(cw + 22528 + 5632 + ch), bv = *(const f32x4*)(cb + 5632 + ch);
#pragma unroll
            for (int ai = 0; ai < 2; ++ai) { const int gb = 4 * u.pm + 2 * ai + wr;
#pragma unroll
                for (int m = 0; m < 4; ++m) {
                    const f32x4 A = acc[ai][0][m][n], V = acc[ai][1][m][n];
                    const f32x4 An = m < 3 ? acc[ai][0][m < 3 ? m + 1 : 3][n] : z4, Ap = m > 0 ? acc[ai][0][m > 0 ? m - 1 : 0][n] : z4;
                    const f32x4 Vn = m < 3 ? acc[ai][1][m < 3 ? m + 1 : 3][n] : z4, Vp = m > 0 ? acc[ai][1][m > 0 ? m - 1 : 0][n] : z4;
                    const f32x4 cA = wa0 * row_prev(A, Ap) + wa1 * A + wa2 * row_next(A, An) + ba;
                    const f32x4 cV = wv0 * row_prev(V, Vp) + wv1 * V + wv2 * row_next(V, Vn) + bv;
                    const bool e0 = (m == 0) && (fr == 0), e1 = (m == 3) && (fr == 15);
                    if (e0 || e1) { float* sb = SB + ((size_t)(gb * 2 + (e1 ? 1 : 0)) * 4) * 5632 + ch;
                        *(f32x4*)sb = A; *(f32x4*)(sb + 5632) = V; *(f32x4*)(sb + 2 * 5632) = cA; *(f32x4*)(sb + 3 * 5632) = cV; }
                    else { f32x4 o;
#pragma unroll
                        for (int e2 = 0; e2 < 4; ++e2) o[e2] = cA[e2] * sigmoid_f(cA[e2]) * cV[e2];
                        *(unsigned long long*)(ACT + (size_t)(64 * gb + 16 * m + fr) * 5632 + ch) = (unsigned long long)cvt_pk_bf16(o[0], o[1]) | ((unsigned long long)cvt_pk_bf16(o[2], o[3]) << 32); } } } }
    }
};

template <class Epi, class Sched, bool ALIGN_EPI = false, bool SP2 = false, bool FP8 = false>
__device__ __forceinline__ void gemm_phase(PG8_LAS unsigned char* lds, const Gemm g, const Sched& S, const Epi& E) {
    int tid = threadIdx.x; asm volatile("" : "+v"(tid));
    const int wid = __builtin_amdgcn_readfirstlane(tid >> 6), lane = tid & 63, wr = wid >> 2, wc = wid & 3, fr = lane & 15, fq = lane >> 4;
    const int K = g.K, nt = K / BK;
    unsigned voffA[2], voffB[2];
#pragma unroll
    for (int i = 0; i < 2; ++i) { int R, C; stage_rc(tid * 16 + i * 8192, R, C); const int Rb = Epi::PERM ? ((R & ~31) + perm32(R & 31)) : R;
        voffA[i] = (unsigned)(R * K + C) * 2u; voffB[i] = (unsigned)(Rb * K + C) * 2u; }
    const size_t kstep = (size_t)(BK * 2);
    const size_t hstep = (size_t)HALF * K * 2;
    const size_t tstep = 2 * hstep;
    const unsigned ldsw = (unsigned)wid * 1024u;
    const int aoff = lds_byte(wr * 64 + fr, fq * 8), boff = lds_byte(wc * 32 + fr, fq * 8);
#define PG8_SA(b, h) (((b) * 2 + (h)) * HTB)
#define PG8_SB(b, h) ((4 + (b) * 2 + (h)) * HTB)
#define PG8_STAGE(bufoff, gbase, voff) do { _Pragma("unroll") for (int _i = 0; _i < 2; ++_i) \
        __builtin_amdgcn_global_load_lds((const unsigned*)((const char*)(gbase) + (voff)[_i]), (PG8_LAS unsigned*)(lds + (bufoff) + ldsw + _i * 8192), 16, 0, 0); } while (0)
#define PG8_LD2(p) __builtin_shufflevector(*(const PG8_LAS i32x4*)(p), *(const PG8_LAS i32x4*)((p) + 1024), 0, 1, 2, 3, 4, 5, 6, 7)
#define PG8_LDA(dst, b, h) do { _Pragma("unroll") for (int m = 0; m < 4; ++m) dst[m] = PG8_LD2(lds + PG8_SA(b, h) + aoff + m * 2048); } while (0)
#define PG8_LDB(dst, b, h) do { _Pragma("unroll") for (int n = 0; n < 2; ++n) dst[n] = PG8_LD2(lds + PG8_SB(b, h) + boff + n * 2048); } while (0)
#define PG8_LOH(v) __builtin_bit_cast(bf16x8, __builtin_shufflevector(v, v, 0, 1, 2, 3))
#define PG8_HIH(v) __builtin_bit_cast(bf16x8, __builtin_shufflevector(v, v, 4, 5, 6, 7))
#define PG8_MMA(ai, bj, At, Bt) do { __builtin_amdgcn_s_setprio(1); \
        if constexpr (FP8) { _Pragma("unroll") for (int m = 0; m < 4; ++m) _Pragma("unroll") for (int n = 0; n < 2; ++n) \
            asm("v_mfma_scale_f32_16x16x128_f8f6f4 %0, %1, %2, %0, %3, %3 op_sel_hi:[0,0,0]" : "+v"(acc[ai][bj][m][n]) : "v"(Bt[n]), "v"(At[m]), "v"(sc8)); } \
        else { _Pragma("unroll") for (int m = 0; m < 4; ++m) _Pragma("unroll") for (int n = 0; n < 2; ++n) { \
            acc[ai][bj][m][n] = __builtin_amdgcn_mfma_f32_16x16x32_bf16(PG8_LOH(Bt[n]), PG8_LOH(At[m]), acc[ai][bj][m][n], 0, 0, 0); \
            acc[ai][bj][m][n] = __builtin_amdgcn_mfma_f32_16x16x32_bf16(PG8_HIH(Bt[n]), PG8_HIH(At[m]), acc[ai][bj][m][n], 0, 0, 0); } } \
        __builtin_amdgcn_s_setprio(0); } while (0)
#define PG8_WAIT_V(n) asm volatile("s_waitcnt vmcnt(" #n ")" ::: "memory")
#define PG8_WAIT_L(n) asm volatile("s_waitcnt lgkmcnt(" #n ")" ::: "memory")
#define PG8_BAR __builtin_amdgcn_s_barrier()
#define PG8_SCHED __builtin_amdgcn_sched_barrier(0)
    Unit cur, nxt; int ui = 0;
    if (!S.next(0, cur)) return;
    f32x4 acc[2][2][4][2];
#pragma unroll
    for (int a = 0; a < 2; ++a)
#pragma unroll
        for (int b = 0; b < 2; ++b)
#pragma unroll
            for (int m = 0; m < 4; ++m)
#pragma unroll
                for (int n = 0; n < 2; ++n) acc[a][b][m][n] = (f32x4){0.f, 0.f, 0.f, 0.f};
    const int sc8 = 0x7F7F7F7F;
    i32x8 At[4], B0[2], B1[2];
    const char* cA = (const char*)g.A + (size_t)cur.pm * tstep + (size_t)cur.kz * g.kzA; const char* cB = (const char*)g.Bt + (size_t)cur.pn * tstep + (size_t)cur.kz * g.kzB;
    S.a_ready(cur);
    if constexpr (SP2) {
        PG8_STAGE(PG8_SB(0, 0), cB, voffB); PG8_STAGE(PG8_SB(0, 1), cB + hstep, voffB); PG8_STAGE(PG8_SA(0, 0), cA, voffA); PG8_STAGE(PG8_SA(0, 1), cA + hstep, voffA);
        if (wr == 1) PG8_BAR;
        PG8_WAIT_V(2); PG8_BAR;
        PG8_STAGE(PG8_SB(1, 0), cB + kstep, voffB); PG8_STAGE(PG8_SA(1, 0), cA + kstep, voffA); PG8_STAGE(PG8_SB(1, 1), cB + hstep + kstep, voffB);
        PG8_WAIT_V(6); PG8_BAR;
    } else {
        PG8_STAGE(PG8_SB(0, 0), cB, voffB); PG8_STAGE(PG8_SA(0, 0), cA, voffA); PG8_STAGE(PG8_SB(0, 1), cB + hstep, voffB); PG8_STAGE(PG8_SA(0, 1), cA + hstep, voffA);
        if (wr == 1) PG8_BAR;
        PG8_WAIT_V(4); PG8_BAR;
        PG8_STAGE(PG8_SB(1, 0), cB + kstep, voffB); PG8_STAGE(PG8_SA(1, 0), cA + kstep, voffA); PG8_STAGE(PG8_SB(1, 1), cB + hstep + kstep, voffB);
        PG8_WAIT_V(6); PG8_BAR;
    }
    for (;;) {
        const bool has_next = S.next(ui + 1, nxt);
        const char* nA = has_next ? (const char*)g.A + (size_t)nxt.pm * tstep + (size_t)nxt.kz * g.kzA : cA; const char* nB = has_next ? (const char*)g.Bt + (size_t)nxt.pn * tstep + (size_t)nxt.kz * g.kzB : cB;
        for (int t = 0; t < nt; t += 2) {
            const bool last = (t == nt - 2);
            const char* a1 = cA + (size_t)(t + 1) * kstep;
            const char* a2 = last ? nA : cA + (size_t)(t + 2) * kstep; const char* b2 = last ? nB : cB + (size_t)(t + 2) * kstep;
            const char* a3 = a2 + kstep; const char* b3 = b2 + kstep;
            if (last && has_next) S.a_ready(nxt);
            if constexpr (SP2) {
            PG8_LDB(B0, 0, 0); PG8_LDB(B1, 0, 1); PG8_SCHED; PG8_LDA(At, 0, 0); PG8_STAGE(PG8_SA(1, 1), a1 + hstep, voffA);
            PG8_WAIT_V(8); PG8_WAIT_L(0); PG8_BAR; PG8_MMA(0, 0, At, B0); PG8_MMA(0, 1, At, B1); PG8_BAR; PG8_SCHED;
            PG8_LDA(At, 0, 1); PG8_STAGE(PG8_SB(0, 0), b2, voffB); PG8_STAGE(PG8_SB(0, 1), b2 + hstep, voffB); PG8_STAGE(PG8_SA(0, 0), a2, voffA);
            PG8_WAIT_V(8); PG8_WAIT_L(0); PG8_BAR; PG8_MMA(1, 0, At, B0); PG8_MMA(1, 1, At, B1); PG8_BAR; PG8_SCHED;
            PG8_LDB(B0, 1, 0); PG8_LDB(B1, 1, 1); PG8_SCHED; PG8_LDA(At, 1, 0); PG8_STAGE(PG8_SA(0, 1), a2 + hstep, voffA);
            PG8_WAIT_V(8); PG8_WAIT_L(0); PG8_BAR; PG8_MMA(0, 0, At, B0); PG8_MMA(0, 1, At, B1); PG8_BAR; PG8_SCHED;
            PG8_LDA(At, 1, 1); PG8_STAGE(PG8_SB(1, 0), b3, voffB); PG8_STAGE(PG8_SB(1, 1), b3 + hstep, voffB); PG8_STAGE(PG8_SA(1, 0), a3, voffA);
            PG8_WAIT_V(8); PG8_WAIT_L(0); PG8_BAR; PG8_MMA(1, 0, At, B0); PG8_MMA(1, 1, At, B1); PG8_BAR; PG8_SCHED;
            } else {
            PG8_LDB(B0, 0, 0); PG8_SCHED; PG8_LDA(At, 0, 0); PG8_STAGE(PG8_SA(1, 1), a1 + hstep, voffA);
            PG8_WAIT_L(8); PG8_BAR; PG8_WAIT_L(0); PG8_MMA(0, 0, At, B0); PG8_BAR; PG8_SCHED;
            PG8_LDB(B1, 0, 1); PG8_STAGE(PG8_SB(0, 0), b2, voffB);
            PG8_BAR; PG8_WAIT_L(0); PG8_MMA(0, 1, At, B1); PG8_BAR;
            PG8_LDA(At, 0, 1); PG8_STAGE(PG8_SA(0, 0), a2, voffA);
            PG8_BAR; PG8_WAIT_L(0); PG8_MMA(1, 0, At, B0); PG8_BAR; PG8_SCHED;
            PG8_STAGE(PG8_SB(0, 1), b2 + hstep, voffB);
            PG8_WAIT_V(6); PG8_BAR; PG8_MMA(1, 1, At, B1); PG8_BAR;
            PG8_LDB(B0, 1, 0); PG8_SCHED; PG8_LDA(At, 1, 0); PG8_STAGE(PG8_SA(0, 1), a2 + hstep, voffA);
            PG8_WAIT_L(8); PG8_BAR; PG8_WAIT_L(0); PG8_MMA(0, 0, At, B0); PG8_BAR; PG8_SCHED;
            PG8_LDB(B1, 1, 1); PG8_STAGE(PG8_SB(1, 0), b3, voffB);
            PG8_BAR; PG8_WAIT_L(0); PG8_MMA(0, 1, At, B1); PG8_BAR;
            PG8_LDA(At, 1, 1); PG8_STAGE(PG8_SA(1, 0), a3, voffA);
            PG8_BAR; PG8_WAIT_L(0); PG8_MMA(1, 0, At, B0); PG8_BAR; PG8_SCHED;
            PG8_STAGE(PG8_SB(1, 1), b3 + hstep, voffB);
            PG8_WAIT_V(6); PG8_BAR; PG8_MMA(1, 1, At, B1); PG8_BAR;
            }
        }
        if constexpr (ALIGN_EPI) { if (wr == 0) PG8_BAR; }
        if constexpr (FP8) asm volatile("s_nop 15\n\ts_nop 15" ::: "memory");
        if constexpr (!Epi::AFTER_DRAIN) { E(acc, cur, wr, wc, fr, fq); S.done(cur); }
        if (!has_next) break;
#pragma unroll
        for (int a = 0; a < 2; ++a)
#pragma unroll
            for (int b = 0; b < 2; ++b)
#pragma unroll
                for (int m = 0; m < 4; ++m)
#pragma unroll
                    for (int n = 0; n < 2; ++n) acc[a][b][m][n] = (f32x4){0.f, 0.f, 0.f, 0.f};
        cur = nxt; cA = nA; cB = nB; ++ui;
        if constexpr (ALIGN_EPI) { if (wr == 1) PG8_BAR; }
    }
    PG8_WAIT_V(0);
    if constexpr (!ALIGN_EPI) { if (wr == 0) PG8_BAR; }
    PG8_BAR;
    if constexpr (Epi::AFTER_DRAIN) { E.fused(acc, cur, wr, wc, fr, fq, lds, wid, lane); S.done(cur); }
#undef PG8_SA
#undef PG8_SB
#undef PG8_STAGE
#undef PG8_LDA
#undef PG8_LDB
#undef PG8_MMA
#undef PG8_LOH
#undef PG8_HIH
#undef PG8_LD2
#undef PG8_WAIT_V
#undef PG8_WAIT_L
#undef PG8_BAR
#undef PG8_SCHED
}
}


#define GAS __attribute__((address_space(1)))
#define LAS __attribute__((address_space(3)))
typedef unsigned short bf16;
typedef unsigned v4u __attribute__((ext_vector_type(4)));
typedef float f32x4 __attribute__((ext_vector_type(4)));
typedef short bf16x8 __attribute__((ext_vector_type(8)));
typedef GAS unsigned gu32;
typedef GAS unsigned long long gu64;
#define RLX_AGENT __ATOMIC_RELAXED, __HIP_MEMORY_SCOPE_AGENT
#define LDS_WAIT() asm volatile("s_waitcnt lgkmcnt(0)" ::: "memory")
#define VM_WAIT() asm volatile("s_waitcnt vmcnt(0)" ::: "memory")
__device__ __forceinline__ unsigned long long rt() { return __builtin_amdgcn_s_memrealtime(); }
__device__ __forceinline__ unsigned f2bf(float f) { unsigned u = __builtin_bit_cast(unsigned, f); return (u + 0x7fffu + ((u >> 16) & 1u)) >> 16; }
__device__ __forceinline__ unsigned pk2(float lo, float hi) { return f2bf(lo) | (f2bf(hi) << 16); }

#define XB_TMO      128
#define XB_XCNT(j)  (256  + 64 * (j))
#define XB_XSUB(j)  (1280 + 64 * (j))
#define XB_XGEN(j)  (2304 + 64 * (j))
#define XB_TOP      3328
#define XB_TOPGEN   3392
#define XCD_BAR_WORDS 3456
#define XB_SPIN_CAP (1u << 18)

__device__ __forceinline__ unsigned xb_ld(unsigned* p)              { return __hip_atomic_load(p, __ATOMIC_RELAXED, __HIP_MEMORY_SCOPE_AGENT); }
__device__ __forceinline__ unsigned xb_add(unsigned* p, unsigned v) { return __hip_atomic_fetch_add(p, v, __ATOMIC_RELAXED, __HIP_MEMORY_SCOPE_AGENT); }
__device__ __forceinline__ unsigned xb_xcc_id() { return (unsigned)__builtin_amdgcn_s_getreg((3 << 11) | 20) & 0xFu; }
#define XB_SPIN(cond, bar) do { unsigned _sp = 0; while (cond) { __builtin_amdgcn_s_sleep(1); \
    if ((++_sp & 255u) == 0u) { if (xb_ld(&(bar)[XB_TMO])) break; if (_sp > XB_SPIN_CAP) { atomicAdd(&(bar)[XB_TMO], 1u); break; } } } } while (0)

struct XcdBarrier {
    unsigned* bar; unsigned x;
    volatile LAS unsigned* st;
};

__device__ __forceinline__ XcdBarrier xcd_barrier_post(unsigned* bar, volatile LAS unsigned* st) {
    XcdBarrier b; b.bar = bar; b.x = xb_xcc_id(); b.st = st;
    if (threadIdx.x == 0) (void)xb_add(&bar[XB_XCNT(b.x)], 1u);
    return b;
}
__device__ __forceinline__ void xcd_barrier_complete(unsigned* bar, unsigned x, unsigned& nloc, unsigned& nx) {
    const unsigned G = gridDim.x * gridDim.y * gridDim.z;
    unsigned sum, cnt, mine, sp = 0u;
    for (;;) {
        sum = 0u; cnt = 0u; mine = 0u;
#pragma unroll
        for (unsigned j = 0; j < 16; ++j) { const unsigned c = xb_ld(&bar[XB_XCNT(j)]); sum += c; cnt += (c > 0u) ? 1u : 0u; mine = (j == x) ? c : mine; }
        if (sum == G) break;
        __builtin_amdgcn_s_sleep(1);
        if ((++sp & 255u) == 0u) { if (xb_ld(&bar[XB_TMO])) break; if (sp > XB_SPIN_CAP) { atomicAdd(&bar[XB_TMO], 1u); break; } }
    }
    nloc = mine > 0u ? mine : 1u; nx = cnt > 0u ? cnt : 1u;
}

__device__ __forceinline__ void xcd_barrier(const XcdBarrier& b) {
    asm volatile("s_waitcnt vmcnt(0)" ::: "memory");
    __syncthreads();
    if (threadIdx.x == 0) {
        unsigned* bar = b.bar;
        __builtin_amdgcn_s_waitcnt(0);
        unsigned nloc = b.st[0], nx = b.st[1];
        if (nloc == 0u) { xcd_barrier_complete(bar, b.x, nloc, nx); b.st[0] = nloc; b.st[1] = nx; }
        const unsigned old = xb_add(&bar[XB_XSUB(b.x)], 1u);
        const unsigned gen = old / nloc;
        if (old + 1u == (gen + 1u) * nloc) {
            __builtin_amdgcn_fence(__ATOMIC_RELEASE, "agent");
            asm volatile("s_waitcnt vmcnt(0)" ::: "memory");
            const unsigned og = xb_add(&bar[XB_TOP], 1u);
            const unsigned tg = og / nx;
            if (og + 1u == (tg + 1u) * nx) xb_add(&bar[XB_TOPGEN], 1u);
            else XB_SPIN(xb_ld(&bar[XB_TOPGEN]) == tg, bar);
            __builtin_amdgcn_fence(__ATOMIC_ACQUIRE, "agent");
            xb_add(&bar[XB_XGEN(b.x)], 1u);
            asm volatile("s_waitcnt vmcnt(0)" ::: "memory");
        } else {
            XB_SPIN(xb_ld(&bar[XB_XGEN(b.x)]) == gen, bar);
            __builtin_amdgcn_fence(__ATOMIC_ACQUIRE, "agent");
            asm volatile("s_waitcnt vmcnt(0)" ::: "memory");
        }
    }
    __syncthreads();
}


typedef unsigned u32x4v __attribute__((ext_vector_type(4)));
constexpr int NWAVES = 8, GRID_C = 256;
constexpr int NB = 8, SEQ = 4096, CTXL = 256, TOK = SEQ + CTXL, M = NB * TOK, DM = 2048, NL = 4;
constexpr int ZM_LD = 9728, ZG_LD = 6144, NIN = 15872, DFF = 5632, UP_LD = 2 * DFF, BW = 1024;
constexpr int ZA_Q = 0, ZA_FF = 1024, ZA_FB = 2048, ZA_V = 3072, ZA_G = 4096, ZB_Q = 5120, ZB_K = 6144, ZB_V = 7168, ZC_Q = 8192, ZC_K = 9216, ZC_V = 9472;
constexpr float EPS = 1e-6f, LOG2E = 1.4426950408889634f;
constexpr size_t MiB = 1u << 20;
constexpr size_t WS_CTL = 0, CTL_ZERO_BYTES = 1 * MiB;
constexpr size_t WS_MOD = 1 * MiB;
constexpr size_t WS_LB = 3 * MiB;
constexpr size_t WS_LAM = 3 * MiB + 65536;
constexpr size_t WS_ROPE = 3 * MiB + 131072;
constexpr size_t WS_W = 5 * MiB;
constexpr size_t W_IN = 0, W_BR = 62 * MiB, W_OUT = 74 * MiB, W_UP = 82 * MiB, W_DN = 126 * MiB;
constexpr size_t WS_Z = 153 * MiB;
constexpr size_t WS_ZG = WS_Z + 646 * MiB;
constexpr size_t WS_H = 1207 * MiB;
constexpr size_t WS_A = 1343 * MiB;
constexpr size_t WS_KP = WS_A + 204 * MiB;
constexpr size_t WS_H8 = WS_KP;
constexpr size_t W_G8 = (size_t)9728 * 2048 * 2;
constexpr float H8_SCALE = 16.0f, W8_SCALE = 512.0f;
constexpr size_t WS_M2 = 1717 * MiB;
constexpr size_t WS_CX = 1853 * MiB;
constexpr size_t WS_END = 1869 * MiB;
static_assert((size_t)M * ZM_LD * 2 == 646 * MiB && (size_t)M * ZG_LD * 2 == 408 * MiB && (size_t)M * DM * 2 == 136 * MiB && (size_t)3 * M * BW * 2 == 204 * MiB && (size_t)M * DFF * 2 == 374 * MiB, "ws map");
static_assert((size_t)NIN * DM * 2 == 62 * MiB && (size_t)UP_LD * DM * 2 == 44 * MiB && (size_t)DM * DFF * 2 == 22 * MiB, "w map");
constexpr int G8_LATE = 4 * (GRID_C / 2);
constexpr int CW_BAR = 4096;

constexpr int RING_BYTES = 139264;
constexpr int LDSCTL_OFF = RING_BYTES, MISC_OFF = LDSCTL_OFF + 320;
constexpr int LDS_BYTES = 147456;

struct Frame {
    LAS unsigned char* lds;
    volatile LAS unsigned* MISC;
    int tid, lane, wave, vcu, G;
};
typedef __attribute__((address_space(4))) const unsigned char kchar_t;
__device__ __forceinline__ kchar_t* kargs() { kchar_t* k = (kchar_t*)__builtin_amdgcn_kernarg_segment_ptr(); asm volatile("" : "+s"(k)); return k; }
__device__ __forceinline__ const float* inptr(int i) { return *(const float* __attribute__((address_space(4)))*)(kargs() + 8 * i); }
__device__ __forceinline__ float* outptr() { return *(float* __attribute__((address_space(4)))*)(kargs() + 176); }
__device__ __forceinline__ unsigned char* wsptr() { return *(unsigned char* __attribute__((address_space(4)))*)(kargs() + 184); }
constexpr int GRID = 256;
__device__ __forceinline__ Frame mkframe(LAS unsigned char* lds) {
    Frame F; int t = threadIdx.x; asm volatile("" : "+v"(t)); int bx = blockIdx.x; asm volatile("" : "+s"(bx));
    F.lds = lds; F.MISC = (volatile LAS unsigned*)(lds + MISC_OFF);
    F.tid = t; F.lane = t & 63; F.wave = __builtin_amdgcn_readfirstlane(t >> 6); F.G = GRID; F.vcu = (bx & 7) * (GRID / 8) + (bx >> 3);
    return F;
}
__device__ __forceinline__ float wave_sum(float v) {
#pragma unroll
    for (int o = 1; o < 64; o <<= 1) v += __shfl_xor(v, o);
    return v;
}
__device__ __forceinline__ float bf2f(unsigned short b) { return __uint_as_float(((unsigned)b) << 16); }
__device__ __forceinline__ float bflo(unsigned w) { return __uint_as_float(w << 16); }
__device__ __forceinline__ float bfhi(unsigned w) { return __uint_as_float(w & 0xffff0000u); }
__device__ __forceinline__ unsigned pkbf(float lo, float hi) { return pg8::cvt_pk_bf16(lo, hi); }
__device__ __forceinline__ unsigned pk4_fp8(float a, float b, float c, float d) { int w = __builtin_amdgcn_cvt_pk_fp8_f32(a, b, 0, false); w = __builtin_amdgcn_cvt_pk_fp8_f32(c, d, w, true); return (unsigned)w; }
__device__ __forceinline__ float silu_f(float x) { return x * __builtin_amdgcn_rcpf(1.0f + __expf(-x)); }

__device__ __forceinline__ int permc(int n) { if (n < ZC_Q || n >= ZC_V) return n; const int d = n & 127, rc = d >> 6, half = (d >> 5) & 1, i = d & 31; return (n & ~127) + 32 * (2 * rc + (i >> 4)) + 16 * half + (i & 15); }
__device__ __forceinline__ int permu(int n) { const int v = n >= DFF, r = v ? n - DFF : n; return 256 * (r >> 7) + 128 * v + (r & 127); }
__device__ __forceinline__ void transpose_item(const float* W, int K, int N, bf16* WT, LAS float* scr, int item, int lane, int pc = 0) {
    const int nblk = N / 32, kb = item / nblk, nb = item % nblk, k0 = 64 * kb, n0 = 32 * nb;
    float wv[32];
#pragma unroll
    for (int i = 0; i < 32; ++i) { const int kk = 2 * i + (lane >> 5); wv[i] = W[(size_t)(k0 + kk) * N + n0 + (lane & 31)]; }
#pragma unroll
    for (int i = 0; i < 32; ++i) { const int kk = 2 * i + (lane >> 5); scr[kk * 33 + (lane & 31)] = wv[i]; }
    LDS_WAIT(); asm volatile("" ::: "memory");
    const int c = lane & 7;
#pragma unroll
    for (int j = 0; j < 4; ++j) { const int n = (lane >> 3) + 8 * j; const LAS float* s = scr + (8 * c) * 33 + n;
        v4u o; o.x = pkbf(s[0 * 33], s[1 * 33]); o.y = pkbf(s[2 * 33], s[3 * 33]); o.z = pkbf(s[4 * 33], s[5 * 33]); o.w = pkbf(s[6 * 33], s[7 * 33]);
        *(GAS v4u*)(WT + (size_t)(pc == 1 ? permc(n0 + n) : (pc == 2 ? permu(n0 + n) : n0 + n)) * K + k0 + 8 * c) = o; }
    LDS_WAIT(); asm volatile("" ::: "memory");
}
__device__ __forceinline__ void transpose_item8(const float* W, int K, int N, unsigned char* WT, int nsub, float sc, LAS float* scr, int item, int lane) {
    const int nblk = N / 32, kb = item / nblk, nb = item % nblk, k0 = 64 * kb, n0 = 32 * nb;
    float wv[32];
#pragma unroll
    for (int i = 0; i < 32; ++i) { const int kk = 2 * i + (lane >> 5); wv[i] = W[(size_t)(k0 + kk) * N + n0 + (lane & 31)]; }
#pragma unroll
    for (int i = 0; i < 32; ++i) { const int kk = 2 * i + (lane >> 5); scr[kk * 33 + (lane & 31)] = wv[i]; }
    LDS_WAIT(); asm volatile("" ::: "memory");
#pragma unroll
    for (int i = 0; i < 2; ++i) { const int t = lane + 64 * i, n = t >> 2, ch = t & 3; const LAS float* s = scr + (16 * ch) * 33 + n;
        v4u o; o.x = pk4_fp8(s[0 * 33] * sc, s[1 * 33] * sc, s[2 * 33] * sc, s[3 * 33] * sc); o.y = pk4_fp8(s[4 * 33] * sc, s[5 * 33] * sc, s[6 * 33] * sc, s[7 * 33] * sc);
        o.z = pk4_fp8(s[8 * 33] * sc, s[9 * 33] * sc, s[10 * 33] * sc, s[11 * 33] * sc); o.w = pk4_fp8(s[12 * 33] * sc, s[13 * 33] * sc, s[14 * 33] * sc, s[15 * 33] * sc);
        *(GAS v4u*)(WT + (size_t)(n0 - nsub + n) * K + k0 + 16 * ch) = o; }
    LDS_WAIT(); asm volatile("" ::: "memory");
}
constexpr int CVT_I_IN = (DM / 64) * (NIN / 32), CVT_ALL = CVT_I_IN + 3 * (BW / 64) * (DM / 32) + (DM / 64) * (DM / 32) + (DM / 64) * (UP_LD / 32) + (DFF / 64) * (DM / 32);
__device__ __forceinline__ void convert_weights(Frame& F, int l, int lo, int hi, int gw, int NGW) {
    LAS float* scr = (LAS float*)(F.lds + F.wave * 16384);
    constexpr int I_IN = (DM / 64) * (NIN / 32), I_BR = (BW / 64) * (DM / 32), I_OUT = (DM / 64) * (DM / 32), I_UP = (DM / 64) * (UP_LD / 32), I_DN = (DFF / 64) * (DM / 32);
    constexpr int NITEMS = I_IN + 3 * I_BR + I_OUT + I_UP + I_DN; static_assert(NITEMS == CVT_ALL && I_IN == CVT_I_IN, "conversion list");
    unsigned char* wb = wsptr() + WS_W;
    for (int it = lo + gw; it < hi; it += NGW) {
        int r = it;
        if (r < I_IN) { if ((r % (NIN / 32)) * 32 < ZM_LD) transpose_item(inptr(10) + (size_t)l * DM * NIN, DM, NIN, (bf16*)(wb + W_IN), scr, r, F.lane, 1);
                        else transpose_item8(inptr(10) + (size_t)l * DM * NIN, DM, NIN, wb + W_IN + W_G8, ZM_LD, W8_SCALE, scr, r, F.lane); continue; } r -= I_IN;
        if (r < 3 * I_BR) { const int n = r / I_BR; transpose_item(inptr(16) + ((size_t)l * 3 + n) * BW * DM, BW, DM, (bf16*)(wb + W_BR) + (size_t)n * DM * BW, scr, r - n * I_BR, F.lane); continue; } r -= 3 * I_BR;
        if (r < I_OUT) { transpose_item(inptr(17) + (size_t)l * DM * DM, DM, DM, (bf16*)(wb + W_OUT), scr, r, F.lane); continue; } r -= I_OUT;
        if (r < I_UP) { transpose_item(inptr(18) + (size_t)l * DM * UP_LD, DM, UP_LD, (bf16*)(wb + W_UP), scr, r, F.lane, 2); continue; } r -= I_UP;
        transpose_item(inptr(21) + (size_t)l * DFF * DM, DFF, DM, (bf16*)(wb + W_DN), scr, r, F.lane);
    }
}
__device__ __forceinline__ void prologue_small(Frame& F) {
    LAS float* sv = (LAS float*)F.lds;
    LAS f32x4* red = (LAS f32x4*)F.lds;
    static_assert(NL * 48 <= GRID && 9 * 2048 * 4 <= RING_BYTES && 8 * 9 * 64 * 16 <= RING_BYTES, "prologue LDS");
    for (int i = F.tid; i < 9 * 2048; i += NWAVES * 64) { const int j = i >> 11, k = i & 2047; const float c = j < 8 ? inptr(1)[j * DM + k] : inptr(3)[k]; sv[i] = silu_f(c); }
    __syncthreads();
    float* mod = (float*)(wsptr() + WS_MOD);
    for (int it = F.vcu; it < NL * 48; it += F.G) {
        const int l = it / 48, cg = it - l * 48, n = cg * 256 + F.lane * 4;
        const float* W = inptr(4) + (size_t)l * DM * (6 * DM) + n;
        f32x4 a[9];
#pragma unroll
        for (int j = 0; j < 9; ++j) a[j] = (f32x4){0.f, 0.f, 0.f, 0.f};
        const int kb = F.wave * 256;
#pragma unroll 8
        for (int k = 0; k < 256; ++k) { const f32x4 w = *(const f32x4*)(W + (size_t)(kb + k) * (6 * DM));
#pragma unroll
            for (int j = 0; j < 9; ++j) a[j] += sv[j * 2048 + kb + k] * w; }
        __syncthreads();
#pragma unroll
        for (int j = 0; j < 9; ++j) red[(F.wave * 9 + j) * 64 + F.lane] = a[j];
        __syncthreads();
        for (int o = F.tid; o < 9 * 64; o += NWAVES * 64) { const int j = o >> 6, ln = o & 63; f32x4 s = (f32x4){0.f, 0.f, 0.f, 0.f};
#pragma unroll
            for (int w = 0; w < 8; ++w) s += red[(w * 9 + j) * 64 + ln];
            const int nn = cg * 256 + ln * 4; const f32x4 bb = *(const f32x4*)(inptr(5) + (size_t)l * (6 * DM) + nn);
            *(f32x4*)(mod + ((size_t)l * 9 + j) * (6 * DM) + nn) = s + bb; }
        __syncthreads();
    }
    const int gt = F.vcu * NWAVES * 64 + F.tid, NGT = F.G * NWAVES * 64;
    float* lb = (float*)(wsptr() + WS_LB);
    for (int i = gt; i < 2 * 1024; i += NGT) { const int dir = i >> 10, c = i & 1023; float lg[NL], mx = -1e30f;
#pragma unroll
        for (int l = 0; l < NL; ++l) { lg[l] = inptr(11)[((size_t)dir * NL + l) * 1024 + c]; mx = fmaxf(mx, lg[l]); }
        float s = 0.f;
#pragma unroll
        for (int l = 0; l < NL; ++l) { lg[l] = expf(lg[l] - mx); s += lg[l]; }
        float cum = 0.f;
#pragma unroll
        for (int l = 0; l < NL; ++l) { if (l > 0) cum += lg[l] / s; lb[((size_t)dir * NL + l) * 1024 + c] = cum; } }
    if (gt < NL) { const float* lv = inptr(13) + (size_t)gt * 4 * 64; float s1 = 0.f, s2 = 0.f;
        for (int i = 0; i < 64; ++i) { s1 += lv[i] * lv[64 + i]; s2 += lv[128 + i] * lv[192 + i]; }
        ((float*)(wsptr() + WS_LAM))[gt] = expf(s1) - expf(s2) + (0.8f - 0.6f * expf(-0.3f * (float)gt)); }
    float* rp = (float*)(wsptr() + WS_ROPE);
    for (int i = gt; i < 64 * 16; i += NGT) { const int pos = i >> 4, k = i & 15; const float inv = powf(10000.0f, -(float)k / 16.0f), ang = (float)pos * inv; rp[i] = cosf(ang); rp[1024 + i] = sinf(ang); }
    for (int i = gt; i < 64 * 32; i += NGT) { const int pos = i >> 5, k = i & 31; const float inv = powf(10000.0f, -(float)k / 32.0f), ang = (float)pos * inv; rp[2048 + i] = cosf(ang); rp[4096 + i] = sinf(ang); }
}
__device__ __forceinline__ const float* row_src(int b, int p, const float* lat, const float* ctx) { return p < CTXL ? ctx + (size_t)(b * CTXL + p) * DM : lat + (size_t)(b * SEQ + p - CTXL) * DM; }

__device__ __forceinline__ void prenorm_phase(Frame& F, int l, const float* xlat, const float* xctx) {
    const int gw = F.vcu * NWAVES + F.wave, NGW = F.G * NWAVES;
    const float* mod = (const float*)(wsptr() + WS_MOD) + (size_t)l * 9 * (6 * DM);
    const float* g = inptr(6) + (size_t)l * DM;
    bf16* H = (bf16*)(wsptr() + WS_H);
    for (int r = gw; r < M; r += NGW) {
        const int b = r / TOK, p = r - b * TOK; const float* xr = row_src(b, p, xlat, xctx); const float* mr = mod + (size_t)(p < CTXL ? 8 : b) * (6 * DM);
        f32x4 v[8]; float ss = 0.f;
#pragma unroll
        for (int j = 0; j < 8; ++j) { v[j] = *(const f32x4*)(xr + 4 * (64 * j + F.lane)); ss += (v[j].x * v[j].x + v[j].y * v[j].y) + (v[j].z * v[j].z + v[j].w * v[j].w); }
        const float rstd = rsqrtf(wave_sum(ss) * (1.f / DM) + EPS);
#pragma unroll
        for (int j = 0; j < 8; ++j) { const int c = 4 * (64 * j + F.lane); const f32x4 gg = *(const f32x4*)(g + c), sh = *(const f32x4*)(mr + c), sc = *(const f32x4*)(mr + DM + c);
            const f32x4 hv = (v[j] * rstd * gg) * (1.0f + sc) + sh;
            *(unsigned long long*)(H + (size_t)r * DM + c) = (unsigned long long)pkbf(hv.x, hv.y) | ((unsigned long long)pkbf(hv.z, hv.w) << 32);
            *(unsigned*)(wsptr() + WS_H8 + (size_t)r * DM + c) = pk4_fp8(hv.x * H8_SCALE, hv.y * H8_SCALE, hv.z * H8_SCALE, hv.w * H8_SCALE); }
    }
}
constexpr size_t WS_XM = WS_Z + 512 * MiB;
template <bool XF32, int MODE>
__device__ __forceinline__ void post_pre_phase(Frame& F, int l, bool wxm) {
    static_assert(M == 136 * GRID && TOK % 136 == 0, "row deal");
    constexpr bool XS32 = XF32 || MODE == 3;
    LAS f32x4* L4 = (LAS f32x4*)F.lds;
    const int b = (F.vcu * 136) / TOK;
    { const float* ml = (const float*)(wsptr() + WS_MOD) + (size_t)l * 9 * (6 * DM);
      const int ln = MODE == 0 ? l : (l + 1 < NL ? l + 1 : l);
      const float* modp = MODE == 0 ? ml + 3 * DM : (const float*)(wsptr() + WS_MOD) + (size_t)ln * 9 * (6 * DM);
      const float* gpre = MODE == 0 ? inptr(8) + (size_t)l * DM : inptr(6) + (size_t)ln * DM;
      for (int i = F.tid; i < 2 * 512; i += NWAVES * 64) { const int s = i >> 9, q = i & 511, c = q * 4; const size_t mo = (size_t)(s ? 8 : b) * (6 * DM) + c;
          if (MODE != 3) L4[s * 512 + q] = *(const f32x4*)(ml + 2 * DM + mo) * *(const f32x4*)(inptr(7) + (size_t)l * DM + c);
          if (MODE != 0) L4[(6 + s) * 512 + q] = *(const f32x4*)(ml + 5 * DM + mo) * *(const f32x4*)(inptr(9) + (size_t)l * DM + c);
          if (MODE != 3) { const f32x4 g2 = *(const f32x4*)(gpre + c), sh = *(const f32x4*)(modp + mo), sc = *(const f32x4*)(modp + mo + DM);
              L4[(2 + s) * 512 + q] = g2 * (1.0f + sc); L4[(4 + s) * 512 + q] = sh; } } }
    __syncthreads();
    const int rbase = F.vcu * 136 + F.wave;
    f32x4 xfA[8], xfB[8]; unsigned long long xbA[8], xbB[8], mA[8], mB[8], fA[8], fB[8];
#define PP_XOFF(p_) ((p_) < CTXL ? (size_t)(b * CTXL + (p_)) * DM : (size_t)(b * SEQ + (p_) - CTXL) * DM)
#define PP_LOAD(S, r) do { const int p_ = (r) - b * TOK; if (MODE != 3 || p_ >= CTXL) { \
        const float* xf_ = MODE == 3 ? (const float*)(wsptr() + WS_XM) + (size_t)(r) * DM : (p_ < CTXL ? inptr(2) : inptr(0)) + PP_XOFF(p_); \
        const bf16* xb_ = (p_ < CTXL ? (const bf16*)(wsptr() + WS_CX) : (const bf16*)outptr()) + PP_XOFF(p_); \
        const bf16* mr_ = (const bf16*)(wsptr() + WS_M2) + (size_t)(r) * DM; const bf16* fr_ = (const bf16*)(wsptr() + WS_H) + (size_t)(r) * DM; \
        _Pragma("unroll") for (int j = 0; j < 8; ++j) { const int c_ = 4 * (64 * j + F.lane); \
            if (XS32) xf##S[j] = *(const f32x4*)(xf_ + c_); else xb##S[j] = *(const unsigned long long*)(xb_ + c_); \
            if (MODE != 3) m##S[j] = *(const unsigned long long*)(mr_ + c_); \
            if (MODE != 0) f##S[j] = *(const unsigned long long*)(fr_ + c_); } } } while (0)
#define PP_UNPK(w_) (f32x4){bflo((unsigned)(w_)), bfhi((unsigned)(w_)), bflo((unsigned)((w_) >> 32)), bfhi((unsigned)((w_) >> 32))}
#define PP_SQ(v_) (((v_).x * (v_).x + (v_).y * (v_).y) + ((v_).z * (v_).z + (v_).w * (v_).w))
#define PP_PROC(S, r) do { const int p_ = (r) - b * TOK, s_ = (p_ < CTXL) ? 1 : 0; if (MODE != 3 || p_ >= CTXL) { \
        f32x4 xv_[8]; float ssm_ = 0.f, ssf_ = 0.f; \
        _Pragma("unroll") for (int j = 0; j < 8; ++j) { if (XS32) xv_[j] = xf##S[j]; else xv_[j] = PP_UNPK(xb##S[j]); \
            if (MODE != 3) { const f32x4 t_ = PP_UNPK(m##S[j]); ssm_ += PP_SQ(t_); } \
            if (MODE != 0) { const f32x4 t_ = PP_UNPK(f##S[j]); ssf_ += PP_SQ(t_); } } \
        float rsm_ = 0.f, rsf_ = 0.f; \
        if (MODE != 3) rsm_ = rsqrtf(wave_sum(ssm_) * (1.f / DM) + EPS); \
        if (MODE != 0) rsf_ = rsqrtf(wave_sum(ssf_) * (1.f / DM) + EPS); \
        float sx_ = 0.f; \
        _Pragma("unroll") for (int j = 0; j < 8; ++j) { const int q_ = 64 * j + F.lane; f32x4 xn_ = xv_[j]; \
            if (MODE != 3) { const f32x4 t_ = PP_UNPK(m##S[j]); xn_ = xn_ + L4[s_ * 512 + q_] * (t_ * rsm_); } \
            if (MODE == 0 && wxm) *(f32x4*)((float*)(wsptr() + WS_XM) + (size_t)(r) * DM + 4 * q_) = xn_; \
            if (MODE != 0) { const f32x4 t_ = PP_UNPK(f##S[j]); xn_ = xn_ + L4[(6 + s_) * 512 + q_] * (t_ * rsf_); } \
            if (MODE == 1) *(unsigned long long*)((p_ < CTXL ? (bf16*)(wsptr() + WS_CX) : (bf16*)outptr()) + PP_XOFF(p_) + 4 * q_) = (unsigned long long)pkbf(xn_.x, xn_.y) | ((unsigned long long)pkbf(xn_.z, xn_.w) << 32); \
            if (MODE == 3) *(f32x4*)(outptr() + PP_XOFF(p_) + 4 * q_) = xn_; \
            xv_[j] = xn_; sx_ += PP_SQ(xn_); } \
        if (MODE != 3) { const float rs2_ = rsqrtf(wave_sum(sx_) * (1.f / DM) + EPS); \
            _Pragma("unroll") for (int j = 0; j < 8; ++j) { const int q_ = 64 * j + F.lane; const f32x4 a2_ = L4[(2 + s_) * 512 + q_], sh_ = L4[(4 + s_) * 512 + q_]; \
                const f32x4 hv_ = (xv_[j] * rs2_) * a2_ + sh_; \
                *(unsigned long long*)((bf16*)(wsptr() + WS_H) + (size_t)(r) * DM + 4 * q_) = (unsigned long long)pkbf(hv_.x, hv_.y) | ((unsigned long long)pkbf(hv_.z, hv_.w) << 32); \
                if (MODE == 1) *(unsigned*)(wsptr() + WS_H8 + (size_t)(r) * DM + 4 * q_) = pk4_fp8(hv_.x * H8_SCALE, hv_.y * H8_SCALE, hv_.z * H8_SCALE, hv_.w * H8_SCALE); } } } } while (0)
    PP_LOAD(A, rbase);
#pragma unroll 1
    for (int i = 0; i < 17; i += 2) {
        if (i + 1 < 17) PP_LOAD(B, rbase + 8 * (i + 1));
        PP_PROC(A, rbase + 8 * i);
        if (i + 2 < 17) PP_LOAD(A, rbase + 8 * (i + 2));
        if (i + 1 < 17) PP_PROC(B, rbase + 8 * (i + 1));
    }
#undef PP_LOAD
#undef PP_PROC
#undef PP_UNPK
#undef PP_SQ
#undef PP_XOFF
    __syncthreads();
}

__device__ __forceinline__ void rope8(const u32x4v a, const u32x4v b, const float* cs, const float* sn, u32x4v& oa, u32x4v& ob) {
    const f32x4 c0 = *(const f32x4*)cs, c1 = *(const f32x4*)(cs + 4), s0 = *(const f32x4*)sn, s1 = *(const f32x4*)(sn + 4);
    const float x1[8] = {bflo(a.x), bfhi(a.x), bflo(a.y), bfhi(a.y), bflo(a.z), bfhi(a.z), bflo(a.w), bfhi(a.w)};
    const float x2[8] = {bflo(b.x), bfhi(b.x), bflo(b.y), bfhi(b.y), bflo(b.z), bfhi(b.z), bflo(b.w), bfhi(b.w)};
    const float cc[8] = {c0.x, c0.y, c0.z, c0.w, c1.x, c1.y, c1.z, c1.w}, ss[8] = {s0.x, s0.y, s0.z, s0.w, s1.x, s1.y, s1.z, s1.w};
    float o1[8], o2[8];
#pragma unroll
    for (int j = 0; j < 8; ++j) { o1[j] = x1[j] * cc[j] - x2[j] * ss[j]; o2[j] = x2[j] * cc[j] + x1[j] * ss[j]; }
    oa.x = pkbf(o1[0], o1[1]); oa.y = pkbf(o1[2], o1[3]); oa.z = pkbf(o1[4], o1[5]); oa.w = pkbf(o1[6], o1[7]);
    ob.x = pkbf(o2[0], o2[1]); ob.y = pkbf(o2[2], o2[3]); ob.z = pkbf(o2[4], o2[5]); ob.w = pkbf(o2[6], o2[7]);
}
__device__ __forceinline__ void rope_prep_phase(Frame& F) {
    const int gw = F.vcu * NWAVES + F.wave, NGW = F.G * NWAVES, t = F.lane;
    bf16* Zm = (bf16*)(wsptr() + WS_Z);
    const float* rp = (const float*)(wsptr() + WS_ROPE);
#pragma unroll 2
    for (int rl = gw; rl < NB * SEQ; rl += NGW) {
        const int b = rl >> 12, n = rl & (SEQ - 1); bf16* zr = Zm + (size_t)(b * TOK + CTXL + n) * ZM_LD;
        const bool lat = true; const int prow = n >> 6, pcol = n & 63;
        if (lat) {
            { const int hd = t >> 3, sub = t & 7, rc = sub >> 2, q8 = sub & 3, off = ZC_Q + hd * 128 + rc * 64 + q8 * 8, pos = rc ? pcol : prow;
              const float* cs = rp + 2048 + pos * 32 + q8 * 8; const float* sn = rp + 4096 + pos * 32 + q8 * 8;
              u32x4v a = *(const u32x4v*)(zr + off), bb = *(const u32x4v*)(zr + off + 32), oa, ob; rope8(a, bb, cs, sn, oa, ob);
              *(u32x4v*)(zr + off) = oa; *(u32x4v*)(zr + off + 32) = ob; }
            if (t < 16) { const int hd = t >> 3, sub = t & 7, rc = sub >> 2, q8 = sub & 3, off = ZC_K + hd * 128 + rc * 64 + q8 * 8, pos = rc ? pcol : prow;
              const float* cs = rp + 2048 + pos * 32 + q8 * 8; const float* sn = rp + 4096 + pos * 32 + q8 * 8;
              u32x4v a = *(const u32x4v*)(zr + off), bb = *(const u32x4v*)(zr + off + 32), oa, ob; rope8(a, bb, cs, sn, oa, ob);
              *(u32x4v*)(zr + off) = oa; *(u32x4v*)(zr + off + 32) = ob; }
        }
    }
}
__device__ __forceinline__ void finish_a_phase(Frame& F, int l) {
    const int gw = F.vcu * NWAVES + F.wave, NGW = F.G * NWAVES;
    const bf16* OF = (const bf16*)(wsptr() + WS_H); const bf16* OB = OF + (size_t)M * BW; const bf16* Zm = (const bf16*)(wsptr() + WS_Z); bf16* BR = (bf16*)(wsptr() + WS_A);
    const float* ng = inptr(12) + (size_t)l * 128;
#pragma unroll 2
    for (int it = gw; it < 2 * M; it += NGW) {
        const int r = it >> 1, hh = it & 1, col = (hh * 4 + (F.lane >> 4)) * 128 + (F.lane & 15) * 8, e0 = (F.lane & 15) * 8;
        const u32x4v a = *(const u32x4v*)(OF + (size_t)r * BW + col), bb = *(const u32x4v*)(OB + (size_t)r * BW + col), gz = *(const u32x4v*)(Zm + (size_t)r * ZM_LD + ZA_G + col);
        float o[8] = {bflo(a.x) + bflo(bb.x), bfhi(a.x) + bfhi(bb.x), bflo(a.y) + bflo(bb.y), bfhi(a.y) + bfhi(bb.y), bflo(a.z) + bflo(bb.z), bfhi(a.z) + bfhi(bb.z), bflo(a.w) + bflo(bb.w), bfhi(a.w) + bfhi(bb.w)};
        const float g[8] = {bflo(gz.x), bfhi(gz.x), bflo(gz.y), bfhi(gz.y), bflo(gz.z), bfhi(gz.z), bflo(gz.w), bfhi(gz.w)};
        float ss = 0.f;
#pragma unroll
        for (int j = 0; j < 8; ++j) ss += o[j] * o[j];
        ss += __shfl_xor(ss, 1); ss += __shfl_xor(ss, 2); ss += __shfl_xor(ss, 4); ss += __shfl_xor(ss, 8);
        const float rstd = rsqrtf(ss * (1.f / 128.f) + EPS);
        const f32x4 n0 = *(const f32x4*)(ng + e0), n1 = *(const f32x4*)(ng + e0 + 4); const float nn[8] = {n0.x, n0.y, n0.z, n0.w, n1.x, n1.y, n1.z, n1.w};
#pragma unroll
        for (int j = 0; j < 8; ++j) o[j] = o[j] * rstd * nn[j] * silu_f(g[j]);
        u32x4v w; w.x = pkbf(o[0], o[1]); w.y = pkbf(o[2], o[3]); w.z = pkbf(o[4], o[5]); w.w = pkbf(o[6], o[7]);
        *(u32x4v*)(BR + (size_t)r * BW + col) = w;
    }
}
__device__ __forceinline__ void unpack8(const u32x4v w, float (&f)[8]) { f[0] = bflo(w.x); f[1] = bfhi(w.x); f[2] = bflo(w.y); f[3] = bfhi(w.y); f[4] = bflo(w.z); f[5] = bfhi(w.z); f[6] = bflo(w.w); f[7] = bfhi(w.w); }
__device__ __forceinline__ void conv_act_phase(Frame& F, int l) {
    const bf16* U = (const bf16*)(wsptr() + WS_Z); bf16* ACT = (bf16*)(wsptr() + WS_A);
    const float* cw = inptr(19) + (size_t)l * 3 * UP_LD; const float* cb = inptr(20) + (size_t)l * UP_LD;
    constexpr int NCG = DFF / 8, NRS = M / 16;
    const int gt = F.vcu * NWAVES * 64 + F.tid, NGT = F.G * NWAVES * 64;
    for (int idx = gt; idx < NCG * NRS; idx += NGT) {
        const int rs = idx / NCG, cg = idx - rs * NCG, c = cg * 8, r0 = rs * 16, p0 = r0 % TOK;
        float wa[3][8], wv[3][8], ba[8], bv[8];
#pragma unroll
        for (int k = 0; k < 3; ++k)
#pragma unroll
            for (int h = 0; h < 2; ++h) { const f32x4 t0 = *(const f32x4*)(cw + (size_t)k * UP_LD + c + 4 * h), t1 = *(const f32x4*)(cw + (size_t)k * UP_LD + DFF + c + 4 * h);
                wa[k][4 * h] = t0.x; wa[k][4 * h + 1] = t0.y; wa[k][4 * h + 2] = t0.z; wa[k][4 * h + 3] = t0.w; wv[k][4 * h] = t1.x; wv[k][4 * h + 1] = t1.y; wv[k][4 * h + 2] = t1.z; wv[k][4 * h + 3] = t1.w; }
#pragma unroll
        for (int h = 0; h < 2; ++h) { const f32x4 t0 = *(const f32x4*)(cb + c + 4 * h), t1 = *(const f32x4*)(cb + DFF + c + 4 * h);
            ba[4 * h] = t0.x; ba[4 * h + 1] = t0.y; ba[4 * h + 2] = t0.z; ba[4 * h + 3] = t0.w; bv[4 * h] = t1.x; bv[4 * h + 1] = t1.y; bv[4 * h + 2] = t1.z; bv[4 * h + 3] = t1.w; }
        float pa[8], pv[8], ca[8], cv[8], na[8], nv[8];
        const u32x4v zz = {0u, 0u, 0u, 0u};
        { const bool ok = (p0 != 0) && (p0 != CTXL); const bf16* up = U + (size_t)(ok ? r0 - 1 : r0) * UP_LD + c; u32x4v x = *(const u32x4v*)up, y = *(const u32x4v*)(up + DFF); if (!ok) { x = zz; y = zz; } unpack8(x, pa); unpack8(y, pv); }
        { const bf16* up = U + (size_t)r0 * UP_LD + c; unpack8(*(const u32x4v*)up, ca); unpack8(*(const u32x4v*)(up + DFF), cv); }
#pragma unroll 4
        for (int i = 0; i < 16; ++i) {
            const int r = r0 + i, p = p0 + i; const bool ok = (p != CTXL - 1) && (p != TOK - 1);
            { const bf16* up = U + (size_t)(ok ? r + 1 : r) * UP_LD + c; u32x4v x = *(const u32x4v*)up, y = *(const u32x4v*)(up + DFF); if (!ok) { x = zz; y = zz; } unpack8(x, na); unpack8(y, nv); }
            float o[8];
#pragma unroll
            for (int j = 0; j < 8; ++j) { const float a = pa[j] * wa[0][j] + ca[j] * wa[1][j] + na[j] * wa[2][j] + ba[j], v = pv[j] * wv[0][j] + cv[j] * wv[1][j] + nv[j] * wv[2][j] + bv[j];
                o[j] = silu_f(a) * v; pa[j] = ca[j]; pv[j] = cv[j]; ca[j] = na[j]; cv[j] = nv[j]; }
            u32x4v w; w.x = pkbf(o[0], o[1]); w.y = pkbf(o[2], o[3]); w.z = pkbf(o[4], o[5]); w.w = pkbf(o[6], o[7]);
            *(u32x4v*)(ACT + (size_t)r * DFF + c) = w;
        }
    }
}

__device__ __forceinline__ void conv_fix_phase(Frame& F, int l) {
    const float* SB = (const float*)(wsptr() + WS_Z); bf16* ACT = (bf16*)(wsptr() + WS_A);
    const float* cw = inptr(19) + (size_t)l * 3 * UP_LD;
    constexpr int NE = (M / 64) * 2, NC4 = DFF / 4;
    const int gt = F.vcu * NWAVES * 64 + F.tid, NGT = F.G * NWAVES * 64;
    for (int idx = gt; idx < NE * NC4; idx += NGT) {
        const int E = idx / NC4, ch = (idx - E * NC4) * 4, gb = E >> 1, edge = E & 1, r = 64 * gb + (edge ? 63 : 0), p = r % TOK;
        const bool has = edge ? !(p == CTXL - 1 || p == TOK - 1) : !(p == 0 || p == CTXL);
        const float* sb = SB + ((size_t)E * 4) * DFF + ch;
        f32x4 a = *(const f32x4*)(sb + 2 * DFF), v = *(const f32x4*)(sb + 3 * DFF);
        if (has) { const float* nb = SB + ((size_t)(edge ? E + 1 : E - 1) * 4) * DFF + ch; const float* w = cw + (size_t)(edge ? 2 : 0) * UP_LD + ch;
            a += *(const f32x4*)w * *(const f32x4*)nb; v += *(const f32x4*)(w + DFF) * *(const f32x4*)(nb + DFF); }
        f32x4 o;
#pragma unroll
        for (int e2 = 0; e2 < 4; ++e2) o[e2] = silu_f(a[e2]) * v[e2];
        *(unsigned long long*)(ACT + (size_t)r * DFF + ch) = (unsigned long long)pkbf(o[0], o[1]) | ((unsigned long long)pkbf(o[2], o[3]) << 32);
    }
}

namespace hg {
constexpr int QT = 0, KT = 17408, QH = 34816, KHT = 52224, VT = 70656, PP = 89088, ST = 98304, SEG = 133120, DEC = 135168, END = 135680;
static_assert(END <= RING_BYTES, "HGRN LDS");
constexpr int LDR = 272, LDS_ = 144;
__device__ __forceinline__ int tok_of(int dir, int i) { return dir == 0 ? i : (i < CTXL ? (CTXL - 1 - i) : (TOK + CTXL - 1 - i)); }
}
__device__ __forceinline__ void hgrn_unit(Frame& F, int l, int unit) {
    using namespace hg;
    const int b = unit >> 4, h = (unit >> 1) & 7, dir = unit & 1;
    LAS unsigned char* L = F.lds;
    const int tid = F.tid, lane = F.lane, w = F.wave, l15 = lane & 15, kq = lane >> 4;
    const int d = tid & 127, tq = tid >> 7;
    const bf16* Zb = (const bf16*)(wsptr() + WS_Z) + (size_t)b * TOK * ZM_LD;
    bf16* Od = (bf16*)(wsptr() + WS_H) + (size_t)dir * M * BW + (size_t)b * TOK * BW + h * 128;
    const int cq = ZA_Q + h * 128 + d, cf = (dir ? ZA_FB : ZA_FF) + h * 128 + d;
    const int vs = tid >> 3, ve16 = (tid & 7) * 16, cv = ZA_V + h * 128 + ve16;
    for (int i = tid; i < 128 * LDR / 4; i += NWAVES * 64) ((LAS unsigned*)(L + ST))[i] = 0u;
    f32x4 S[8];
#pragma unroll
    for (int j = 0; j < 8; ++j) S[j] = (f32x4){0.f, 0.f, 0.f, 0.f};
    unsigned short zq[16], zf[16]; u32x4v vv, vw;
#define HG_LOAD(c) do { _Pragma("unroll") for (int i_ = 0; i_ < 16; ++i_) { const bf16* rp_ = Zb + (size_t)tok_of(dir, 64 * (c) + 16 * tq + i_) * ZM_LD; zq[i_] = rp_[cq]; zf[i_] = rp_[cf]; } \
        { const bf16* vp_ = Zb + (size_t)tok_of(dir, 64 * (c) + vs) * ZM_LD + cv; vv = *(const u32x4v*)vp_; vw = *(const u32x4v*)(vp_ + 8); } } while (0)
    HG_LOAD(0);
    __syncthreads();
    for (int c = 0; c < TOK / 64; ++c) {
        float pl[16], qv[16], kv[16]; float prod = 1.0f;
#pragma unroll
        for (int i = 0; i < 16; ++i) { const float f = bf2f(zf[i]);
            prod *= f; pl[i] = prod; kv[i] = 1.0f - f; qv[i] = bf2f(zq[i]); }
        ((LAS float*)(L + SEG))[tq * 128 + d] = prod;
        { const unsigned ww[8] = {vv.x, vv.y, vv.z, vv.w, vw.x, vw.y, vw.z, vw.w};
#pragma unroll
          for (int j = 0; j < 8; ++j) { *(LAS unsigned short*)(L + VT + (ve16 + 2 * j) * LDS_ + vs * 2) = (unsigned short)(ww[j] & 0xffffu); *(LAS unsigned short*)(L + VT + (ve16 + 2 * j + 1) * LDS_ + vs * 2) = (unsigned short)(ww[j] >> 16); } }
        __syncthreads();
        if (c + 1 < TOK / 64) HG_LOAD(c + 1);
        { const LAS float* sg = (const LAS float*)(L + SEG); const float s0 = sg[d], s1 = sg[128 + d], s2 = sg[256 + d], s3 = sg[384 + d];
          const float cmid = s0 * s1, cend = s2 * s3;
          const float fac = tq == 0 ? __builtin_amdgcn_rcpf(cmid) : (tq == 1 ? __builtin_amdgcn_rcpf(s1) : (tq == 2 ? 1.0f : s2));
          if (tq == 0) ((LAS float*)(L + DEC))[d] = cmid * cend;
          unsigned kh[8];
#pragma unroll
          for (int i = 0; i < 16; ++i) { const int t = 16 * tq + i; const float e1 = pl[i] * fac, r1 = __builtin_amdgcn_rcpf(e1);
              const float qt = qv[i] * e1, kt = kv[i] * r1, qh = qt * cmid, kh_ = kt * cend;
              const unsigned pq = pkbf(qt, qh), pk = pkbf(kt, kh_);
              *(LAS unsigned short*)(L + QT + t * LDR + d * 2) = (unsigned short)(pq & 0xffffu); *(LAS unsigned short*)(L + QH + t * LDR + d * 2) = (unsigned short)(pq >> 16);
              *(LAS unsigned short*)(L + KT + t * LDR + d * 2) = (unsigned short)(pk & 0xffffu);
              if (i & 1) kh[i >> 1] |= (pk & 0xffff0000u); else kh[i >> 1] = pk >> 16; }
          *(LAS u32x4v*)(L + KHT + d * LDS_ + tq * 32) = (u32x4v){kh[0], kh[1], kh[2], kh[3]}; *(LAS u32x4v*)(L + KHT + d * LDS_ + tq * 32 + 16) = (u32x4v){kh[4], kh[5], kh[6], kh[7]}; }
        __syncthreads();
        { const int st = w & 3, tt0 = (w >> 2) * 2; bf16x8 a[4];
#pragma unroll
          for (int k = 0; k < 4; ++k) a[k] = *(const LAS bf16x8*)(L + KT + (st * 16 + l15) * LDR + (k * 32 + kq * 8) * 2);
#pragma unroll
          for (int u = 0; u < 2; ++u) { const int tt = tt0 + u; f32x4 acc = (f32x4){0.f, 0.f, 0.f, 0.f};
#pragma unroll
              for (int k = 0; k < 4; ++k) { const bf16x8 bq = *(const LAS bf16x8*)(L + QT + (tt * 16 + l15) * LDR + (k * 32 + kq * 8) * 2); acc = __builtin_amdgcn_mfma_f32_16x16x32_bf16(a[k], bq, acc, 0, 0, 0); }
              const int tabs = tt * 16 + l15, s0 = st * 16 + 4 * kq;
              const float p0 = (s0 + 0 <= tabs) ? acc[0] : 0.f, p1 = (s0 + 1 <= tabs) ? acc[1] : 0.f, p2 = (s0 + 2 <= tabs) ? acc[2] : 0.f, p3 = (s0 + 3 <= tabs) ? acc[3] : 0.f;
              *(LAS unsigned long long*)(L + PP + tabs * LDS_ + s0 * 2) = (unsigned long long)pkbf(p0, p1) | ((unsigned long long)pkbf(p2, p3) << 32); } }
        __syncthreads();
        { const int tt = w & 3, et0 = (w >> 2) * 4;
          bf16x8 bp[2], bqh[4];
#pragma unroll
          for (int k = 0; k < 2; ++k) bp[k] = *(const LAS bf16x8*)(L + PP + (tt * 16 + l15) * LDS_ + (k * 32 + kq * 8) * 2);
#pragma unroll
          for (int k = 0; k < 4; ++k) bqh[k] = *(const LAS bf16x8*)(L + QH + (tt * 16 + l15) * LDR + (k * 32 + kq * 8) * 2);
          const int tproc = 64 * c + tt * 16 + l15; bf16* orow = Od + (size_t)tok_of(dir, tproc) * BW;
#pragma unroll
          for (int u = 0; u < 4; ++u) { const int et = et0 + u; f32x4 acc = (f32x4){0.f, 0.f, 0.f, 0.f};
#pragma unroll
              for (int k = 0; k < 2; ++k) { const bf16x8 av = *(const LAS bf16x8*)(L + VT + (et * 16 + l15) * LDS_ + (k * 32 + kq * 8) * 2); acc = __builtin_amdgcn_mfma_f32_16x16x32_bf16(av, bp[k], acc, 0, 0, 0); }
#pragma unroll
              for (int k = 0; k < 4; ++k) { const bf16x8 as = *(const LAS bf16x8*)(L + ST + (et * 16 + l15) * LDR + (k * 32 + kq * 8) * 2); acc = __builtin_amdgcn_mfma_f32_16x16x32_bf16(as, bqh[k], acc, 0, 0, 0); }
              *(unsigned long long*)(orow + et * 16 + 4 * kq) = (unsigned long long)pkbf(acc[0], acc[1]) | ((unsigned long long)pkbf(acc[2], acc[3]) << 32); } }
        __syncthreads();
        { const LAS float* dc = (const LAS float*)(L + DEC) + 16 * w + 4 * kq; const float d0 = dc[0], d1 = dc[1], d2 = dc[2], d3 = dc[3];
          bf16x8 ak[2];
#pragma unroll
          for (int k = 0; k < 2; ++k) ak[k] = *(const LAS bf16x8*)(L + KHT + (16 * w + l15) * LDS_ + (k * 32 + kq * 8) * 2);
#pragma unroll
          for (int et = 0; et < 8; ++et) { f32x4 acc = S[et]; acc[0] *= d0; acc[1] *= d1; acc[2] *= d2; acc[3] *= d3;
#pragma unroll
              for (int k = 0; k < 2; ++k) { const bf16x8 bv = *(const LAS bf16x8*)(L + VT + (et * 16 + l15) * LDS_ + (k * 32 + kq * 8) * 2); acc = __builtin_amdgcn_mfma_f32_16x16x32_bf16(ak[k], bv, acc, 0, 0, 0); }
              S[et] = acc;
              *(LAS unsigned long long*)(L + ST + (et * 16 + l15) * LDR + (16 * w + 4 * kq) * 2) = (unsigned long long)pkbf(acc[0], acc[1]) | ((unsigned long long)pkbf(acc[2], acc[3]) << 32); } }
        __syncthreads();
    }
#undef HG_LOAD
}

namespace att {
using s16x4  = __attribute__((ext_vector_type(4))) short;
using f32x16 = __attribute__((ext_vector_type(16))) float;
typedef LAS char lchar;
constexpr int SHM_V = 64 * 128 * 2, SHM_K = 64 * 128 * 2, SHM_ATTN = 2 * SHM_V + 2 * SHM_K + NWAVES * 64 * 4  , STASH_OFF = SHM_ATTN, STASH_BYTES = 32 * 512 * 4;
static_assert(STASH_OFF + STASH_BYTES <= RING_BYTES, "attention LDS");
#define KSWZ(row, colB) ((row) * 256 + ((colB) ^ (((row) & 7) << 4)))
#define SBAR() __builtin_amdgcn_sched_barrier(0)
__device__ __forceinline__ int crow(int r, int hi) { return (r & 3) + 8 * (r >> 2) + 4 * hi; }
__device__ __forceinline__ unsigned cvtpk(float lo, float hi) { return pg8::cvt_pk_bf16(lo, hi); }
__device__ __forceinline__ void partialSM(f32x16& p0, f32x16& p1, float& m_reg, float& mn, float& alpha, float C, float thr) {
  float pmax = p0[0];
#pragma unroll
  for (int r = 1; r < 16; ++r) pmax = fmaxf(pmax, p0[r]);
#pragma unroll
  for (int r = 0; r < 16; ++r) pmax = fmaxf(pmax, p1[r]);
  { auto rr = __builtin_amdgcn_permlane32_swap(__float_as_uint(pmax), __float_as_uint(pmax), false, false);
    pmax = fmaxf(__uint_as_float(rr[0]), __uint_as_float(rr[1])); }
  if (__builtin_expect(__all(pmax - m_reg <= thr), 1)) { mn = m_reg; alpha = 1.f; }
  else { mn = fmaxf(m_reg, pmax); alpha = __builtin_amdgcn_exp2f((m_reg - mn) * C); m_reg = mn; }
  float mnC = -mn * C;
#pragma unroll
  for (int r = 0; r < 16; ++r) p0[r] = fmaf(p0[r], C, mnC);
#pragma unroll
  for (int r = 0; r < 16; ++r) p1[r] = fmaf(p1[r], C, mnC);
#pragma unroll
  for (int r = 0; r < 16; ++r) p0[r] = __builtin_amdgcn_exp2f(p0[r]);
}
__device__ __forceinline__ void finishSM(f32x16& p0, f32x16& p1, float alpha, float& l_reg, bf16x8& pa0, bf16x8& pa1, bf16x8& pa2, bf16x8& pa3) {
#pragma unroll
  for (int r = 0; r < 16; ++r) p1[r] = __builtin_amdgcn_exp2f(p1[r]);
  float ps = 0;
#pragma unroll
  for (int r = 0; r < 16; ++r) ps += p0[r];
#pragma unroll
  for (int r = 0; r < 16; ++r) ps += p1[r];
  { auto rr = __builtin_amdgcn_permlane32_swap(__float_as_uint(ps), __float_as_uint(ps), false, false);
    ps = __uint_as_float(rr[0]) + __uint_as_float(rr[1]); }
  l_reg = l_reg * alpha + ps;
#define PK4(P, BASE, OUT) do { unsigned a0 = cvtpk(P[BASE + 0], P[BASE + 1]), a1 = cvtpk(P[BASE + 2], P[BASE + 3]);   \
    unsigned b0 = cvtpk(P[BASE + 4], P[BASE + 5]), b1 = cvtpk(P[BASE + 6], P[BASE + 7]);                              \
    auto r0 = __builtin_amdgcn_permlane32_swap(a0, b0, false, false); auto r1 = __builtin_amdgcn_permlane32_swap(a1, b1, false, false); \
    u32x4v w = {r0[0], r1[0], r0[1], r1[1]}; OUT = *reinterpret_cast<bf16x8*>(&w); } while (0)
  PK4(p0, 0, pa0); PK4(p0, 8, pa1); PK4(p1, 0, pa2); PK4(p1, 8, pa3);
#undef PK4
}
template <int ND0>
__device__ __forceinline__ void qkt(f32x16& p0, f32x16& p1, const lchar* Ks, const bf16x8* qr, int r32, int hi, int colx) {
  p0 = f32x16{}; p1 = f32x16{};
  int A = ND0 == 4 ? r32 * 128 + ((hi * 16) ^ ((r32 & 7) << 4)) : (r32 * 256 + ((hi * 16) ^ ((r32 & 7) << 4))) ^ colx; asm volatile("" : "+v"(A));
#pragma unroll
  for (int d0 = 0; d0 < ND0; ++d0) { const int off = A ^ (d0 * 32);
    bf16x8 b0 = *reinterpret_cast<const LAS bf16x8*>(Ks + off);
    bf16x8 b1 = *reinterpret_cast<const LAS bf16x8*>(Ks + off + (ND0 == 4 ? 4096 : 8192));
    p0 = __builtin_amdgcn_mfma_f32_32x32x16_bf16(b0, qr[d0], p0, 0, 0, 0);
    p1 = __builtin_amdgcn_mfma_f32_32x32x16_bf16(b1, qr[d0], p1, 0, 0, 0); }
}
__device__ __forceinline__ void mask_tile(f32x16& p0, f32x16& p1, int kp0, int qp, int hi) {
  const int dlt = kp0 - qp;
#pragma unroll
  for (int r = 0; r < 16; ++r) { const int k0 = dlt + crow(r, hi), k1 = k0 + 32;
    p0[r] = (k0 < -128 || k0 > 128) ? -1e30f : p0[r]; p1[r] = (k1 < -128 || k1 > 128) ? -1e30f : p1[r]; }
}
__device__ __forceinline__ int v_st(int k, int c) { const int kk = (k & ~0xC) | ((k & 4) << 1) | ((k & 8) >> 1); return ((kk >> 3) * 4 + (c >> 5)) * 512 + ((kk & 7) * 32 + (c & 31)) * 2; }
__device__ __forceinline__ int v_rd_base(int lane) { return ((lane & 3) << 3) | (((lane >> 2) & 3) << 6) | (((lane >> 4) & 1) << 5) | (((lane >> 5) & 1) << 8); }
constexpr int v_rd_off(int d0, int ks, int half) { return d0 * 512 + ks * 4096 + half * 2048; }
template <int OFF> __device__ __forceinline__ s16x4 tr_read(int vb) {
  s16x4 r; asm volatile("ds_read_b64_tr_b16 %0, %1 offset:%2" : "=&v"(r) : "v"(vb), "i"(OFF) : "memory"); return r;
}
template <int D0> __device__ __forceinline__ void pv_one(f32x16& od, int vb, bf16x8 pa0, bf16x8 pa1, bf16x8 pa2, bf16x8 pa3) {
  const s16x4 l0 = tr_read<v_rd_off(D0, 0, 0)>(vb), h0 = tr_read<v_rd_off(D0, 0, 1)>(vb), l1 = tr_read<v_rd_off(D0, 1, 0)>(vb), h1 = tr_read<v_rd_off(D0, 1, 1)>(vb);
  const s16x4 l2 = tr_read<v_rd_off(D0, 2, 0)>(vb), h2 = tr_read<v_rd_off(D0, 2, 1)>(vb), l3 = tr_read<v_rd_off(D0, 3, 0)>(vb), h3 = tr_read<v_rd_off(D0, 3, 1)>(vb);
  asm volatile("s_waitcnt lgkmcnt(0)" ::: "memory"); SBAR();
#define PK(L, H) (bf16x8){L[0], L[1], L[2], L[3], H[0], H[1], H[2], H[3]}
  od = __builtin_amdgcn_mfma_f32_32x32x16_bf16(pa0, PK(l0, h0), od, 0, 0, 0);
  od = __builtin_amdgcn_mfma_f32_32x32x16_bf16(pa1, PK(l1, h1), od, 0, 0, 0);
  od = __builtin_amdgcn_mfma_f32_32x32x16_bf16(pa2, PK(l2, h2), od, 0, 0, 0);
  od = __builtin_amdgcn_mfma_f32_32x32x16_bf16(pa3, PK(l3, h3), od, 0, 0, 0);
#undef PK
}
__device__ __forceinline__ void pv_d0(f32x16* o, int vb, bf16x8 pa0, bf16x8 pa1, bf16x8 pa2, bf16x8 pa3) {
  pv_one<0>(o[0], vb, pa0, pa1, pa2, pa3); pv_one<1>(o[1], vb, pa0, pa1, pa2, pa3); pv_one<2>(o[2], vb, pa0, pa1, pa2, pa3); pv_one<3>(o[3], vb, pa0, pa1, pa2, pa3);
}
template <int TYPE>
__device__ __forceinline__ void attn_run(const bf16* __restrict__ Qb, const bf16* __restrict__ Kh, const bf16* __restrict__ Vh,
                                         int NT, int gap, int qp, int bs, int comp, lchar* lds, f32x16 (&o)[4], float& m_reg, float& l_reg) {
  constexpr int ldq = ZM_LD, ldv = ZM_LD, ldk = ZM_LD, ND0 = TYPE == 0 ? 4 : 8, SD = TYPE == 0 ? 2 : 1; constexpr bool mask = TYPE == 1;
  constexpr float C = (TYPE == 0 ? 0.125f : 0.08838834764831845f) * LOG2E, thr = 8.0f * LOG2E / C;
  int tid = threadIdx.x; asm volatile("" : "+v"(tid));
  const int wid = tid >> 6, lane = tid & 63, r32 = lane & 31, hi = lane >> 5;
  lchar* V_lds = lds; lchar* K_lds = lds + 2 * SHM_V;
  LAS float* wsf = (LAS float*)(lds + 2 * SHM_V + 2 * SHM_K) + wid * 64; LAS float* al_l = wsf + 32;
  m_reg = -1e30f; l_reg = 0.f;
#pragma unroll
  for (int d = 0; d < 4; ++d) o[d] = f32x16{};
  bf16x8 qr[ND0];
  const unsigned qro = (unsigned)((wid * 32 + r32) * ldq + hi * 8) * 2u + (unsigned)(comp * 128);
#pragma unroll
  for (int d0 = 0; d0 < ND0; ++d0) qr[d0] = *reinterpret_cast<const bf16x8*>((const char*)Qb + qro + d0 * 32);
  const int colx = comp * 128;
  const int sr = tid >> 4, sc = (tid & 15) * 8, vst0 = v_st(sr, sc);
  const int kr = tid >> 3, kc = tid & 7;
  const int kst0 = TYPE == 0 ? kr * 128 + ((kc * 16) ^ ((kr & 7) << 4)) : KSWZ(sr, sc * 2);
  const int vb0 = (int)(unsigned)(uintptr_t)V_lds + v_rd_base(lane);
  const unsigned vro = (unsigned)(sr * ldv + sc) * 2u, kro = TYPE == 0 ? (unsigned)(kr * ldk + comp * 64 + kc * 8) * 2u : (unsigned)(sr * ldk + sc) * 2u;
  bf16x8 vsA0, vsA1, ksA0, ksA1, vsB0, vsB1, ksB0, ksB1;
#define KOFF(j) (64 * (j) + ((j) >= 4 ? gap : 0))
#define SLOAD(S, j) do { const size_t k0_ = (size_t)KOFF(j); const char* vb_ = (const char*)Vh + k0_ * (size_t)(ldv * 2); const char* kb_ = (const char*)Kh + k0_ * (size_t)(ldk * 2); \
    vs##S##0 = *reinterpret_cast<const bf16x8*>(vb_ + vro); vs##S##1 = *reinterpret_cast<const bf16x8*>(vb_ + (size_t)(32 * ldv * 2) + vro); \
    ks##S##0 = *reinterpret_cast<const bf16x8*>(kb_ + kro); if (TYPE == 1) ks##S##1 = *reinterpret_cast<const bf16x8*>(kb_ + (size_t)(32 * ldk * 2) + kro); } while (0)
#define SWRITE(b, S) do { *(LAS bf16x8*)(V_lds + (b) * SHM_V + vst0) = vs##S##0; *(LAS bf16x8*)(V_lds + (b) * SHM_V + vst0 + 8192) = vs##S##1; \
    *(LAS bf16x8*)(K_lds + (b) * SHM_K + kst0) = ks##S##0; if (TYPE == 1) *(LAS bf16x8*)(K_lds + (b) * SHM_K + kst0 + 8192) = ks##S##1; } while (0)
#define SWAIT() do { if constexpr (SD == 2) asm volatile("s_waitcnt vmcnt(3)" ::: "memory");   else asm volatile("s_waitcnt vmcnt(0)" ::: "memory"); } while (0)
#define RESC(a) do { if (__any((a) < 1.f)) { if (hi == 0) al_l[r32] = (a); asm volatile("s_waitcnt lgkmcnt(0)" ::: "memory"); \
    _Pragma("unroll") for (int d = 0; d < 4; ++d) _Pragma("unroll") for (int r = 0; r < 16; ++r) o[d][r] *= al_l[crow(r, hi)]; } } while (0)
#define MASKT(P0, P1, j) do { if (mask && (j) >= 4) mask_tile(P0, P1, bs + 64 * ((j) - 4), qp, hi); } while (0)
  f32x16 pA0, pA1, pB0, pB1; float mnA, mnB, alA, alB; bf16x8 pa0, pa1, pa2, pa3;
  SLOAD(A, 0); asm volatile("s_waitcnt vmcnt(0)" ::: "memory"); SWRITE(0, A); __syncthreads();
  qkt<ND0>(pA0, pA1, K_lds, qr, r32, hi, colx); partialSM(pA0, pA1, m_reg, mnA, alA, C, thr);
  if constexpr (SD == 2) { SLOAD(B, 1); if (2 < NT) SLOAD(A, 2); SWAIT(); SWRITE(1, B); } else { SLOAD(A, 1); SWAIT(); SWRITE(1, A); }
  __syncthreads();
  for (int j = 1; j + 1 < NT; j += 2) {
    SBAR(); qkt<ND0>(pB0, pB1, K_lds + SHM_K, qr, r32, hi, colx); MASKT(pB0, pB1, j);
    finishSM(pA0, pA1, alA, l_reg, pa0, pa1, pa2, pa3); SBAR();
    if constexpr (SD == 2) { SLOAD(B, j + 2); } else { SLOAD(A, j + 1); } SBAR();
    pv_d0(o, vb0, pa0, pa1, pa2, pa3); partialSM(pB0, pB1, m_reg, mnB, alB, C, thr);
    __syncthreads(); SWAIT(); SWRITE(0, A);
    RESC(alB); __syncthreads();
    SBAR(); qkt<ND0>(pA0, pA1, K_lds, qr, r32, hi, colx); MASKT(pA0, pA1, j + 1);
    finishSM(pB0, pB1, alB, l_reg, pa0, pa1, pa2, pa3); SBAR();
    if constexpr (SD == 2) { if (j + 3 < NT) SLOAD(A, j + 3); } else { SLOAD(A, j + 2); } SBAR();
    pv_d0(o, vb0 + SHM_V, pa0, pa1, pa2, pa3); partialSM(pA0, pA1, m_reg, mnA, alA, C, thr);
    __syncthreads(); SWAIT(); if constexpr (SD == 2) { SWRITE(1, B); } else { SWRITE(1, A); }
    RESC(alA); __syncthreads();
  }
  SBAR(); qkt<ND0>(pB0, pB1, K_lds + SHM_K, qr, r32, hi, colx); MASKT(pB0, pB1, NT - 1);
  finishSM(pA0, pA1, alA, l_reg, pa0, pa1, pa2, pa3); SBAR();
  pv_d0(o, vb0, pa0, pa1, pa2, pa3); partialSM(pB0, pB1, m_reg, mnB, alB, C, thr);
  __syncthreads(); RESC(alB);
  finishSM(pB0, pB1, alB, l_reg, pa0, pa1, pa2, pa3); SBAR();
  pv_d0(o, vb0 + SHM_V, pa0, pa1, pa2, pa3);
  (void)mnA; (void)mnB; (void)vsB0; (void)vsB1; (void)ksB0; (void)ksB1;
#undef KOFF
#undef SLOAD
#undef SWRITE
#undef SWAIT
#undef RESC
#undef MASKT
}
}

template <int TYPE>
__device__ __forceinline__ void attn_unit(Frame& F, int l, int bh, int qb) {
  using namespace att;
  lchar* lds = (lchar*)F.lds;
  const int tid = F.tid, wid = tid >> 6, lane = tid & 63, r32 = lane & 31, hi = lane >> 5;
  LAS float* li_l = (LAS float*)(lds + 2 * SHM_V + 2 * SHM_K) + wid * 64;
  LAS unsigned* stash = (LAS unsigned*)(lds + STASH_OFF);
  const int b = bh >> 3, hd = bh & 7;
  const size_t row0 = (size_t)b * TOK, rowq = row0 + (qb < 0 ? 0 : CTXL + 256 * qb);
  constexpr float C = (TYPE == 0 ? 0.125f : 0.08838834764831845f) * LOG2E;
#pragma unroll 1
  for (int pass = 0; pass < (TYPE == 0 ? 2 : 1); ++pass) {
    const bf16* Zm = (const bf16*)(wsptr() + WS_Z);
    const bf16 *Q, *K, *V; int NT, gap = 0, bs = 0;
    if (TYPE == 0) { Q = Zm + rowq * ZM_LD + ZB_Q + hd * 128; K = Zm + row0 * ZM_LD + ZB_K + hd * 128; V = Zm + row0 * ZM_LD + ZB_V + hd * 128; NT = qb < 0 ? 4 : TOK / 64; }
    else { const int g = hd >> 2; Q = Zm + rowq * ZM_LD + ZC_Q + hd * 128; K = Zm + row0 * ZM_LD + ZC_K + g * 128; V = Zm + row0 * ZM_LD + ZC_V + g * 128;
      if (qb < 0) NT = 4; else { bs = 256 * qb - 128; if (bs < 0) bs = 0; int be = 256 * qb + 384; if (be > SEQ) be = SEQ; NT = 4 + (be - bs) / 64; gap = bs; } }
    const int qp = 256 * qb + wid * 32 + r32;
    f32x16 o[4]; float m_reg, l_reg;
    attn_run<TYPE>(Q, K, V, NT, gap, qp, bs, TYPE == 0 ? pass : 0, lds, o, m_reg, l_reg);
    if (TYPE == 1) { const float sk = inptr(15)[l * 8 + hd]; l_reg += __builtin_amdgcn_exp2f(sk * LOG2E - m_reg * C); }
    if (hi == 0) li_l[r32] = l_reg;
    asm volatile("s_waitcnt lgkmcnt(0)" ::: "memory");
#pragma unroll
    for (int r = 0; r < 16; ++r) { const float rl = __builtin_amdgcn_rcpf(li_l[crow(r, hi)]);
#pragma unroll
      for (int d0 = 0; d0 < 4; ++d0) o[d0][r] *= rl; }
    if (TYPE == 0 && pass == 0) {
#pragma unroll
      for (int d0 = 0; d0 < 4; ++d0)
#pragma unroll
        for (int r = 0; r < 16; r += 2) stash[(d0 * 8 + (r >> 1)) * 512 + tid] = cvtpk(o[d0][r], o[d0][r + 1]);
    } else {
      __syncthreads();
      lchar* SG = lds + wid * 8192;
      if (TYPE == 0) { const float lam = ((const float*)(wsptr() + WS_LAM))[l];
#pragma unroll
        for (int d0 = 0; d0 < 4; ++d0)
#pragma unroll
          for (int r = 0; r < 16; r += 2) { const unsigned w = stash[(d0 * 8 + (r >> 1)) * 512 + tid]; o[d0][r] = bflo(w) - lam * o[d0][r]; o[d0][r + 1] = bfhi(w) - lam * o[d0][r + 1]; } }
#pragma unroll
      for (int r = 0; r < 16; ++r)
#pragma unroll
        for (int d0 = 0; d0 < 4; ++d0) *(LAS unsigned short*)(SG + crow(r, hi) * 256 + (d0 * 32 + r32) * 2) = (unsigned short)(cvtpk(o[d0][r], o[d0][r]) & 0xffffu);
      asm volatile("s_waitcnt lgkmcnt(0)" ::: "memory");
      const int cc = lane & 15;
      bf16* Ow = (bf16*)(wsptr() + WS_A) + (size_t)(TYPE == 0 ? 1 : 2) * M * BW + (rowq + wid * 32 + (lane >> 4)) * BW + hd * 128 + cc * 8;
      float gsc[8];
      if (TYPE == 0) { const float linit = 0.8f - 0.6f * __expf(-0.3f * (float)l); const float* sg = inptr(14) + (size_t)l * 128 + cc * 8;
#pragma unroll
        for (int j = 0; j < 8; ++j) gsc[j] = sg[j] * (1.0f - linit); }
#pragma unroll
      for (int i = 0; i < 8; ++i) {
        u32x4v v = *(const LAS u32x4v*)(SG + ((lane >> 4) + 4 * i) * 256 + cc * 16);
        if (TYPE == 0) { float f[8]; unpack8(v, f); float ss = 0.f;
#pragma unroll
          for (int j = 0; j < 8; ++j) ss += f[j] * f[j];
          ss += __shfl_xor(ss, 1); ss += __shfl_xor(ss, 2); ss += __shfl_xor(ss, 4); ss += __shfl_xor(ss, 8);
          const float rs = rsqrtf(ss * (1.f / 128.f) + EPS);
#pragma unroll
          for (int j = 0; j < 8; ++j) f[j] *= rs * gsc[j];
          v.x = cvtpk(f[0], f[1]); v.y = cvtpk(f[2], f[3]); v.z = cvtpk(f[4], f[5]); v.w = cvtpk(f[6], f[7]); }
        *(u32x4v*)(Ow + (size_t)(4 * i) * BW) = v;
      }
    }
    __syncthreads();
  }
}
__device__ __forceinline__ void attn_units(Frame& F, int l) {
  const int odd = F.vcu & 1, j = F.vcu >> 1;
#pragma unroll 1
  for (int k = 0; k < 5; ++k) {
    int bh, qb;
    if (k < 4) { const int U = k * 256 + F.vcu; bh = U >> 4; qb = U & 15; } else { if (!odd || j >= 64 || l == NL - 1) break; bh = j; qb = -1; }
#ifndef NO_AT0
    attn_unit<0>(F, l, bh, qb);
#endif
  }
  if (odd) {
#pragma unroll 1
    for (int k = 0; k < 9; ++k) {
      int bh, qb;
      if (k < 8) { const int U = k * 128 + j; bh = U >> 4; qb = U & 15; } else { if (j < 64 || l == NL - 1) break; bh = j - 64; qb = -1; }
#ifndef NO_AT1
      attn_unit<1>(F, l, bh, qb);
#endif
    }
  }
}

struct Args { const float* in[22]; float* out; unsigned char* ws; };
__global__ void __launch_bounds__(NWAVES * 64, 2) mk_fwd(Args args) {
    extern __shared__ __attribute__((aligned(16))) unsigned char lds[];
    LAS unsigned char* const ldsb = (LAS unsigned char*)lds;
    for (int u = threadIdx.x; u < (LDS_BYTES - LDSCTL_OFF) / 4; u += NWAVES * 64) ((LAS unsigned*)(ldsb + LDSCTL_OFF))[u] = 0u;
    __syncthreads();
    (void)xcd_barrier_post((unsigned*)(wsptr() + WS_CTL) + CW_BAR, (volatile LAS unsigned*)(ldsb + MISC_OFF) + 8);
#define GRID_BAR() do { XcdBarrier b_; b_.bar = (unsigned*)(wsptr() + WS_CTL) + CW_BAR; b_.x = xb_xcc_id(); b_.st = (volatile LAS unsigned*)(ldsb + MISC_OFF) + 8; xcd_barrier(b_); } while (0)
#define FRAME() Frame F = mkframe(ldsb)
#if PROBE_CLASS
#define PH_END(cls) do { if (threadIdx.x == 0) { volatile LAS unsigned long long* tw_ = (volatile LAS unsigned long long*)(ldsb + MISC_OFF + 64); const unsigned long long now_ = wall_clock64(); \
        if ((cls) == PROBE_CLASS || (PROBE_CLASS == 1 && (cls) >= 8 && (cls) <= 12) || (PROBE_CLASS == 40 && ((cls) == 3 || (cls) == 4 || (cls) == 7))) tw_[1] += now_ - tw_[0]; tw_[0] = now_; } } while (0)
#else
#define PH_END(cls) do { } while (0)
#endif
#define H    ((bf16*)(wsptr() + WS_H))
#define Zm   ((bf16*)(wsptr() + WS_Z))
#define Zg   ((bf16*)(wsptr() + WS_ZG))
#define BR   ((bf16*)(wsptr() + WS_A))
#define M2   ((bf16*)(wsptr() + WS_M2))
#define CX   ((float*)(wsptr() + WS_CX))
#define MIX  ((float*)(wsptr() + WS_Z))
#define UP   ((bf16*)(wsptr() + WS_Z))
#define ACT  ((bf16*)(wsptr() + WS_A))
#define mod  ((const float*)(wsptr() + WS_MOD))
#define WinT ((bf16*)(wsptr() + WS_W + W_IN))
#define WbT  ((bf16*)(wsptr() + WS_W + W_BR))
#define WoT  ((bf16*)(wsptr() + WS_W + W_OUT))
#define WupT ((bf16*)(wsptr() + WS_W + W_UP))
#define WdT  ((bf16*)(wsptr() + WS_W + W_DN))

#if PROBE_CLASS
    if (threadIdx.x == 0) { volatile LAS unsigned long long* tw_ = (volatile LAS unsigned long long*)(ldsb + MISC_OFF + 64); tw_[0] = wall_clock64(); tw_[1] = 0ull; }
#endif
    #ifndef NO_PRO
    { FRAME(); prologue_small(F); __syncthreads(); convert_weights(F, 0, 0, CVT_ALL, F.vcu * NWAVES + F.wave, GRID * NWAVES); }
#endif
    GRID_BAR();
    PH_END(7);
#ifndef NO_NORM
    { FRAME(); prenorm_phase(F, 0, inptr(0), inptr(2)); }
#endif
    GRID_BAR();
    PH_END(7);

    for (int l = 0; l < NL; ++l) {
#if !DBG_NO_MIX
#ifndef NO_G0
#if PROBE_CLASS == 20
        if (threadIdx.x == 0) { volatile LAS unsigned long long* tw_ = (volatile LAS unsigned long long*)(ldsb + MISC_OFF + 64); tw_[2] = clock64(); tw_[3] = wall_clock64(); }
#endif
        { FRAME(); pg8::Gemm g{H, WinT, M, ZM_LD, DM, 0, 0}; pg8::StaticOrder S; S.init(M, ZM_LD, F.G, (int)blockIdx.x);
          pg8::EpiZ E{Zm, Zg, (const float*)(wsptr() + WS_ROPE), (const float*)(wsptr() + WS_LB) + (size_t)l * 1024};
          pg8::gemm_phase<pg8::EpiZ, pg8::StaticOrder, true, true>(F.lds, g, S, E); }
        { FRAME(); pg8::Gemm g{(const bf16*)(wsptr() + WS_H8), (const bf16*)(wsptr() + WS_W + W_IN + W_G8), M, ZG_LD, DM / 2, 0, 0}; pg8::SubOrder S; S.base.init(M, ZG_LD, F.G, GRID - 1 - (int)blockIdx.x); S.lo = 0; S.hi = (M / 256) * (ZG_LD / 256) - G8_LATE;
          pg8::EpiG E{Zg, 1.0f / (H8_SCALE * W8_SCALE)};
          pg8::gemm_phase<pg8::EpiG, pg8::SubOrder, true, true, true>(F.lds, g, S, E); }
#endif
        GRID_BAR();
        PH_END(8);
#if PROBE_CLASS == 20
        if (threadIdx.x == 0) { volatile LAS unsigned long long* tw_ = (volatile LAS unsigned long long*)(ldsb + MISC_OFF + 64); const unsigned long long dc_ = clock64() - tw_[2], dw_ = wall_clock64() - tw_[3];
            if (l == 1) tw_[1] = (dc_ * 100ull / dw_) * 100ull; }
#endif
#if !DBG_NO_HGRN
        { FRAME(); if ((F.vcu & 1) == 0) { hgrn_unit(F, l, F.vcu >> 1); __syncthreads(); } }
        if (((int)blockIdx.x >> 3) & 1)
        { FRAME(); pg8::Gemm g{(const bf16*)(wsptr() + WS_H8), (const bf16*)(wsptr() + WS_W + W_IN + W_G8), M, ZG_LD, DM / 2, 0, 0}; pg8::SubOrder S; S.base.init(M, ZG_LD, F.G / 2, F.vcu >> 1); S.hi = (M / 256) * (ZG_LD / 256); S.lo = S.hi - G8_LATE;
          pg8::EpiG E{Zg, 1.0f / (H8_SCALE * W8_SCALE)};
          pg8::gemm_phase<pg8::EpiG, pg8::SubOrder, true, true, true>(F.lds, g, S, E); }
#else
        { FRAME(); const int gt = F.vcu * 512 + F.tid; u32x4v* p = (u32x4v*)(wsptr() + WS_H); for (size_t i = gt; i < (size_t)M * DM * 2 / 16; i += 256 * 512) p[i] = (u32x4v){0u, 0u, 0u, 0u}; }
#endif
#if !DBG_NO_ATTN
        { FRAME(); attn_units(F, l); }
#else
        { FRAME(); const int gt = F.vcu * 512 + F.tid; u32x4v* p = (u32x4v*)(wsptr() + WS_A + (size_t)M * BW * 2); for (size_t i = gt; i < (size_t)2 * M * BW * 2 / 16; i += 256 * 512) p[i] = (u32x4v){0u, 0u, 0u, 0u}; }
#endif
        GRID_BAR();
        PH_END(2);
#ifndef NO_FINA
        { FRAME(); finish_a_phase(F, l); }
#endif
        GRID_BAR();
        PH_END(4);
#ifndef NO_G1
        { FRAME(); pg8::Gemm g{BR, WbT, M, DM, BW, (size_t)M * BW * 2, (size_t)DM * BW * 2}; pg8::MergeOrder S; S.base.init(DM, l == NL - 1, F.G, (int)blockIdx.x);
          pg8::EpiMerge E{Zg, H};
          pg8::gemm_phase<pg8::EpiMerge, pg8::MergeOrder, true, true>(F.lds, g, S, E); }
#endif
        GRID_BAR();
        PH_END(9);
#ifndef NO_G2
        { FRAME(); pg8::Gemm g{H, WoT, M, DM, DM, 0, 0}; pg8::RowOrder S; S.init(DM, l == NL - 1, F.G, (int)blockIdx.x);
          pg8::EpiBf16<0> E{M2, DM, nullptr, 0, 0, 1.f};
          pg8::gemm_phase<pg8::EpiBf16<0>, pg8::RowOrder, true, true>(F.lds, g, S, E); }
#endif
        GRID_BAR();
        PH_END(10);
#endif
        { FRAME(); if (l == 0) post_pre_phase<true, 0>(F, l, false); else post_pre_phase<false, 0>(F, l, l == NL - 1); }
        GRID_BAR();
        PH_END(5);
#ifndef NO_G3
        { FRAME(); pg8::Gemm g{H, WupT, M, UP_LD, DM, 0, 0}; pg8::RowOrder S; S.init(UP_LD, l == NL - 1, F.G, (int)blockIdx.x);
          pg8::EpiConv E{ACT, (float*)(wsptr() + WS_Z), inptr(19) + (size_t)l * 3 * UP_LD, inptr(20) + (size_t)l * UP_LD};
          pg8::gemm_phase<pg8::EpiConv, pg8::RowOrder, true, true>(F.lds, g, S, E); }
#endif
        GRID_BAR();
        PH_END(11);
#ifndef NO_CONV
        { FRAME(); conv_fix_phase(F, l); }
#endif
        GRID_BAR();
        PH_END(6);
#ifndef NO_G4
        { FRAME(); pg8::Gemm g{ACT, WdT, M, DM, DFF, 0, 0}; pg8::RowOrder S; S.init(DM, l == NL - 1, F.G, (int)blockIdx.x);
          pg8::EpiBf16<0> E{H, DM, nullptr, 0, 0, 1.f};
          pg8::gemm_phase<pg8::EpiBf16<0>, pg8::RowOrder, true, true>(F.lds, g, S, E); }
#endif
        GRID_BAR();
        PH_END(12);
        { FRAME(); if (l == 0) post_pre_phase<true, 1>(F, l, false); else if (l + 1 < NL) post_pre_phase<false, 1>(F, l, false); else post_pre_phase<false, 3>(F, l, false);
          if (l + 1 < NL) { __syncthreads(); convert_weights(F, l + 1, 0, CVT_ALL, F.vcu * NWAVES + F.wave, GRID * NWAVES); } }
        GRID_BAR();
        PH_END(5);
    }
#if PROBE_CLASS
    if (blockIdx.x == 0 && threadIdx.x == 0) { volatile LAS unsigned long long* tw_ = (volatile LAS unsigned long long*)(ldsb + MISC_OFF + 64); const unsigned long long t0_ = wall_clock64(), d_ = tw_[1];
        while (wall_clock64() - t0_ < d_) __builtin_amdgcn_s_sleep(8); }
#endif
#undef GRID_BAR
#undef FRAME
#undef H
#undef Zm
#undef Zg
#undef BR
#undef M2
#undef CX
#undef MIX
#undef UP
#undef ACT
#undef mod
#undef WinT
#undef WbT
#undef WoT
#undef WupT
#undef WdT
}

extern "C" void kernel_launch(void* const* d_in, const int* in_sizes, int n_in, void* d_out, int out_size, void* d_ws, size_t ws_size, hipStream_t stream) {
    static int grid = 0;
    if (grid == 0) {
        if (n_in != 22 || in_sizes[0] != NB * SEQ * DM || out_size != NB * SEQ * DM || ws_size < WS_END) {
            fprintf(stderr, "kernel_launch: shape mismatch: n_in %d in0 %d out %d ws %zu (need %zu); nothing launched\n", n_in, n_in > 0 ? in_sizes[0] : -1, out_size, ws_size, (size_t)WS_END); grid = -1; return; }
        int dev = 0, cus = 0;
        if (hipGetDevice(&dev) != hipSuccess || hipDeviceGetAttribute(&cus, hipDeviceAttributeMultiprocessorCount, dev) != hipSuccess) { fprintf(stderr, "kernel_launch: device query failed\n"); grid = -1; return; }
        if (hipFuncSetAttribute((const void*)mk_fwd, hipFuncAttributeMaxDynamicSharedMemorySize, LDS_BYTES) != hipSuccess) { fprintf(stderr, "kernel_launch: hipFuncSetAttribute failed\n"); grid = -1; return; }
        int per_cu = 0;
        if (hipOccupancyMaxActiveBlocksPerMultiprocessor(&per_cu, (const void*)mk_fwd, NWAVES * 64, LDS_BYTES) != hipSuccess || per_cu < 1)
            fprintf(stderr, "kernel_launch: note: occupancy query reports %d workgroups per CU\n", per_cu);
        (void)hipGetLastError();
        if (cus < 256) { fprintf(stderr, "kernel_launch: needs 256 CUs (one resident workgroup each), device has %d; nothing launched\n", cus); grid = -1; return; }
        grid = 256;
    }
    if (grid < 0) return;
    if (hipMemsetAsync((char*)d_ws + WS_CTL, 0, CTL_ZERO_BYTES, stream) != hipSuccess) { fprintf(stderr, "kernel_launch: memset failed\n"); return; }
    Args a{};
    for (int i = 0; i < 22; ++i) a.in[i] = (const float*)d_in[i];
    a.out = (float*)d_out; a.ws = (unsigned char*)d_ws;
    hipLaunchKernelGGL(mk_fwd, dim3(grid), dim3(NWAVES * 64), LDS_BYTES, stream, a);
    const hipError_t le = hipPeekAtLastError();
    if (le != hipSuccess) fprintf(stderr, "kernel_launch: launch failed: %s\n", hipGetErrorName(le));
}
```

```cpp
#include <hip/hip_runtime.h>
#include <cstdio>
#include <cstdint>
#ifndef PROBE_CLASS
#define PROBE_CLASS 0
#endif
#ifndef DBG_NO_MIX
#define DBG_NO_MIX 0
#endif
#ifndef DBG_NO_HGRN
#define DBG_NO_HGRN 0
#endif
#ifndef DBG_NO_ATTN
#define DBG_NO_ATTN 0
#endif
#ifndef DBG_NO_FFN
#define DBG_NO_FFN 0
#endif
namespace pg8 {
#define PG8_LAS __attribute__((address_space(3)))
typedef unsigned short bf16_t;
typedef short bf16x8 __attribute__((ext_vector_type(8)));
typedef float f32x4 __attribute__((ext_vector_type(4)));
typedef unsigned u32x4 __attribute__((ext_vector_type(4)));
typedef int i32x4 __attribute__((ext_vector_type(4)));
typedef int i32x8 __attribute__((ext_vector_type(8)));
constexpr int BM = 256, BK = 64, HALF = 128, HTB = HALF * BK * 2  , STAGE_BYTES = 8 * HTB, NXCD = 8;

__host__ __device__ __forceinline__ int lds_byte(int r, int c) { const int st = (r >> 4) * 2 + (c >> 5), rr = r & 15, cc = c & 31, ob = rr * 64 + cc * 2; return st * 1024 + (ob ^ (((ob >> 9) & 1) << 5)); }
__host__ __device__ __forceinline__ void stage_rc(int b, int& R, int& C) { const int st = b / 1024, sb = b % 1024, swz = sb ^ (((sb >> 9) & 1) << 5); R = (st >> 1) * 16 + swz / 64; C = (st & 1) * 32 + (swz % 64) / 2; }
__host__ __device__ __forceinline__ int perm32(int rho) { const int n = rho >> 4, i = rho & 15; return 8 * (i >> 2) + 4 * n + (i & 3); }

struct Unit { int pm, pn, kz; };
struct Gemm { const bf16_t* A; const bf16_t* Bt; int M, N, K; size_t kzA, kzB; };

struct StaticOrder {
    int nM, nN, nwg, G, c, WGM;
    __host__ __device__ void init(int M, int N, int G_, int c_, int wgm = 4) { nM = M / BM; nN = N / BM; nwg = nM * nN; G = G_; c = c_; WGM = wgm; }
    __host__ __device__ bool next(int i, Unit& u) const { return at((long)i * G + c, u); }
    __host__ __device__ bool at(long L, Unit& u) const {
        if (L >= nwg) return false;
        int wgid = (int)L; { const int q = nwg / NXCD, r = nwg % NXCD, xcd = wgid % NXCD, off = wgid / NXCD; wgid = (xcd < r ? xcd * (q + 1) : r * (q + 1) + (xcd - r) * q) + off; }
        const int nig = WGM * nN, gid = wgid / nig, fm = gid * WGM, gsz = (nM - fm) < WGM ? (nM - fm) : WGM;
        u.pm = fm + ((wgid % nig) % gsz); u.pn = (wgid % nig) / gsz; u.kz = 0; return true;
    }
    __device__ __forceinline__ void a_ready(const Unit&) const {}
    __device__ __forceinline__ void done(const Unit&) const {}
};

struct SubOrder {
    StaticOrder base; int lo, hi;
    __device__ __forceinline__ bool next(int i, Unit& u) const { const long L = (long)lo + (long)i * base.G + base.c; if (L >= hi) return false; return base.at(L, u); }
    __device__ __forceinline__ void a_ready(const Unit&) const {}
    __device__ __forceinline__ void done(const Unit&) const {}
};

typedef float f32x2c_t __attribute__((ext_vector_type(2))); typedef __bf16 bf16x2c_t __attribute__((ext_vector_type(2)));
__device__ __forceinline__ unsigned cvt_pk_bf16(float lo, float hi) { f32x2c_t v = {lo, hi}; bf16x2c_t b = __builtin_convertvector(v, bf16x2c_t); return __builtin_bit_cast(unsigned, b); }
typedef float f32x2 __attribute__((ext_vector_type(2)));
__device__ __forceinline__ f32x2 gelu_pk(f32x2 v) {
    const f32x2 av = __builtin_elementwise_abs(v), d = av * 0.2316418882f + 1.0f;
    f32x2 t; t.x = __builtin_amdgcn_rcpf(d.x); t.y = __builtin_amdgcn_rcpf(d.y);
    f32x2 q = t * 0.5307027145f + (-0.7265760135f); q = q * t + 0.7107068705f; q = q * t + (-0.142248368f); q = q * t + 0.127414796f; q = q * t;
    const f32x2 s = (v * v) * (-0.72134752044f);
    f32x2 e; e.x = __builtin_amdgcn_exp2f(s.x); e.y = __builtin_amdgcn_exp2f(s.y);
    const f32x2 m = v * (q * e), r = v - m;
    f32x2 o; o.x = v.x < 0.f ? m.x : r.x; o.y = v.y < 0.f ? m.y : r.y; return o;
}

template <int ACT  > struct EpiBf16 {
    static constexpr bool PERM = true, AFTER_DRAIN = false; static_assert(ACT == 0 || ACT == 1, "EpiBf16: ACT is 0 (none) or 1 (gelu_pk)");
    bf16_t* O; int ldc; const float* bias; int split_cols; size_t split_stride; float scale0;
    __device__ __forceinline__ void operator()(const f32x4 (&acc)[2][2][4][2], const Unit& u, int wr, int wc, int fr, int fq) const {
        const int row0 = u.pm * BM + wr * 64 + fr; int colt = u.pn * BM; bf16_t* base = O;
        float sc = 1.f; if (split_cols) { const int t = colt / split_cols; base += (size_t)t * split_stride; colt -= t * split_cols; if (t == 0) sc = scale0; }
        const int col0 = colt + wc * 32 + 8 * fq, bcol0 = u.pn * BM + wc * 32 + 8 * fq;
        f32x4 bv[2][2];
#pragma unroll
        for (int bj = 0; bj < 2; ++bj)
#pragma unroll
            for (int n = 0; n < 2; ++n) bv[bj][n] = bias ? *(const f32x4*)(bias + bcol0 + bj * HALF + 4 * n) : (f32x4){0.f, 0.f, 0.f, 0.f};
#pragma unroll
        for (int ai = 0; ai < 2; ++ai)
#pragma unroll
            for (int m = 0; m < 4; ++m) { bf16_t* rowp = base + (size_t)(row0 + ai * HALF + m * 16) * ldc + col0;
#pragma unroll
                for (int bj = 0; bj < 2; ++bj) { f32x4 v0 = acc[ai][bj][m][0] + bv[bj][0], v1 = acc[ai][bj][m][1] + bv[bj][1];
                    if (ACT == 1) { f32x2 a = gelu_pk((f32x2){v0[0], v0[1]}), b = gelu_pk((f32x2){v0[2], v0[3]}), c = gelu_pk((f32x2){v1[0], v1[1]}), d = gelu_pk((f32x2){v1[2], v1[3]});
                        v0 = (f32x4){a.x, a.y, b.x, b.y}; v1 = (f32x4){c.x, c.y, d.x, d.y}; }
                    v0 = v0 * sc; v1 = v1 * sc; u32x4 w; w.x = cvt_pk_bf16(v0[0], v0[1]); w.y = cvt_pk_bf16(v0[2], v0[3]); w.z = cvt_pk_bf16(v1[0], v1[1]); w.w = cvt_pk_bf16(v1[2], v1[3]);
                    *(u32x4*)(rowp + bj * HALF) = w; } }
    }
};


__device__ __forceinline__ float sigmoid_f(float x) { return __builtin_amdgcn_rcpf(1.0f + __expf(-x)); }
__device__ __forceinline__ f32x4 ld_sc1_f32x4(const float* p) { f32x4 v; asm volatile("global_load_dwordx4 %0, %1, off sc1\n\ts_waitcnt vmcnt(0)" : "=v"(v) : "v"(p) : "memory"); return v; }
struct EpiZ {
    static constexpr bool PERM = true, AFTER_DRAIN = false;
    bf16_t* Zm; bf16_t* Zg; const float* rp; const float* lbl;
    __device__ __forceinline__ void operator()(const f32x4 (&acc)[2][2][4][2], const Unit& u, int wr, int wc, int fr, int fq) const {
        const int row0 = u.pm * BM + wr * 64 + fr;
        const bool mainz = u.pn < 38; bf16_t* base = mainz ? Zm : Zg; const int ldc = mainz ? 9728 : 6144; const int colt = (mainz ? u.pn : u.pn - 38) * BM;
        const int col0 = colt + wc * 32 + 8 * fq;
        const bool ropeb = (u.pn >= 20) && (u.pn < 28), ropec = (u.pn >= 32) && (u.pn < 37), rope = ropeb || ropec;
        const float sgn = fq < 2 ? -1.0f : 1.0f;
        const int tab = ropeb ? 0 : 2048, tsn = ropeb ? 1024 : 2048, tpitch = ropeb ? 16 : 32, ti = (ropeb ? 0 : 16 * (wc & 1)) + 8 * (fq & 1);
        const bool colpart = ropeb ? (wc & 1) : (wc >> 1);
#pragma unroll
        for (int ai = 0; ai < 2; ++ai)
#pragma unroll
            for (int m = 0; m < 4; ++m) { const int r = row0 + ai * HALF + m * 16; bf16_t* rowp = base + (size_t)r * ldc + col0;
                f32x4 cs0 = {1.f, 1.f, 1.f, 1.f}, cs1 = cs0, sn0 = {0.f, 0.f, 0.f, 0.f}, sn1 = sn0;
                if (rope) { const int bb = r / 4352, p = r - bb * 4352;
                    if (p >= 256) { const int n = p - 256, pos = colpart ? (n & 63) : (n >> 6); const float* t = rp + tab + pos * tpitch + ti;
                        cs0 = *(const f32x4*)t; cs1 = *(const f32x4*)(t + 4); sn0 = *(const f32x4*)(t + tsn) * sgn; sn1 = *(const f32x4*)(t + tsn + 4) * sgn; } }
#pragma unroll
                for (int bj = 0; bj < 2; ++bj) { f32x4 v0 = acc[ai][bj][m][0], v1 = acc[ai][bj][m][1];
                    if (u.pn < 4) {
#pragma unroll
                        for (int j = 0; j < 4; ++j) { v0[j] = v0[j] * sigmoid_f(v0[j]); v1[j] = v1[j] * sigmoid_f(v1[j]); } }
                    if (u.pn >= 4 && u.pn < 12) {
                        const int cc = colt + wc * 32 + 8 * fq + bj * HALF - 1024, dir = cc >> 10; const float* lp = lbl + dir * (4 * 1024) + (cc & 1023);
                        const f32x4 l0 = *(const f32x4*)lp, l1 = *(const f32x4*)(lp + 4);
#pragma unroll
                        for (int j = 0; j < 4; ++j) { v0[j] = l0[j] + (1.0f - l0[j]) * sigmoid_f(v0[j]); v1[j] = l1[j] + (1.0f - l1[j]) * sigmoid_f(v1[j]); } }
                    if (rope) { f32x4 p0, p1;
#pragma unroll
                        for (int j = 0; j < 4; ++j) { p0[j] = __shfl_xor(v0[j], 32); p1[j] = __shfl_xor(v1[j], 32); }
                        v0 = v0 * cs0 + p0 * sn0; v1 = v1 * cs1 + p1 * sn1; }
                    u32x4 w; w.x = cvt_pk_bf16(v0[0], v0[1]); w.y = cvt_pk_bf16(v0[2], v0[3]); w.z = cvt_pk_bf16(v1[0], v1[1]); w.w = cvt_pk_bf16(v1[2], v1[3]);
                    *(u32x4*)(rowp + bj * HALF) = w; } }
    }
};
struct EpiG {
    static constexpr bool PERM = true, AFTER_DRAIN = false;
    bf16_t* Zg; float sc;
    __device__ __forceinline__ void operator()(const f32x4 (&acc)[2][2][4][2], const Unit& u, int wr, int wc, int fr, int fq) const {
        const int row0 = u.pm * BM + wr * 64 + fr, col0 = u.pn * BM + wc * 32 + 8 * fq;
#pragma unroll
        for (int ai = 0; ai < 2; ++ai)
#pragma unroll
            for (int m = 0; m < 4; ++m) { bf16_t* rowp = Zg + (size_t)(row0 + ai * HALF + m * 16) * 6144 + col0;
#pragma unroll
                for (int bj = 0; bj < 2; ++bj) { const f32x4 v0 = acc[ai][bj][m][0] * sc, v1 = acc[ai][bj][m][1] * sc;
                    u32x4 w; w.x = cvt_pk_bf16(v0[0], v0[1]); w.y = cvt_pk_bf16(v0[2], v0[3]); w.z = cvt_pk_bf16(v1[0], v1[1]); w.w = cvt_pk_bf16(v1[2], v1[3]);
                    *(u32x4*)(rowp + bj * HALF) = w; } }
    }
};
struct EpiMerge {
    static constexpr bool PERM = true, AFTER_DRAIN = false;
    const bf16_t* Zg; bf16_t* out;
    __device__ __forceinline__ void operator()(const f32x4 (&acc)[2][2][4][2], const Unit& u, int wr, int wc, int fr, int fq) const {
        const int row0 = u.pm * BM + wr * 64 + fr, col0 = u.pn * BM + wc * 32 + 8 * fq, n = u.kz;
        u32x4 gA0, gA1, pA0 = {0u, 0u, 0u, 0u}, pA1 = pA0, gB0, gB1, pB0 = pA0, pB1 = pA0;
#define EM_LOAD(HP, S, AI, MM) do { const size_t row_ = (size_t)(row0 + (AI) * HALF + (MM) * 16); const bf16_t* gp_ = Zg + row_ * 6144 + (size_t)n * 2048 + col0; const bf16_t* op_ = out + row_ * 2048 + col0; \
        asm volatile("global_load_dwordx4 %0, %1, off" : "=v"(g##S##0) : "v"(gp_) : "memory"); asm volatile("global_load_dwordx4 %0, %1, off offset:256" : "=v"(g##S##1) : "v"(gp_) : "memory"); \
        if (HP) { asm volatile("global_load_dwordx4 %0, %1, off sc1" : "=v"(p##S##0) : "v"(op_) : "memory"); asm volatile("global_load_dwordx4 %0, %1, off offset:256 sc1" : "=v"(p##S##1) : "v"(op_) : "memory"); } } while (0)
#define EM_WAIT(HP, S, LASTG) do { if (HP) { if (LASTG) asm volatile("s_waitcnt vmcnt(0)" : "+v"(g##S##0), "+v"(g##S##1), "+v"(p##S##0), "+v"(p##S##1) :: "memory"); \
                                              else asm volatile("s_waitcnt vmcnt(4)" : "+v"(g##S##0), "+v"(g##S##1), "+v"(p##S##0), "+v"(p##S##1) :: "memory"); } \
        else { if (LASTG) asm volatile("s_waitcnt vmcnt(0)" : "+v"(g##S##0), "+v"(g##S##1) :: "memory"); else asm volatile("s_waitcnt vmcnt(2)" : "+v"(g##S##0), "+v"(g##S##1) :: "memory"); } } while (0)
#define EM_PROC(HP, S, AI, MM) do { const size_t row_ = (size_t)(row0 + (AI) * HALF + (MM) * 16); bf16_t* op_ = out + row_ * 2048 + col0; \
        _Pragma("unroll") for (int bj = 0; bj < 2; ++bj) { const u32x4 gw = bj ? g##S##1 : g##S##0, pp = bj ? p##S##1 : p##S##0; \
            f32x4 g0, g1; \
            g0[0] = sigmoid_f(__uint_as_float(gw.x << 16)); g0[1] = sigmoid_f(__uint_as_float(gw.x & 0xffff0000u)); \
            g0[2] = sigmoid_f(__uint_as_float(gw.y << 16)); g0[3] = sigmoid_f(__uint_as_float(gw.y & 0xffff0000u)); \
            g1[0] = sigmoid_f(__uint_as_float(gw.z << 16)); g1[1] = sigmoid_f(__uint_as_float(gw.z & 0xffff0000u)); \
            g1[2] = sigmoid_f(__uint_as_float(gw.w << 16)); g1[3] = sigmoid_f(__uint_as_float(gw.w & 0xffff0000u)); \
            f32x4 v0 = acc[AI][bj][MM][0] * g0, v1 = acc[AI][bj][MM][1] * g1; \
            if (HP) { v0[0] += __uint_as_float(pp.x << 16); v0[1] += __uint_as_float(pp.x & 0xffff0000u); v0[2] += __uint_as_float(pp.y << 16); v0[3] += __uint_as_float(pp.y & 0xffff0000u); \
                      v1[0] += __uint_as_float(pp.z << 16); v1[1] += __uint_as_float(pp.z & 0xffff0000u); v1[2] += __uint_as_float(pp.w << 16); v1[3] += __uint_as_float(pp.w & 0xffff0000u); } \
            u32x4 w; w.x = cvt_pk_bf16(v0[0], v0[1]); w.y = cvt_pk_bf16(v0[2], v0[3]); w.z = cvt_pk_bf16(v1[0], v1[1]); w.w = cvt_pk_bf16(v1[2], v1[3]); \
            *(u32x4*)(op_ + bj * HALF) = w; } \
        asm volatile("" ::: "memory"); } while (0)
#define EM_SEQ(HP) do { \
        EM_LOAD(HP, A, 0, 0); \
        EM_LOAD(HP, B, 0, 1); EM_WAIT(HP, A, 0); EM_PROC(HP, A, 0, 0); \
        EM_LOAD(HP, A, 0, 2); EM_WAIT(HP, B, 0); EM_PROC(HP, B, 0, 1); \
        EM_LOAD(HP, B, 0, 3); EM_WAIT(HP, A, 0); EM_PROC(HP, A, 0, 2); \
        EM_LOAD(HP, A, 1, 0); EM_WAIT(HP, B, 0); EM_PROC(HP, B, 0, 3); \
        EM_LOAD(HP, B, 1, 1); EM_WAIT(HP, A, 0); EM_PROC(HP, A, 1, 0); \
        EM_LOAD(HP, A, 1, 2); EM_WAIT(HP, B, 0); EM_PROC(HP, B, 1, 1); \
        EM_LOAD(HP, B, 1, 3); EM_WAIT(HP, A, 0); EM_PROC(HP, A, 1, 2); \
        EM_WAIT(HP, B, 1); EM_PROC(HP, B, 1, 3); } while (0)
        if (n > 0) EM_SEQ(1); else EM_SEQ(0);
#undef EM_SEQ
#undef EM_LOAD
#undef EM_WAIT
#undef EM_PROC
    }
};
struct RowOrder {
    StaticOrder base; int lat;
    __device__ __forceinline__ void init(int N, int lat_, int G, int c, int wgm = 4) { lat = lat_; base.init(lat_ ? 32768 : 34816, N, G, c, wgm); }
    __device__ __forceinline__ bool next(int i, Unit& u) const { if (!base.next(i, u)) return false; if (lat) u.pm += u.pm / 16 + 1; return true; }
    __device__ __forceinline__ void a_ready(const Unit&) const {}
    __device__ __forceinline__ void done(const Unit&) const {}
};
struct MergeOrder {
    RowOrder base;
    __device__ __forceinline__ bool next(int i, Unit& u) const { const int ti = i / 3; if (!base.next(ti, u)) return false; u.kz = i - 3 * ti; return true; }
    __device__ __forceinline__ void a_ready(const Unit&) const {}
    __device__ __forceinline__ void done(const Unit&) const {}
};


template <int CTRL> __device__ __forceinline__ float dppf(float old, float src) { return __builtin_bit_cast(float, __builtin_amdgcn_update_dpp(__builtin_bit_cast(int, old), __builtin_bit_cast(int, src), CTRL, 0xf, 0xf, false)); }
__device__ __forceinline__ f32x4 row_next(const f32x4 cur, const f32x4 nreg) {
    f32x4 r;
#pragma unroll
    for (int e = 0; e < 4; ++e) { const float y = dppf<0x11F>(0.f, nreg[e]); r[e] = dppf<0x101>(y, cur[e]); }
    return r; }
__device__ __forceinline__ f32x4 row_prev(const f32x4 cur, const f32x4 preg) {
    f32x4 r;
#pragma unroll
    for (int e = 0; e < 4; ++e) { const float y = dppf<0x10F>(0.f, preg[e]); r[e] = dppf<0x111>(y, cur[e]); }
    return r; }
struct EpiConv {
    static constexpr bool PERM = true, AFTER_DRAIN = false;
    bf16_t* ACT; float* SB; const float* cw; const float* cb;
    __device__ __forceinline__ void operator()(const f32x4 (&acc)[2][2][4][2], const Unit& u, int wr, int wc, int fr, int fq) const {
        const int ch0 = u.pn * 128 + wc * 32 + 8 * fq; const f32x4 z4 = {0.f, 0.f, 0.f, 0.f};
#pragma unroll
        for (int n = 0; n < 2; ++n) { const int ch = ch0 + 4 * n;
            const f32x4 wa0 = *(const f32x4*)(cw + ch), wa1 = *(const f32x4*)(cw + 11264 + ch), wa2 = *(const f32x4*)(cw + 22528 + ch), ba = *(const f32x4*)(cb + ch);
            const f32x4 wv0 = *(const f32x4*)(cw + 5632 + ch), wv1 = *(const f32x4*)(cw + 11264 + 5632 + ch), wv2 = *(const f32x4*)(cw + 22528 + 5632 + ch), bv = *(const f32x4*)(cb + 5632 + ch);
#pragma unroll
            for (int ai = 0; ai < 2; ++ai) { const int gb = 4 * u.pm + 2 * ai + wr;
#pragma unroll
                for (int m = 0; m < 4; ++m) {
                    const f32x4 A = acc[ai][0][m][n], V = acc[ai][1][m][n];
                    const f32x4 An = m < 3 ? acc[ai][0][m < 3 ? m + 1 : 3][n] : z4, Ap = m > 0 ? acc[ai][0][m > 0 ? m - 1 : 0][n] : z4;
                    const f32x4 Vn = m < 3 ? acc[ai][1][m < 3 ? m + 1 : 3][n] : z4, Vp = m > 0 ? acc[ai][1][m > 0 ? m - 1 : 0][n] : z4;
                    const f32x4 cA = wa0 * row_prev(A, Ap) + wa1 * A + wa2 * row_next(A, An) + ba;
                    const f32x4 cV = wv0 * row_prev(V, Vp) + wv1 * V + wv2 * row_next(V, Vn) + bv;
                    const bool e0 = (m == 0) && (fr == 0), e1 = (m == 3) && (fr == 15);
                    if (e0 || e1) { float* sb = SB + ((size_t)(gb * 2 + (e1 ? 1 : 0)) * 4) * 5632 + ch;
                        *(f32x4*)sb = A; *(f32x4*)(sb + 5632) = V; *(f32x4*)(sb + 2 * 5632) = cA; *(f32x4*)(sb + 3 * 5632) = cV; }
                    else { f32x4 o;
#pragma unroll
                        for (int e2 = 0; e2 < 4; ++e2) o[e2] = cA[e2] * sigmoid_f(cA[e2]) * cV[e2];
                        *(unsigned long long*)(ACT + (size_t)(64 * gb + 16 * m + fr) * 5632 + ch) = (unsigned long long)cvt_pk_bf16(o[0], o[1]) | ((unsigned long long)cvt_pk_bf16(o[2], o[3]) << 32); } } } }
    }
};

template <class Epi, class Sched, bool ALIGN_EPI = false, bool SP2 = false, bool FP8 = false>
__device__ __forceinline__ void gemm_phase(PG8_LAS unsigned char* lds, const Gemm g, const Sched& S, const Epi& E) {
    int tid = threadIdx.x; asm volatile("" : "+v"(tid));
    const int wid = __builtin_amdgcn_readfirstlane(tid >> 6), lane = tid & 63, wr = wid >> 2, wc = wid & 3, fr = lane & 15, fq = lane >> 4;
    const int K = g.K, nt = K / BK;
    unsigned voffA[2], voffB[2];
#pragma unroll
    for (int i = 0; i < 2; ++i) { int R, C; stage_rc(tid * 16 + i * 8192, R, C); const int Rb = Epi::PERM ? ((R & ~31) + perm32(R & 31)) : R;
        voffA[i] = (unsigned)(R * K + C) * 2u; voffB[i] = (unsigned)(Rb * K + C) * 2u; }
    const size_t kstep = (size_t)(BK * 2);
    const size_t hstep = (size_t)HALF * K * 2;
    const size_t tstep = 2 * hstep;
    const unsigned ldsw = (unsigned)wid * 1024u;
    const int aoff = lds_byte(wr * 64 + fr, fq * 8), boff = lds_byte(wc * 32 + fr, fq * 8);
#define PG8_SA(b, h) (((b) * 2 + (h)) * HTB)
#define PG8_SB(b, h) ((4 + (b) * 2 + (h)) * HTB)
#define PG8_STAGE(bufoff, gbase, voff) do { _Pragma("unroll") for (int _i = 0; _i < 2; ++_i) \
        __builtin_amdgcn_global_load_lds((const unsigned*)((const char*)(gbase) + (voff)[_i]), (PG8_LAS unsigned*)(lds + (bufoff) + ldsw + _i * 8192), 16, 0, 0); } while (0)
#define PG8_LD2(p) __builtin_shufflevector(*(const PG8_LAS i32x4*)(p), *(const PG8_LAS i32x4*)((p) + 1024), 0, 1, 2, 3, 4, 5, 6, 7)
#define PG8_LDA(dst, b, h) do { _Pragma("unroll") for (int m = 0; m < 4; ++m) dst[m] = PG8_LD2(lds + PG8_SA(b, h) + aoff + m * 2048); } while (0)
#define PG8_LDB(dst, b, h) do { _Pragma("unroll") for (int n = 0; n < 2; ++n) dst[n] = PG8_LD2(lds + PG8_SB(b, h) + boff + n * 2048); } while (0)
#define PG8_LOH(v) __builtin_bit_cast(bf16x8, __builtin_shufflevector(v, v, 0, 1, 2, 3))
#define PG8_HIH(v) __builtin_bit_cast(bf16x8, __builtin_shufflevector(v, v, 4, 5, 6, 7))
#define PG8_MMA(ai, bj, At, Bt) do { __builtin_amdgcn_s_setprio(1); \
        if constexpr (FP8) { _Pragma("unroll") for (int m = 0; m < 4; ++m) _Pragma("unroll") for (int n = 0; n < 2; ++n) \
            asm("v_mfma_scale_f32_16x16x128_f8f6f4 %0, %1, %2, %0, %3, %3 op_sel_hi:[0,0,0]" : "+v"(acc[ai][bj][m][n]) : "v"(Bt[n]), "v"(At[m]), "v"(sc8)); } \
        else { _Pragma("unroll") for (int m = 0; m < 4; ++m) _Pragma("unroll") for (int n = 0; n < 2; ++n) { \
            acc[ai][bj][m][n] = __builtin_amdgcn_mfma_f32_16x16x32_bf16(PG8_LOH(Bt[n]), PG8_LOH(At[m]), acc[ai][bj][m][n], 0, 0, 0); \
            acc[ai][bj][m][n] = __builtin_amdgcn_mfma_f32_16x16x32_bf16(PG8_HIH(Bt[n]), PG8_HIH(At[m]), acc[ai][bj][m][n], 0, 0, 0); } } \
        __builtin_amdgcn_s_setprio(0); } while (0)
#define PG8_WAIT_V(n) asm volatile("s_waitcnt vmcnt(" #n ")" ::: "memory")
#define PG8_WAIT_L(n) asm volatile("s_waitcnt lgkmcnt(" #n ")" ::: "memory")
#define PG8_BAR __builtin_amdgcn_s_barrier()
#define PG8_SCHED __builtin_amdgcn_sched_barrier(0)
    Unit cur, nxt; int ui = 0;
    if (!S.next(0, cur)) return;
    f32x4 acc[2][2][4][2];
#pragma unroll
    for (int a = 0; a < 2; ++a)
#pragma unroll
        for (int b = 0; b < 2; ++b)
#pragma unroll
            for (int m = 0; m < 4; ++m)
#pragma unroll
                for (int n = 0; n < 2; ++n) acc[a][b][m][n] = (f32x4){0.f, 0.f, 0.f, 0.f};
    const int sc8 = 0x7F7F7F7F;
    i32x8 At[4], B0[2], B1[2];
    const char* cA = (const char*)g.A + (size_t)cur.pm * tstep + (size_t)cur.kz * g.kzA; const char* cB = (const char*)g.Bt + (size_t)cur.pn * tstep + (size_t)cur.kz * g.kzB;
    S.a_ready(cur);
    if constexpr (SP2) {
        PG8_STAGE(PG8_SB(0, 0), cB, voffB); PG8_STAGE(PG8_SB(0, 1), cB + hstep, voffB); PG8_STAGE(PG8_SA(0, 0), cA, voffA); PG8_STAGE(PG8_SA(0, 1), cA + hstep, voffA);
        if (wr == 1) PG8_BAR;
        PG8_WAIT_V(2); PG8_BAR;
        PG8_STAGE(PG8_SB(1, 0), cB + kstep, voffB); PG8_STAGE(PG8_SA(1, 0), cA + kstep, voffA); PG8_STAGE(PG8_SB(1, 1), cB + hstep + kstep, voffB);
        PG8_WAIT_V(6); PG8_BAR;
    } else {
        PG8_STAGE(PG8_SB(0, 0), cB, voffB); PG8_STAGE(PG8_SA(0, 0), cA, voffA); PG8_STAGE(PG8_SB(0, 1), cB + hstep, voffB); PG8_STAGE(PG8_SA(0, 1), cA + hstep, voffA);
        if (wr == 1) PG8_BAR;
        PG8_WAIT_V(4); PG8_BAR;
        PG8_STAGE(PG8_SB(1, 0), cB + kstep, voffB); PG8_STAGE(PG8_SA(1, 0), cA + kstep, voffA); PG8_STAGE(PG8_SB(1, 1), cB + hstep + kstep, voffB);
        PG8_WAIT_V(6); PG8_BAR;
    }
    for (;;) {
        const bool has_next = S.next(ui + 1, nxt);
        const char* nA = has_next ? (const char*)g.A + (size_t)nxt.pm * tstep + (size_t)nxt.kz * g.kzA : cA; const char* nB = has_next ? (const char*)g.Bt + (size_t)nxt.pn * tstep + (size_t)nxt.kz * g.kzB : cB;
        for (int t = 0; t < nt; t += 2) {
            const bool last = (t == nt - 2);
            const char* a1 = cA + (size_t)(t + 1) * kstep;
            const char* a2 = last ? nA : cA + (size_t)(t + 2) * kstep; const char* b2 = last ? nB : cB + (size_t)(t + 2) * kstep;
            const char* a3 = a2 + kstep; const char* b3 = b2 + kstep;
            if (last && has_next) S.a_ready(nxt);
            if constexpr (SP2) {
            PG8_LDB(B0, 0, 0); PG8_LDB(B1, 0, 1); PG8_SCHED; PG8_LDA(At, 0, 0); PG8_STAGE(PG8_SA(1, 1), a1 + hstep, voffA);
            PG8_WAIT_V(8); PG8_WAIT_L(0); PG8_BAR; PG8_MMA(0, 0, At, B0); PG8_MMA(0, 1, At, B1); PG8_BAR; PG8_SCHED;
            PG8_LDA(At, 0, 1); PG8_STAGE(PG8_SB(0, 0), b2, voffB); PG8_STAGE(PG8_SB(0, 1), b2 + hstep, voffB); PG8_STAGE(PG8_SA(0, 0), a2, voffA);
            PG8_WAIT_V(8); PG8_WAIT_L(0); PG8_BAR; PG8_MMA(1, 0, At, B0); PG8_MMA(1, 1, At, B1); PG8_BAR; PG8_SCHED;
            PG8_LDB(B0, 1, 0); PG8_LDB(B1, 1, 1); PG8_SCHED; PG8_LDA(At, 1, 0); PG8_STAGE(PG8_SA(0, 1), a2 + hstep, voffA);
            PG8_WAIT_V(8); PG8_WAIT_L(0); PG8_BAR; PG8_MMA(0, 0, At, B0); PG8_MMA(0, 1, At, B1); PG8_BAR; PG8_SCHED;
            PG8_LDA(At, 1, 1); PG8_STAGE(PG8_SB(1, 0), b3, voffB); PG8_STAGE(PG8_SB(1, 1), b3 + hstep, voffB); PG8_STAGE(PG8_SA(1, 0), a3, voffA);
            PG8_WAIT_V(8); PG8_WAIT_L(0); PG8_BAR; PG8_MMA(1, 0, At, B0); PG8_MMA(1, 1, At, B1); PG8_BAR; PG8_SCHED;
            } else {
            PG8_LDB(B0, 0, 0); PG8_SCHED; PG8_LDA(At, 0, 0); PG8_STAGE(PG8_SA(1, 1), a1 + hstep, voffA);
            PG8_WAIT_L(8); PG8_BAR; PG8_WAIT_L(0); PG8_MMA(0, 0, At, B0); PG8_BAR; PG8_SCHED;
            PG8_LDB(B1, 0, 1); PG8_STAGE(PG8_SB(0, 0), b2, voffB);
            PG8_BAR; PG8_WAIT_L(0); PG8_MMA(0, 1, At, B1); PG8_BAR;
            PG8_LDA(At, 0, 1); PG8_STAGE(PG8_SA(0, 0), a2, voffA);
            PG8_BAR; PG8_WAIT_L(0); PG8_MMA(1, 0, At, B0); PG8_BAR; PG8_SCHED;
            PG8_STAGE(PG8_SB(0, 1), b2 + hstep, voffB);
            PG8_WAIT_V(6); PG8_BAR; PG8_MMA(1, 1, At, B1); PG8_BAR;
            PG8_LDB(B0, 1, 0); PG8_SCHED; PG8_LDA(At, 1, 0); PG8_STAGE(PG8_SA(0, 1), a2 + hstep, voffA);
            PG8_WAIT_L(8); PG8_BAR; PG8_WAIT_L(0); PG8_MMA(0, 0, At, B0); PG8_BAR; PG8_SCHED;
            PG8_LDB(B1, 1, 1); PG8_STAGE(PG8_SB(1, 0), b3, voffB);
            PG8_BAR; PG8_WAIT_L(0); PG8_MMA(0, 1, At, B1); PG8_BAR;
            PG8_LDA(At, 1, 1); PG8_STAGE(PG8_SA(1, 0), a3, voffA);
            PG8_BAR; PG8_WAIT_L(0); PG8_MMA(1, 0, At, B0); PG8_BAR; PG8_SCHED;
            PG8_STAGE(PG8_SB(1, 1), b3 + hstep, voffB);
            PG8_WAIT_V(6); PG8_BAR; PG8_MMA(1, 1, At, B1); PG8_BAR;
            }
        }
        if constexpr (ALIGN_EPI) { if (wr == 0) PG8_BAR; }
        if constexpr (FP8) asm volatile("s_nop 15\n\ts_nop 15" ::: "memory");
        if constexpr (!Epi::AFTER_DRAIN) { E(acc, cur, wr, wc, fr, fq); S.done(cur); }
        if (!has_next) break;
#pragma unroll
        for (int a = 0; a < 2; ++a)
#pragma unroll
            for (int b = 0; b < 2; ++b)
#pragma unroll
                for (int m = 0; m < 4; ++m)
#pragma unroll
                    for (int n = 0; n < 2; ++n) acc[a][b][m][n] = (f32x4){0.f, 0.f, 0.f, 0.f};
        cur = nxt; cA = nA; cB = nB; ++ui;
        if constexpr (ALIGN_EPI) { if (wr == 1) PG8_BAR; }
    }
    PG8_WAIT_V(0);
    if constexpr (!ALIGN_EPI) { if (wr == 0) PG8_BAR; }
    PG8_BAR;
    if constexpr (Epi::AFTER_DRAIN) { E.fused(acc, cur, wr, wc, fr, fq, lds, wid, lane); S.done(cur); }
#undef PG8_SA
#undef PG8_SB
#undef PG8_STAGE
#undef PG8_LDA
#undef PG8_LDB
#undef PG8_MMA
#undef PG8_LOH
#undef PG8_HIH
#undef PG8_LD2
#undef PG8_WAIT_V
#undef PG8_WAIT_L
#undef PG8_BAR
#undef PG8_SCHED
}
}


#define GAS __attribute__((address_space(1)))
#define LAS __attribute__((address_space(3)))
typedef unsigned short bf16;
typedef unsigned v4u __attribute__((ext_vector_type(4)));
typedef float f32x4 __attribute__((ext_vector_type(4)));
typedef short bf16x8 __attribute__((ext_vector_type(8)));
typedef GAS unsigned gu32;
typedef GAS unsigned long long gu64;
#define RLX_AGENT __ATOMIC_RELAXED, __HIP_MEMORY_SCOPE_AGENT
#define LDS_WAIT() asm volatile("s_waitcnt lgkmcnt(0)" ::: "memory")
#define VM_WAIT() asm volatile("s_waitcnt vmcnt(0)" ::: "memory")
__device__ __forceinline__ unsigned long long rt() { return __builtin_amdgcn_s_memrealtime(); }
__device__ __forceinline__ unsigned f2bf(float f) { unsigned u = __builtin_bit_cast(unsigned, f); return (u + 0x7fffu + ((u >> 16) & 1u)) >> 16; }
__device__ __forceinline__ unsigned pk2(float lo, float hi) { return f2bf(lo) | (f2bf(hi) << 16); }

#define XB_TMO      128
#define XB_XCNT(j)  (256  + 64 * (j))
#define XB_XSUB(j)  (1280 + 64 * (j))
#define XB_XGEN(j)  (2304 + 64 * (j))
#define XB_TOP      3328
#define XB_TOPGEN   3392
#define XCD_BAR_WORDS 3456
#define XB_SPIN_CAP (1u << 18)

__device__ __forceinline__ unsigned xb_ld(unsigned* p)              { return __hip_atomic_load(p, __ATOMIC_RELAXED, __HIP_MEMORY_SCOPE_AGENT); }
__device__ __forceinline__ unsigned xb_add(unsigned* p, unsigned v) { return __hip_atomic_fetch_add(p, v, __ATOMIC_RELAXED, __HIP_MEMORY_SCOPE_AGENT); }
__device__ __forceinline__ unsigned xb_xcc_id() { return (unsigned)__builtin_amdgcn_s_getreg((3 << 11) | 20) & 0xFu; }
#define XB_SPIN(cond, bar) do { unsigned _sp = 0; while (cond) { __builtin_amdgcn_s_sleep(1); \
    if ((++_sp & 255u) == 0u) { if (xb_ld(&(bar)[XB_TMO])) break; if (_sp > XB_SPIN_CAP) { atomicAdd(&(bar)[XB_TMO], 1u); break; } } } } while (0)

struct XcdBarrier {
    unsigned* bar; unsigned x;
    volatile LAS unsigned* st;
};

__device__ __forceinline__ XcdBarrier xcd_barrier_post(unsigned* bar, volatile LAS unsigned* st) {
    XcdBarrier b; b.bar = bar; b.x = xb_xcc_id(); b.st = st;
    if (threadIdx.x == 0) (void)xb_add(&bar[XB_XCNT(b.x)], 1u);
    return b;
}
__device__ __forceinline__ void xcd_barrier_complete(unsigned* bar, unsigned x, unsigned& nloc, unsigned& nx) {
    const unsigned G = gridDim.x * gridDim.y * gridDim.z;
    unsigned sum, cnt, mine, sp = 0u;
    for (;;) {
        sum = 0u; cnt = 0u; mine = 0u;
#pragma unroll
        for (unsigned j = 0; j < 16; ++j) { const unsigned c = xb_ld(&bar[XB_XCNT(j)]); sum += c; cnt += (c > 0u) ? 1u : 0u; mine = (j == x) ? c : mine; }
        if (sum == G) break;
        __builtin_amdgcn_s_sleep(1);
        if ((++sp & 255u) == 0u) { if (xb_ld(&bar[XB_TMO])) break; if (sp > XB_SPIN_CAP) { atomicAdd(&bar[XB_TMO], 1u); break; } }
    }
    nloc = mine > 0u ? mine : 1u; nx = cnt > 0u ? cnt : 1u;
}

__device__ __forceinline__ void xcd_barrier(const XcdBarrier& b) {
    asm volatile("s_waitcnt vmcnt(0)" ::: "memory");
    __syncthreads();
    if (threadIdx.x == 0) {
        unsigned* bar = b.bar;
        __builtin_amdgcn_s_waitcnt(0);
        unsigned nloc = b.st[0], nx = b.st[1];
        if (nloc == 0u) { xcd_barrier_complete(bar, b.x, nloc, nx); b.st[0] = nloc; b.st[1] = nx; }
        const unsigned old = xb_add(&bar[XB_XSUB(b.x)], 1u);
        const unsigned gen = old / nloc;
        if (old + 1u == (gen + 1u) * nloc) {
            __builtin_amdgcn_fence(__ATOMIC_RELEASE, "agent");
            asm volatile("s_waitcnt vmcnt(0)" ::: "memory");
            const unsigned og = xb_add(&bar[XB_TOP], 1u);
            const unsigned tg = og / nx;
            if (og + 1u == (tg + 1u) * nx) xb_add(&bar[XB_TOPGEN], 1u);
            else XB_SPIN(xb_ld(&bar[XB_TOPGEN]) == tg, bar);
            __builtin_amdgcn_fence(__ATOMIC_ACQUIRE, "agent");
            xb_add(&bar[XB_XGEN(b.x)], 1u);
            asm volatile("s_waitcnt vmcnt(0)" ::: "memory");
        } else {
            XB_SPIN(xb_ld(&bar[XB_XGEN(b.x)]) == gen, bar);
            __builtin_amdgcn_fence(__ATOMIC_ACQUIRE, "agent");
            asm volatile("s_waitcnt vmcnt(0)" ::: "memory");
        }
    }
    __syncthreads();
}


typedef unsigned u32x4v __attribute__((ext_vector_type(4)));
constexpr int NWAVES = 8, GRID_C = 256;
constexpr int NB = 8, SEQ = 4096, CTXL = 256, TOK = SEQ + CTXL, M = NB * TOK, DM = 2048, NL = 4;
constexpr int ZM_LD = 9728, ZG_LD = 6144, NIN = 15872, DFF = 5632, UP_LD = 2 * DFF, BW = 1024;
constexpr int ZA_Q = 0, ZA_FF = 1024, ZA_FB = 2048, ZA_V = 3072, ZA_G = 4096, ZB_Q = 5120, ZB_K = 6144, ZB_V = 7168, ZC_Q = 8192, ZC_K = 9216, ZC_V = 9472;
constexpr float EPS = 1e-6f, LOG2E = 1.4426950408889634f;
constexpr size_t MiB = 1u << 20;
constexpr size_t WS_CTL = 0, CTL_ZERO_BYTES = 1 * MiB;
constexpr size_t WS_MOD = 1 * MiB;
constexpr size_t WS_LB = 3 * MiB;
constexpr size_t WS_LAM = 3 * MiB + 65536;
constexpr size_t WS_ROPE = 3 * MiB + 131072;
constexpr size_t WS_W = 5 * MiB;
constexpr size_t W_IN = 0, W_BR = 62 * MiB, W_OUT = 74 * MiB, W_UP = 82 * MiB, W_DN = 126 * MiB;
constexpr size_t WS_Z = 153 * MiB;
constexpr size_t WS_ZG = WS_Z + 646 * MiB;
constexpr size_t WS_H = 1207 * MiB;
constexpr size_t WS_A = 1343 * MiB;
constexpr size_t WS_KP = WS_A + 204 * MiB;
constexpr size_t WS_H8 = WS_KP;
constexpr size_t W_G8 = (size_t)9728 * 2048 * 2;
constexpr float H8_SCALE = 16.0f, W8_SCALE = 512.0f;
constexpr size_t WS_M2 = 1717 * MiB;
constexpr size_t WS_CX = 1853 * MiB;
constexpr size_t WS_END = 1869 * MiB;
static_assert((size_t)M * ZM_LD * 2 == 646 * MiB && (size_t)M * ZG_LD * 2 == 408 * MiB && (size_t)M * DM * 2 == 136 * MiB && (size_t)3 * M * BW * 2 == 204 * MiB && (size_t)M * DFF * 2 == 374 * MiB, "ws map");
static_assert((size_t)NIN * DM * 2 == 62 * MiB && (size_t)UP_LD * DM * 2 == 44 * MiB && (size_t)DM * DFF * 2 == 22 * MiB, "w map");
constexpr int G8_LATE = 4 * (GRID_C / 2);
constexpr int CW_BAR = 4096;

constexpr int RING_BYTES = 139264;
constexpr int LDSCTL_OFF = RING_BYTES, MISC_OFF = LDSCTL_OFF + 320;
constexpr int LDS_BYTES = 147456;

struct Frame {
    LAS unsigned char* lds;
    volatile LAS unsigned* MISC;
    int tid, lane, wave, vcu, G;
};
typedef __attribute__((address_space(4))) const unsigned char kchar_t;
__device__ __forceinline__ kchar_t* kargs() { kchar_t* k = (kchar_t*)__builtin_amdgcn_kernarg_segment_ptr(); asm volatile("" : "+s"(k)); return k; }
__device__ __forceinline__ const float* inptr(int i) { return *(const float* __attribute__((address_space(4)))*)(kargs() + 8 * i); }
__device__ __forceinline__ float* outptr() { return *(float* __attribute__((address_space(4)))*)(kargs() + 176); }
__device__ __forceinline__ unsigned char* wsptr() { return *(unsigned char* __attribute__((address_space(4)))*)(kargs() + 184); }
constexpr int GRID = 256;
__device__ __forceinline__ Frame mkframe(LAS unsigned char* lds) {
    Frame F; int t = threadIdx.x; asm volatile("" : "+v"(t)); int bx = blockIdx.x; asm volatile("" : "+s"(bx));
    F.lds = lds; F.MISC = (volatile LAS unsigned*)(lds + MISC_OFF);
    F.tid = t; F.lane = t & 63; F.wave = __builtin_amdgcn_readfirstlane(t >> 6); F.G = GRID; F.vcu = (bx & 7) * (GRID / 8) + (bx >> 3);
    return F;
}
__device__ __forceinline__ float wave_sum(float v) {
#pragma unroll
    for (int o = 1; o < 64; o <<= 1) v += __shfl_xor(v, o);
    return v;
}
__device__ __forceinline__ float bf2f(unsigned short b) { return __uint_as_float(((unsigned)b) << 16); }
__device__ __forceinline__ float bflo(unsigned w) { return __uint_as_float(w << 16); }
__device__ __forceinline__ float bfhi(unsigned w) { return __uint_as_float(w & 0xffff0000u); }
__device__ __forceinline__ unsigned pkbf(float lo, float hi) { return pg8::cvt_pk_bf16(lo, hi); }
__device__ __forceinline__ unsigned pk4_fp8(float a, float b, float c, float d) { int w = __builtin_amdgcn_cvt_pk_fp8_f32(a, b, 0, false); w = __builtin_amdgcn_cvt_pk_fp8_f32(c, d, w, true); return (unsigned)w; }
__device__ __forceinline__ float silu_f(float x) { return x * __builtin_amdgcn_rcpf(1.0f + __expf(-x)); }

__device__ __forceinline__ int permc(int n) { if (n < ZC_Q || n >= ZC_V) return n; const int d = n & 127, rc = d >> 6, half = (d >> 5) & 1, i = d & 31; return (n & ~127) + 32 * (2 * rc + (i >> 4)) + 16 * half + (i & 15); }
__device__ __forceinline__ int permu(int n) { const int v = n >= DFF, r = v ? n - DFF : n; return 256 * (r >> 7) + 128 * v + (r & 127); }
__device__ __forceinline__ void transpose_item(const float* W, int K, int N, bf16* WT, LAS float* scr, int item, int lane, int pc = 0) {
    const int nblk = N / 32, kb = item / nblk, nb = item % nblk, k0 = 64 * kb, n0 = 32 * nb;
    float wv[32];
#pragma unroll
    for (int i = 0; i < 32; ++i) { const int kk = 2 * i + (lane >> 5); wv[i] = W[(size_t)(k0 + kk) * N + n0 + (lane & 31)]; }
#pragma unroll
    for (int i = 0; i < 32; ++i) { const int kk = 2 * i + (lane >> 5); scr[kk * 33 + (lane & 31)] = wv[i]; }
    LDS_WAIT(); asm volatile("" ::: "memory");
    const int c = lane & 7;
#pragma unroll
    for (int j = 0; j < 4; ++j) { const int n = (lane >> 3) + 8 * j; const LAS float* s = scr + (8 * c) * 33 + n;
        v4u o; o.x = pkbf(s[0 * 33], s[1 * 33]); o.y = pkbf(s[2 * 33], s[3 * 33]); o.z = pkbf(s[4 * 33], s[5 * 33]); o.w = pkbf(s[6 * 33], s[7 * 33]);
        *(GAS v4u*)(WT + (size_t)(pc == 1 ? permc(n0 + n) : (pc == 2 ? permu(n0 + n) : n0 + n)) * K + k0 + 8 * c) = o; }
    LDS_WAIT(); asm volatile("" ::: "memory");
}
__device__ __forceinline__ void transpose_item8(const float* W, int K, int N, unsigned char* WT, int nsub, float sc, LAS float* scr, int item, int lane) {
    const int nblk = N / 32, kb = item / nblk, nb = item % nblk, k0 = 64 * kb, n0 = 32 * nb;
    float wv[32];
#pragma unroll
    for (int i = 0; i < 32; ++i) { const int kk = 2 * i + (lane >> 5); wv[i] = W[(size_t)(k0 + kk) * N + n0 + (lane & 31)]; }
#pragma unroll
    for (int i = 0; i < 32; ++i) { const int kk = 2 * i + (lane >> 5); scr[kk * 33 + (lane & 31)] = wv[i]; }
    LDS_WAIT(); asm volatile("" ::: "memory");
#pragma unroll
    for (int i = 0; i < 2; ++i) { const int t = lane + 64 * i, n = t >> 2, ch = t & 3; const LAS float* s = scr + (16 * ch) * 33 + n;
        v4u o; o.x = pk4_fp8(s[0 * 33] * sc, s[1 * 33] * sc, s[2 * 33] * sc, s[3 * 33] * sc); o.y = pk4_fp8(s[4 * 33] * sc, s[5 * 33] * sc, s[6 * 33] * sc, s[7 * 33] * sc);
        o.z = pk4_fp8(s[8 * 33] * sc, s[9 * 33] * sc, s[10 * 33] * sc, s[11 * 33] * sc); o.w = pk4_fp8(s[12 * 33] * sc, s[13 * 33] * sc, s[14 * 33] * sc, s[15 * 33] * sc);
        *(GAS v4u*)(WT + (size_t)(n0 - nsub + n) * K + k0 + 16 * ch) = o; }
    LDS_WAIT(); asm volatile("" ::: "memory");
}
constexpr int CVT_I_IN = (DM / 64) * (NIN / 32), CVT_ALL = CVT_I_IN + 3 * (BW / 64) * (DM / 32) + (DM / 64) * (DM / 32) + (DM / 64) * (UP_LD / 32) + (DFF / 64) * (DM / 32);
__device__ __forceinline__ void convert_weights(Frame& F, int l, int lo, int hi, int gw, int NGW) {
    LAS float* scr = (LAS float*)(F.lds + F.wave * 16384);
    constexpr int I_IN = (DM / 64) * (NIN / 32), I_BR = (BW / 64) * (DM / 32), I_OUT = (DM / 64) * (DM / 32), I_UP = (DM / 64) * (UP_LD / 32), I_DN = (DFF / 64) * (DM / 32);
    constexpr int NITEMS = I_IN + 3 * I_BR + I_OUT + I_UP + I_DN; static_assert(NITEMS == CVT_ALL && I_IN == CVT_I_IN, "conversion list");
    unsigned char* wb = wsptr() + WS_W;
    for (int it = lo + gw; it < hi; it += NGW) {
        int r = it;
        if (r < I_IN) { if ((r % (NIN / 32)) * 32 < ZM_LD) transpose_item(inptr(10) + (size_t)l * DM * NIN, DM, NIN, (bf16*)(wb + W_IN), scr, r, F.lane, 1);
                        else transpose_item8(inptr(10) + (size_t)l * DM * NIN, DM, NIN, wb + W_IN + W_G8, ZM_LD, W8_SCALE, scr, r, F.lane); continue; } r -= I_IN;
        if (r < 3 * I_BR) { const int n = r / I_BR; transpose_item(inptr(16) + ((size_t)l * 3 + n) * BW * DM, BW, DM, (bf16*)(wb + W_BR) + (size_t)n * DM * BW, scr, r - n * I_BR, F.lane); continue; } r -= 3 * I_BR;
        if (r < I_OUT) { transpose_item(inptr(17) + (size_t)l * DM * DM, DM, DM, (bf16*)(wb + W_OUT), scr, r, F.lane); continue; } r -= I_OUT;
        if (r < I_UP) { transpose_item(inptr(18) + (size_t)l * DM * UP_LD, DM, UP_LD, (bf16*)(wb + W_UP), scr, r, F.lane, 2); continue; } r -= I_UP;
        transpose_item(inptr(21) + (size_t)l * DFF * DM, DFF, DM, (bf16*)(wb + W_DN), scr, r, F.lane);
    }
}
__device__ __forceinline__ void prologue_small(Frame& F) {
    LAS float* sv = (LAS float*)F.lds;
    LAS f32x4* red = (LAS f32x4*)F.lds;
    static_assert(NL * 48 <= GRID && 9 * 2048 * 4 <= RING_BYTES && 8 * 9 * 64 * 16 <= RING_BYTES, "prologue LDS");
    for (int i = F.tid; i < 9 * 2048; i += NWAVES * 64) { const int j = i >> 11, k = i & 2047; const float c = j < 8 ? inptr(1)[j * DM + k] : inptr(3)[k]; sv[i] = silu_f(c); }
    __syncthreads();
    float* mod = (float*)(wsptr() + WS_MOD);
    for (int it = F.vcu; it < NL * 48; it += F.G) {
        const int l = it / 48, cg = it - l * 48, n = cg * 256 + F.lane * 4;
        const float* W = inptr(4) + (size_t)l * DM * (6 * DM) + n;
        f32x4 a[9];
#pragma unroll
        for (int j = 0; j < 9; ++j) a[j] = (f32x4){0.f, 0.f, 0.f, 0.f};
        const int kb = F.wave * 256;
#pragma unroll 8
        for (int k = 0; k < 256; ++k) { const f32x4 w = *(const f32x4*)(W + (size_t)(kb + k) * (6 * DM));
#pragma unroll
            for (int j = 0; j < 9; ++j) a[j] += sv[j * 2048 + kb + k] * w; }
        __syncthreads();
#pragma unroll
        for (int j = 0; j < 9; ++j) red[(F.wave * 9 + j) * 64 + F.lane] = a[j];
        __syncthreads();
        for (int o = F.tid; o < 9 * 64; o += NWAVES * 64) { const int j = o >> 6, ln = o & 63; f32x4 s = (f32x4){0.f, 0.f, 0.f, 0.f};
#pragma unroll
            for (int w = 0; w < 8; ++w) s += red[(w * 9 + j) * 64 + ln];
            const int nn = cg * 256 + ln * 4; const f32x4 bb = *(const f32x4*)(inptr(5) + (size_t)l * (6 * DM) + nn);
            *(f32x4*)(mod + ((size_t)l * 9 + j) * (6 * DM) + nn) = s + bb; }
        __syncthreads();
    }
    const int gt = F.vcu * NWAVES * 64 + F.tid, NGT = F.G * NWAVES * 64;
    float* lb = (float*)(wsptr() + WS_LB);
    for (int i = gt; i < 2 * 1024; i += NGT) { const int dir = i >> 10, c = i & 1023; float lg[NL], mx = -1e30f;
#pragma unroll
        for (int l = 0; l < NL; ++l) { lg[l] = inptr(11)[((size_t)dir * NL + l) * 1024 + c]; mx = fmaxf(mx, lg[l]); }
        float s = 0.f;
#pragma unroll
        for (int l = 0; l < NL; ++l) { lg[l] = expf(lg[l] - mx); s += lg[l]; }
        float cum = 0.f;
#pragma unroll
        for (int l = 0; l < NL; ++l) { if (l > 0) cum += lg[l] / s; lb[((size_t)dir * NL + l) * 1024 + c] = cum; } }
    if (gt < NL) { const float* lv = inptr(13) + (size_t)gt * 4 * 64; float s1 = 0.f, s2 = 0.f;
        for (int i = 0; i < 64; ++i) { s1 += lv[i] * lv[64 + i]; s2 += lv[128 + i] * lv[192 + i]; }
        ((float*)(wsptr() + WS_LAM))[gt] = expf(s1) - expf(s2) + (0.8f - 0.6f * expf(-0.3f * (float)gt)); }
    float* rp = (float*)(wsptr() + WS_ROPE);
    for (int i = gt; i < 64 * 16; i += NGT) { const int pos = i >> 4, k = i & 15; const float inv = powf(10000.0f, -(float)k / 16.0f), ang = (float)pos * inv; rp[i] = cosf(ang); rp[1024 + i] = sinf(ang); }
    for (int i = gt; i < 64 * 32; i += NGT) { const int pos = i >> 5, k = i & 31; const float inv = powf(10000.0f, -(float)k / 32.0f), ang = (float)pos * inv; rp[2048 + i] = cosf(ang); rp[4096 + i] = sinf(ang); }
}
__device__ __forceinline__ const float* row_src(int b, int p, const float* lat, const float* ctx) { return p < CTXL ? ctx + (size_t)(b * CTXL + p) * DM : lat + (size_t)(b * SEQ + p - CTXL) * DM; }

__device__ __forceinline__ void prenorm_phase(Frame& F, int l, const float* xlat, const float* xctx) {
    const int gw = F.vcu * NWAVES + F.wave, NGW = F.G * NWAVES;
    const float* mod = (const float*)(wsptr() + WS_MOD) + (size_t)l * 9 * (6 * DM);
    const float* g = inptr(6) + (size_t)l * DM;
    bf16* H = (bf16*)(wsptr() + WS_H);
    for (int r = gw; r < M; r += NGW) {
        const int b = r / TOK, p = r - b * TOK; const float* xr = row_src(b, p, xlat, xctx); const float* mr = mod + (size_t)(p < CTXL ? 8 : b) * (6 * DM);
        f32x4 v[8]; float ss = 0.f;
#pragma unroll
        for (int j = 0; j < 8; ++j) { v[j] = *(const f32x4*)(xr + 4 * (64 * j + F.lane)); ss += (v[j].x * v[j].x + v[j].y * v[j].y) + (v[j].z * v[j].z + v[j].w * v[j].w); }
        const float rstd = rsqrtf(wave_sum(ss) * (1.f / DM) + EPS);
#pragma unroll
        for (int j = 0; j < 8; ++j) { const int c = 4 * (64 * j + F.lane); const f32x4 gg = *(const f32x4*)(g + c), sh = *(const f32x4*)(mr + c), sc = *(const f32x4*)(mr + DM + c);
            const f32x4 hv = (v[j] * rstd * gg) * (1.0f + sc) + sh;
            *(unsigned long long*)(H + (size_t)r * DM + c) = (unsigned long long)pkbf(hv.x, hv.y) | ((unsigned long long)pkbf(hv.z, hv.w) << 32);
            *(unsigned*)(wsptr() + WS_H8 + (size_t)r * DM + c) = pk4_fp8(hv.x * H8_SCALE, hv.y * H8_SCALE, hv.z * H8_SCALE, hv.w * H8_SCALE); }
    }
}
constexpr size_t WS_XM = WS_Z + 512 * MiB;
template <bool XF32, int MODE>
__device__ __forceinline__ void post_pre_phase(Frame& F, int l, bool wxm) {
    static_assert(M == 136 * GRID && TOK % 136 == 0, "row deal");
    constexpr bool XS32 = XF32 || MODE == 3;
    LAS f32x4* L4 = (LAS f32x4*)F.lds;
    const int b = (F.vcu * 136) / TOK;
    { const float* ml = (const float*)(wsptr() + WS_MOD) + (size_t)l * 9 * (6 * DM);
      const int ln = MODE == 0 ? l : (l + 1 < NL ? l + 1 : l);
      const float* modp = MODE == 0 ? ml + 3 * DM : (const float*)(wsptr() + WS_MOD) + (size_t)ln * 9 * (6 * DM);
      const float* gpre = MODE == 0 ? inptr(8) + (size_t)l * DM : inptr(6) + (size_t)ln * DM;
      for (int i = F.tid; i < 2 * 512; i += NWAVES * 64) { const int s = i >> 9, q = i & 511, c = q * 4; const size_t mo = (size_t)(s ? 8 : b) * (6 * DM) + c;
          if (MODE != 3) L4[s * 512 + q] = *(const f32x4*)(ml + 2 * DM + mo) * *(const f32x4*)(inptr(7) + (size_t)l * DM + c);
          if (MODE != 0) L4[(6 + s) * 512 + q] = *(const f32x4*)(ml + 5 * DM + mo) * *(const f32x4*)(inptr(9) + (size_t)l * DM + c);
          if (MODE != 3) { const f32x4 g2 = *(const f32x4*)(gpre + c), sh = *(const f32x4*)(modp + mo), sc = *(const f32x4*)(modp + mo + DM);
              L4[(2 + s) * 512 + q] = g2 * (1.0f + sc); L4[(4 + s) * 512 + q] = sh; } } }
    __syncthreads();
    const int rbase = F.vcu * 136 + F.wave;
    f32x4 xfA[8], xfB[8]; unsigned long long xbA[8], xbB[8], mA[8], mB[8], fA[8], fB[8];
#define PP_XOFF(p_) ((p_) < CTXL ? (size_t)(b * CTXL + (p_)) * DM : (size_t)(b * SEQ + (p_) - CTXL) * DM)
#define PP_LOAD(S, r) do { const int p_ = (r) - b * TOK; if (MODE != 3 || p_ >= CTXL) { \
        const float* xf_ = MODE == 3 ? (const float*)(wsptr() + WS_XM) + (size_t)(r) * DM : (p_ < CTXL ? inptr(2) : inptr(0)) + PP_XOFF(p_); \
        const bf16* xb_ = (p_ < CTXL ? (const bf16*)(wsptr() + WS_CX) : (const bf16*)outptr()) + PP_XOFF(p_); \
        const bf16* mr_ = (const bf16*)(wsptr() + WS_M2) + (size_t)(r) * DM; const bf16* fr_ = (const bf16*)(wsptr() + WS_H) + (size_t)(r) * DM; \
        _Pragma("unroll") for (int j = 0; j < 8; ++j) { const int c_ = 4 * (64 * j + F.lane); \
            if (XS32) xf##S[j] = *(const f32x4*)(xf_ + c_); else xb##S[j] = *(const unsigned long long*)(xb_ + c_); \
            if (MODE != 3) m##S[j] = *(const unsigned long long*)(mr_ + c_); \
            if (MODE != 0) f##S[j] = *(const unsigned long long*)(fr_ + c_); } } } while (0)
#define PP_UNPK(w_) (f32x4){bflo((unsigned)(w_)), bfhi((unsigned)(w_)), bflo((unsigned)((w_) >> 32)), bfhi((unsigned)((w_) >> 32))}
#define PP_SQ(v_) (((v_).x * (v_).x + (v_).y * (v_).y) + ((v_).z * (v_).z + (v_).w * (v_).w))
#define PP_PROC(S, r) do { const int p_ = (r) - b * TOK, s_ = (p_ < CTXL) ? 1 : 0; if (MODE != 3 || p_ >= CTXL) { \
        f32x4 xv_[8]; float ssm_ = 0.f, ssf_ = 0.f; \
        _Pragma("unroll") for (int j = 0; j < 8; ++j) { if (XS32) xv_[j] = xf##S[j]; else xv_[j] = PP_UNPK(xb##S[j]); \
            if (MODE != 3) { const f32x4 t_ = PP_UNPK(m##S[j]); ssm_ += PP_SQ(t_); } \
            if (MODE != 0) { const f32x4 t_ = PP_UNPK(f##S[j]); ssf_ += PP_SQ(t_); } } \
        float rsm_ = 0.f, rsf_ = 0.f; \
        if (MODE != 3) rsm_ = rsqrtf(wave_sum(ssm_) * (1.f / DM) + EPS); \
        if (MODE != 0) rsf_ = rsqrtf(wave_sum(ssf_) * (1.f / DM) + EPS); \
        float sx_ = 0.f; \
        _Pragma("unroll") for (int j = 0; j < 8; ++j) { const int q_ = 64 * j + F.lane; f32x4 xn_ = xv_[j]; \
            if (MODE != 3) { const f32x4 t_ = PP_UNPK(m##S[j]); xn_ = xn_ + L4[s_ * 512 + q_] * (t_ * rsm_); } \
            if (MODE == 0 && wxm) *(f32x4*)((float*)(wsptr() + WS_XM) + (size_t)(r) * DM + 4 * q_) = xn_; \
            if (MODE != 0) { const f32x4 t_ = PP_UNPK(f##S[j]); xn_ = xn_ + L4[(6 + s_) * 512 + q_] * (t_ * rsf_); } \
            if (MODE == 1) *(unsigned long long*)((p_ < CTXL ? (bf16*)(wsptr() + WS_CX) : (bf16*)outptr()) + PP_XOFF(p_) + 4 * q_) = (unsigned long long)pkbf(xn_.x, xn_.y) | ((unsigned long long)pkbf(xn_.z, xn_.w) << 32); \
            if (MODE == 3) *(f32x4*)(outptr() + PP_XOFF(p_) + 4 * q_) = xn_; \
            xv_[j] = xn_; sx_ += PP_SQ(xn_); } \
        if (MODE != 3) { const float rs2_ = rsqrtf(wave_sum(sx_) * (1.f / DM) + EPS); \
            _Pragma("unroll") for (int j = 0; j < 8; ++j) { const int q_ = 64 * j + F.lane; const f32x4 a2_ = L4[(2 + s_) * 512 + q_], sh_ = L4[(4 + s_) * 512 + q_]; \
                const f32x4 hv_ = (xv_[j] * rs2_) * a2_ + sh_; \
                *(unsigned long long*)((bf16*)(wsptr() + WS_H) + (size_t)(r) * DM + 4 * q_) = (unsigned long long)pkbf(hv_.x, hv_.y) | ((unsigned long long)pkbf(hv_.z, hv_.w) << 32); \
                if (MODE == 1) *(unsigned*)(wsptr() + WS_H8 + (size_t)(r) * DM + 4 * q_) = pk4_fp8(hv_.x * H8_SCALE, hv_.y * H8_SCALE, hv_.z * H8_SCALE, hv_.w * H8_SCALE); } } } } while (0)
    PP_LOAD(A, rbase);
#pragma unroll 1
    for (int i = 0; i < 17; i += 2) {
        if (i + 1 < 17) PP_LOAD(B, rbase + 8 * (i + 1));
        PP_PROC(A, rbase + 8 * i);
        if (i + 2 < 17) PP_LOAD(A, rbase + 8 * (i + 2));
        if (i + 1 < 17) PP_PROC(B, rbase + 8 * (i + 1));
    }
#undef PP_LOAD
#undef PP_PROC
#undef PP_UNPK
#undef PP_SQ
#undef PP_XOFF
    __syncthreads();
}

__device__ __forceinline__ void rope8(const u32x4v a, const u32x4v b, const float* cs, const float* sn, u32x4v& oa, u32x4v& ob) {
    const f32x4 c0 = *(const f32x4*)cs, c1 = *(const f32x4*)(cs + 4), s0 = *(const f32x4*)sn, s1 = *(const f32x4*)(sn + 4);
    const float x1[8] = {bflo(a.x), bfhi(a.x), bflo(a.y), bfhi(a.y), bflo(a.z), bfhi(a.z), bflo(a.w), bfhi(a.w)};
    const float x2[8] = {bflo(b.x), bfhi(b.x), bflo(b.y), bfhi(b.y), bflo(b.z), bfhi(b.z), bflo(b.w), bfhi(b.w)};
    const float cc[8] = {c0.x, c0.y, c0.z, c0.w, c1.x, c1.y, c1.z, c1.w}, ss[8] = {s0.x, s0.y, s0.z, s0.w, s1.x, s1.y, s1.z, s1.w};
    float o1[8], o2[8];
#pragma unroll
    for (int j = 0; j < 8; ++j) { o1[j] = x1[j] * cc[j] - x2[j] * ss[j]; o2[j] = x2[j] * cc[j] + x1[j] * ss[j]; }
    oa.x = pkbf(o1[0], o1[1]); oa.y = pkbf(o1[2], o1[3]); oa.z = pkbf(o1[4], o1[5]); oa.w = pkbf(o1[6], o1[7]);
    ob.x = pkbf(o2[0], o2[1]); ob.y = pkbf(o2[2], o2[3]); ob.z = pkbf(o2[4], o2[5]); ob.w = pkbf(o2[6], o2[7]);
}
__device__ __forceinline__ void rope_prep_phase(Frame& F) {
    const int gw = F.vcu * NWAVES + F.wave, NGW = F.G * NWAVES, t = F.lane;
    bf16* Zm = (bf16*)(wsptr() + WS_Z);
    const float* rp = (const float*)(wsptr() + WS_ROPE);
#pragma unroll 2
    for (int rl = gw; rl < NB * SEQ; rl += NGW) {
        const int b = rl >> 12, n = rl & (SEQ - 1); bf16* zr = Zm + (size_t)(b * TOK + CTXL + n) * ZM_LD;
        const bool lat = true; const int prow = n >> 6, pcol = n & 63;
        if (lat) {
            { const int hd = t >> 3, sub = t & 7, rc = sub >> 2, q8 = sub & 3, off = ZC_Q + hd * 128 + rc * 64 + q8 * 8, pos = rc ? pcol : prow;
              const float* cs = rp + 2048 + pos * 32 + q8 * 8; const float* sn = rp + 4096 + pos * 32 + q8 * 8;
              u32x4v a = *(const u32x4v*)(zr + off), bb = *(const u32x4v*)(zr + off + 32), oa, ob; rope8(a, bb, cs, sn, oa, ob);
              *(u32x4v*)(zr + off) = oa; *(u32x4v*)(zr + off + 32) = ob; }
            if (t < 16) { const int hd = t >> 3, sub = t & 7, rc = sub >> 2, q8 = sub & 3, off = ZC_K + hd * 128 + rc * 64 + q8 * 8, pos = rc ? pcol : prow;
              const float* cs = rp + 2048 + pos * 32 + q8 * 8; const float* sn = rp + 4096 + pos * 32 + q8 * 8;
              u32x4v a = *(const u32x4v*)(zr + off), bb = *(const u32x4v*)(zr + off + 32), oa, ob; rope8(a, bb, cs, sn, oa, ob);
              *(u32x4v*)(zr + off) = oa; *(u32x4v*)(zr + off + 32) = ob; }
        }
    }
}
__device__ __forceinline__ void finish_a_phase(Frame& F, int l) {
    const int gw = F.vcu * NWAVES + F.wave, NGW = F.G * NWAVES;
    const bf16* OF = (const bf16*)(wsptr() + WS_H); const bf16* OB = OF + (size_t)M * BW; const bf16* Zm = (const bf16*)(wsptr() + WS_Z); bf16* BR = (bf16*)(wsptr() + WS_A);
    const float* ng = inptr(12) + (size_t)l * 128;
#pragma unroll 2
    for (int it = gw; it < 2 * M; it += NGW) {
        const int r = it >> 1, hh = it & 1, col = (hh * 4 + (F.lane >> 4)) * 128 + (F.lane & 15) * 8, e0 = (F.lane & 15) * 8;
        const u32x4v a = *(const u32x4v*)(OF + (size_t)r * BW + col), bb = *(const u32x4v*)(OB + (size_t)r * BW + col), gz = *(const u32x4v*)(Zm + (size_t)r * ZM_LD + ZA_G + col);
        float o[8] = {bflo(a.x) + bflo(bb.x), bfhi(a.x) + bfhi(bb.x), bflo(a.y) + bflo(bb.y), bfhi(a.y) + bfhi(bb.y), bflo(a.z) + bflo(bb.z), bfhi(a.z) + bfhi(bb.z), bflo(a.w) + bflo(bb.w), bfhi(a.w) + bfhi(bb.w)};
        const float g[8] = {bflo(gz.x), bfhi(gz.x), bflo(gz.y), bfhi(gz.y), bflo(gz.z), bfhi(gz.z), bflo(gz.w), bfhi(gz.w)};
        float ss = 0.f;
#pragma unroll
        for (int j = 0; j < 8; ++j) ss += o[j] * o[j];
        ss += __shfl_xor(ss, 1); ss += __shfl_xor(ss, 2); ss += __shfl_xor(ss, 4); ss += __shfl_xor(ss, 8);
        const float rstd = rsqrtf(ss * (1.f / 128.f) + EPS);
        const f32x4 n0 = *(const f32x4*)(ng + e0), n1 = *(const f32x4*)(ng + e0 + 4); const float nn[8] = {n0.x, n0.y, n0.z, n0.w, n1.x, n1.y, n1.z, n1.w};
#pragma unroll
        for (int j = 0; j < 8; ++j) o[j] = o[j] * rstd * nn[j] * silu_f(g[j]);
        u32x4v w; w.x = pkbf(o[0], o[1]); w.y = pkbf(o[2], o[3]); w.z = pkbf(o[4], o[5]); w.w = pkbf(o[6], o[7]);
        *(u32x4v*)(BR + (size_t)r * BW + col) = w;
    }
}
__device__ __forceinline__ void unpack8(const u32x4v w, float (&f)[8]) { f[0] = bflo(w.x); f[1] = bfhi(w.x); f[2] = bflo(w.y); f[3] = bfhi(w.y); f[4] = bflo(w.z); f[5] = bfhi(w.z); f[6] = bflo(w.w); f[7] = bfhi(w.w); }
__device__ __forceinline__ void conv_act_phase(Frame& F, int l) {
    const bf16* U = (const bf16*)(wsptr() + WS_Z); bf16* ACT = (bf16*)(wsptr() + WS_A);
    const float* cw = inptr(19) + (size_t)l * 3 * UP_LD; const float* cb = inptr(20) + (size_t)l * UP_LD;
    constexpr int NCG = DFF / 8, NRS = M / 16;
    const int gt = F.vcu * NWAVES * 64 + F.tid, NGT = F.G * NWAVES * 64;
    for (int idx = gt; idx < NCG * NRS; idx += NGT) {
        const int rs = idx / NCG, cg = idx - rs * NCG, c = cg * 8, r0 = rs * 16, p0 = r0 % TOK;
        float wa[3][8], wv[3][8], ba[8], bv[8];
#pragma unroll
        for (int k = 0; k < 3; ++k)
#pragma unroll
            for (int h = 0; h < 2; ++h) { const f32x4 t0 = *(const f32x4*)(cw + (size_t)k * UP_LD + c + 4 * h), t1 = *(const f32x4*)(cw + (size_t)k * UP_LD + DFF + c + 4 * h);
                wa[k][4 * h] = t0.x; wa[k][4 * h + 1] = t0.y; wa[k][4 * h + 2] = t0.z; wa[k][4 * h + 3] = t0.w; wv[k][4 * h] = t1.x; wv[k][4 * h + 1] = t1.y; wv[k][4 * h + 2] = t1.z; wv[k][4 * h + 3] = t1.w; }
#pragma unroll
        for (int h = 0; h < 2; ++h) { const f32x4 t0 = *(const f32x4*)(cb + c + 4 * h), t1 = *(const f32x4*)(cb + DFF + c + 4 * h);
            ba[4 * h] = t0.x; ba[4 * h + 1] = t0.y; ba[4 * h + 2] = t0.z; ba[4 * h + 3] = t0.w; bv[4 * h] = t1.x; bv[4 * h + 1] = t1.y; bv[4 * h + 2] = t1.z; bv[4 * h + 3] = t1.w; }
        float pa[8], pv[8], ca[8], cv[8], na[8], nv[8];
        const u32x4v zz = {0u, 0u, 0u, 0u};
        { const bool ok = (p0 != 0) && (p0 != CTXL); const bf16* up = U + (size_t)(ok ? r0 - 1 : r0) * UP_LD + c; u32x4v x = *(const u32x4v*)up, y = *(const u32x4v*)(up + DFF); if (!ok) { x = zz; y = zz; } unpack8(x, pa); unpack8(y, pv); }
        { const bf16* up = U + (size_t)r0 * UP_LD + c; unpack8(*(const u32x4v*)up, ca); unpack8(*(const u32x4v*)(up + DFF), cv); }
#pragma unroll 4
        for (int i = 0; i < 16; ++i) {
            const int r = r0 + i, p = p0 + i; const bool ok = (p != CTXL - 1) && (p != TOK - 1);
            { const bf16* up = U + (size_t)(ok ? r + 1 : r) * UP_LD + c; u32x4v x = *(const u32x4v*)up, y = *(const u32x4v*)(up + DFF); if (!ok) { x = zz; y = zz; } unpack8(x, na); unpack8(y, nv); }
            float o[8];
#pragma unroll
            for (int j = 0; j < 8; ++j) { const float a = pa[j] * wa[0][j] + ca[j] * wa[1][j] + na[j] * wa[2][j] + ba[j], v = pv[j] * wv[0][j] + cv[j] * wv[1][j] + nv[j] * wv[2][j] + bv[j];
                o[j] = silu_f(a) * v; pa[j] = ca[j]; pv[j] = cv[j]; ca[j] = na[j]; cv[j] = nv[j]; }
            u32x4v w; w.x = pkbf(o[0], o[1]); w.y = pkbf(o[2], o[3]); w.z = pkbf(o[4], o[5]); w.w = pkbf(o[6], o[7]);
            *(u32x4v*)(ACT + (size_t)r * DFF + c) = w;
        }
    }
}

__device__ __forceinline__ void conv_fix_phase(Frame& F, int l) {
    const float* SB = (const float*)(wsptr() + WS_Z); bf16* ACT = (bf16*)(wsptr() + WS_A);
    const float* cw = inptr(19) + (size_t)l * 3 * UP_LD;
    constexpr int NE = (M / 64) * 2, NC4 = DFF / 4;
    const int gt = F.vcu * NWAVES * 64 + F.tid, NGT = F.G * NWAVES * 64;
    for (int idx = gt; idx < NE * NC4; idx += NGT) {
        const int E = idx / NC4, ch = (idx - E * NC4) * 4, gb = E >> 1, edge = E & 1, r = 64 * gb + (edge ? 63 : 0), p = r % TOK;
        const bool has = edge ? !(p == CTXL - 1 || p == TOK - 1) : !(p == 0 || p == CTXL);
        const float* sb = SB + ((size_t)E * 4) * DFF + ch;
        f32x4 a = *(const f32x4*)(sb + 2 * DFF), v = *(const f32x4*)(sb + 3 * DFF);
        if (has) { const float* nb = SB + ((size_t)(edge ? E + 1 : E - 1) * 4) * DFF + ch; const float* w = cw + (size_t)(edge ? 2 : 0) * UP_LD + ch;
            a += *(const f32x4*)w * *(const f32x4*)nb; v += *(const f32x4*)(w + DFF) * *(const f32x4*)(nb + DFF); }
        f32x4 o;
#pragma unroll
        for (int e2 = 0; e2 < 4; ++e2) o[e2] = silu_f(a[e2]) * v[e2];
        *(unsigned long long*)(ACT + (size_t)r * DFF + ch) = (unsigned long long)pkbf(o[0], o[1]) | ((unsigned long long)pkbf(o[2], o[3]) << 32);
    }
}

typedef float f32x2v __attribute__((ext_vector_type(2)));
namespace hg {
constexpr int QT = 0, KT = 17408, QH = 34816, KHT = 52224, VT = 70656, PP = 89088, ST = 98304, SEG = 133120, DEC = 137216, END = 137728;
static_assert(END <= RING_BYTES, "HGRN LDS");
constexpr int LDR = 272, LDS_ = 144;
__device__ __forceinline__ int tok_of(int dir, int i) { return dir == 0 ? i : (i < CTXL ? (CTXL - 1 - i) : (TOK + CTXL - 1 - i)); }
}
__device__ __forceinline__ void hgrn_unit(Frame& F, int l, int unit) {
    using namespace hg;
    const int b = unit >> 4, h = (unit >> 1) & 7, dir = unit & 1;
    LAS unsigned char* L = F.lds;
    const int tid = F.tid, lane = F.lane, w = F.wave, l15 = lane & 15, kq = lane >> 4;
    const int dp = lane, d0 = 2 * lane;
    const bf16* Zb = (const bf16*)(wsptr() + WS_Z) + (size_t)b * TOK * ZM_LD;
    bf16* Od = (bf16*)(wsptr() + WS_H) + (size_t)dir * M * BW + (size_t)b * TOK * BW + h * 128;
    const int cq = ZA_Q + h * 128 + d0, cf = (dir ? ZA_FB : ZA_FF) + h * 128 + d0;
    const int vs = tid >> 3, ve16 = (tid & 7) * 16, cv = ZA_V + h * 128 + ve16;
    for (int i = tid; i < 128 * LDR / 4; i += NWAVES * 64) ((LAS unsigned*)(L + ST))[i] = 0u;
    f32x4 S[8];
#pragma unroll
    for (int j = 0; j < 8; ++j) S[j] = (f32x4){0.f, 0.f, 0.f, 0.f};
    unsigned zq[8], zf[8]; u32x4v vv, vw;
#define HG_LOAD(c) do { _Pragma("unroll") for (int i_ = 0; i_ < 8; ++i_) { const bf16* rp_ = Zb + (size_t)tok_of(dir, 64 * (c) + 8 * w + i_) * ZM_LD; zq[i_] = *(const unsigned*)(rp_ + cq); zf[i_] = *(const unsigned*)(rp_ + cf); } \
        { const bf16* vp_ = Zb + (size_t)tok_of(dir, 64 * (c) + vs) * ZM_LD + cv; vv = *(const u32x4v*)vp_; vw = *(const u32x4v*)(vp_ + 8); } } while (0)
    HG_LOAD(0);
    __syncthreads();
    for (int c = 0; c < TOK / 64; ++c) {
        float pl0[8], pl1[8], qv0[8], qv1[8], kv0[8], kv1[8]; float prod0 = 1.0f, prod1 = 1.0f;
#pragma unroll
        for (int i = 0; i < 8; ++i) { const float f0 = bflo(zf[i]), f1 = bfhi(zf[i]);
            prod0 *= f0; pl0[i] = prod0; kv0[i] = 1.0f - f0; qv0[i] = bflo(zq[i]);
            prod1 *= f1; pl1[i] = prod1; kv1[i] = 1.0f - f1; qv1[i] = bfhi(zq[i]); }
        *(LAS f32x2v*)(L + SEG + (w * 128 + d0) * 4) = (f32x2v){prod0, prod1};
        { const unsigned ww[8] = {vv.x, vv.y, vv.z, vv.w, vw.x, vw.y, vw.z, vw.w};
#pragma unroll
          for (int j = 0; j < 8; ++j) { *(LAS unsigned short*)(L + VT + (ve16 + 2 * j) * LDS_ + vs * 2) = (unsigned short)(ww[j] & 0xffffu); *(LAS unsigned short*)(L + VT + (ve16 + 2 * j + 1) * LDS_ + vs * 2) = (unsigned short)(ww[j] >> 16); } }
        __syncthreads();
        if (c + 1 < TOK / 64) HG_LOAD(c + 1);
        { f32x2v sgp[8];
#pragma unroll
          for (int j = 0; j < 8; ++j) sgp[j] = *(const LAS f32x2v*)(L + SEG + (j * 128 + d0) * 4);
          const f32x2v cmid = (sgp[0] * sgp[1]) * (sgp[2] * sgp[3]), cend = (sgp[4] * sgp[5]) * (sgp[6] * sgp[7]);
          f32x2v fac = (f32x2v){1.0f, 1.0f};
          if (w < 4) {
#pragma unroll
              for (int j = 0; j < 4; ++j) if (j >= w) fac = fac * sgp[j];
              fac = (f32x2v){__builtin_amdgcn_rcpf(fac.x), __builtin_amdgcn_rcpf(fac.y)}; }
          else {
#pragma unroll
              for (int j = 4; j < 8; ++j) if (j < w) fac = fac * sgp[j]; }
          if (w == 0) *(LAS f32x2v*)(L + DEC + d0 * 4) = cmid * cend;
          float kf0[8], kf1[8];
#pragma unroll
          for (int i = 0; i < 8; ++i) { const int t = 8 * w + i;
              const float e0 = pl0[i] * fac.x, e1 = pl1[i] * fac.y, r0 = __builtin_amdgcn_rcpf(e0), r1 = __builtin_amdgcn_rcpf(e1);
              const float qt0 = qv0[i] * e0, qt1 = qv1[i] * e1, kt0 = kv0[i] * r0, kt1 = kv1[i] * r1;
              *(LAS unsigned*)(L + QT + t * LDR + d0 * 2) = pkbf(qt0, qt1);
              *(LAS unsigned*)(L + QH + t * LDR + d0 * 2) = pkbf(qt0 * cmid.x, qt1 * cmid.y);
              *(LAS unsigned*)(L + KT + t * LDR + d0 * 2) = pkbf(kt0, kt1);
              kf0[i] = kt0 * cend.x; kf1[i] = kt1 * cend.y; }
          const unsigned kh0[4] = {pkbf(kf0[0], kf0[1]), pkbf(kf0[2], kf0[3]), pkbf(kf0[4], kf0[5]), pkbf(kf0[6], kf0[7])}, kh1[4] = {pkbf(kf1[0], kf1[1]), pkbf(kf1[2], kf1[3]), pkbf(kf1[4], kf1[5]), pkbf(kf1[6], kf1[7])};
          *(LAS u32x4v*)(L + KHT + d0 * LDS_ + w * 16) = (u32x4v){kh0[0], kh0[1], kh0[2], kh0[3]}; *(LAS u32x4v*)(L + KHT + (d0 + 1) * LDS_ + w * 16) = (u32x4v){kh1[0], kh1[1], kh1[2], kh1[3]}; }
        __syncthreads();
        { const int st = w & 3, tt0 = (w >> 2) * 2; bf16x8 a[4];
#pragma unroll
          for (int k = 0; k < 4; ++k) a[k] = *(const LAS bf16x8*)(L + KT + (st * 16 + l15) * LDR + (k * 32 + kq * 8) * 2);
#pragma unroll
          for (int u = 0; u < 2; ++u) { const int tt = tt0 + u; f32x4 acc = (f32x4){0.f, 0.f, 0.f, 0.f};
#pragma unroll
              for (int k = 0; k < 4; ++k) { const bf16x8 bq = *(const LAS bf16x8*)(L + QT + (tt * 16 + l15) * LDR + (k * 32 + kq * 8) * 2); acc = __builtin_amdgcn_mfma_f32_16x16x32_bf16(a[k], bq, acc, 0, 0, 0); }
              const int tabs = tt * 16 + l15, s0 = st * 16 + 4 * kq;
              const float p0 = (s0 + 0 <= tabs) ? acc[0] : 0.f, p1 = (s0 + 1 <= tabs) ? acc[1] : 0.f, p2 = (s0 + 2 <= tabs) ? acc[2] : 0.f, p3 = (s0 + 3 <= tabs) ? acc[3] : 0.f;
              *(LAS unsigned long long*)(L + PP + tabs * LDS_ + s0 * 2) = (unsigned long long)pkbf(p0, p1) | ((unsigned long long)pkbf(p2, p3) << 32); } }
        __syncthreads();
        { const int tt0 = (w & 1) * 2, et0 = (w >> 1) * 2;
          bf16x8 bp[2][2], bqh[2][4];
#pragma unroll
          for (int v = 0; v < 2; ++v) {
#pragma unroll
            for (int k = 0; k < 2; ++k) bp[v][k] = *(const LAS bf16x8*)(L + PP + ((tt0 + v) * 16 + l15) * LDS_ + (k * 32 + kq * 8) * 2);
#pragma unroll
            for (int k = 0; k < 4; ++k) bqh[v][k] = *(const LAS bf16x8*)(L + QH + ((tt0 + v) * 16 + l15) * LDR + (k * 32 + kq * 8) * 2); }
          bf16* orow0 = Od + (size_t)tok_of(dir, 64 * c + tt0 * 16 + l15) * BW; bf16* orow1 = Od + (size_t)tok_of(dir, 64 * c + (tt0 + 1) * 16 + l15) * BW;
#pragma unroll
          for (int u = 0; u < 2; ++u) { const int et = et0 + u; bf16x8 av[2], as[4];
#pragma unroll
              for (int k = 0; k < 2; ++k) av[k] = *(const LAS bf16x8*)(L + VT + (et * 16 + l15) * LDS_ + (k * 32 + kq * 8) * 2);
#pragma unroll
              for (int k = 0; k < 4; ++k) as[k] = *(const LAS bf16x8*)(L + ST + (et * 16 + l15) * LDR + (k * 32 + kq * 8) * 2);
#pragma unroll
              for (int v = 0; v < 2; ++v) { f32x4 acc = (f32x4){0.f, 0.f, 0.f, 0.f};
#pragma unroll
                  for (int k = 0; k < 2; ++k) acc = __builtin_amdgcn_mfma_f32_16x16x32_bf16(av[k], bp[v][k], acc, 0, 0, 0);
#pragma unroll
                  for (int k = 0; k < 4; ++k) acc = __builtin_amdgcn_mfma_f32_16x16x32_bf16(as[k], bqh[v][k], acc, 0, 0, 0);
                  *(unsigned long long*)((v ? orow1 : orow0) + et * 16 + 4 * kq) = (unsigned long long)pkbf(acc[0], acc[1]) | ((unsigned long long)pkbf(acc[2], acc[3]) << 32); } } }
        __syncthreads();
        { const int dt0 = (w >> 1) * 2, eq0 = (w & 1) * 4;
          bf16x8 ak[2][2], bv[4][2]; f32x4 dcv[2];
#pragma unroll
          for (int dt = 0; dt < 2; ++dt) { dcv[dt] = *(const LAS f32x4*)(L + DEC + (16 * (dt0 + dt) + 4 * kq) * 4);
#pragma unroll
              for (int k = 0; k < 2; ++k) ak[dt][k] = *(const LAS bf16x8*)(L + KHT + (16 * (dt0 + dt) + l15) * LDS_ + (k * 32 + kq * 8) * 2); }
#pragma unroll
          for (int et = 0; et < 4; ++et)
#pragma unroll
              for (int k = 0; k < 2; ++k) bv[et][k] = *(const LAS bf16x8*)(L + VT + ((eq0 + et) * 16 + l15) * LDS_ + (k * 32 + kq * 8) * 2);
#pragma unroll
          for (int dt = 0; dt < 2; ++dt)
#pragma unroll
              for (int et = 0; et < 4; ++et) { f32x4 acc = S[4 * dt + et] * dcv[dt];
#pragma unroll
                  for (int k = 0; k < 2; ++k) acc = __builtin_amdgcn_mfma_f32_16x16x32_bf16(ak[dt][k], bv[et][k], acc, 0, 0, 0);
                  S[4 * dt + et] = acc;
                  *(LAS unsigned long long*)(L + ST + ((eq0 + et) * 16 + l15) * LDR + (16 * (dt0 + dt) + 4 * kq) * 2) = (unsigned long long)pkbf(acc[0], acc[1]) | ((unsigned long long)pkbf(acc[2], acc[3]) << 32); } }
        __syncthreads();
    }
#undef HG_LOAD
}

namespace att {
using s16x4  = __attribute__((ext_vector_type(4))) short;
using f32x16 = __attribute__((ext_vector_type(16))) float;
typedef LAS char lchar;
constexpr int SHM_V = 64 * 128 * 2, SHM_K = 64 * 128 * 2, SHM_ATTN = 2 * SHM_V + 2 * SHM_K + NWAVES * 64 * 4  , STASH_OFF = SHM_ATTN, STASH_BYTES = 32 * 512 * 4;
static_assert(STASH_OFF + STASH_BYTES <= RING_BYTES, "attention LDS");
#define KSWZ(row, colB) ((row) * 256 + ((colB) ^ (((row) & 7) << 4)))
#define SBAR() __builtin_amdgcn_sched_barrier(0)
__device__ __forceinline__ int crow(int r, int hi) { return (r & 3) + 8 * (r >> 2) + 4 * hi; }
__device__ __forceinline__ unsigned cvtpk(float lo, float hi) { return pg8::cvt_pk_bf16(lo, hi); }
__device__ __forceinline__ void partialSM(f32x16& p0, f32x16& p1, float& m_reg, float& mn, float& alpha, float C, float thr) {
  float pmax = p0[0];
#pragma unroll
  for (int r = 1; r < 16; ++r) pmax = fmaxf(pmax, p0[r]);
#pragma unroll
  for (int r = 0; r < 16; ++r) pmax = fmaxf(pmax, p1[r]);
  { auto rr = __builtin_amdgcn_permlane32_swap(__float_as_uint(pmax), __float_as_uint(pmax), false, false);
    pmax = fmaxf(__uint_as_float(rr[0]), __uint_as_float(rr[1])); }
  if (__builtin_expect(__all(pmax - m_reg <= thr), 1)) { mn = m_reg; alpha = 1.f; }
  else { mn = fmaxf(m_reg, pmax); alpha = __builtin_amdgcn_exp2f((m_reg - mn) * C); m_reg = mn; }
  float mnC = -mn * C;
#pragma unroll
  for (int r = 0; r < 16; ++r) p0[r] = fmaf(p0[r], C, mnC);
#pragma unroll
  for (int r = 0; r < 16; ++r) p1[r] = fmaf(p1[r], C, mnC);
#pragma unroll
  for (int r = 0; r < 16; ++r) p0[r] = __builtin_amdgcn_exp2f(p0[r]);
}
__device__ __forceinline__ void finishSM(f32x16& p0, f32x16& p1, float alpha, float& l_reg, bf16x8& pa0, bf16x8& pa1, bf16x8& pa2, bf16x8& pa3) {
#pragma unroll
  for (int r = 0; r < 16; ++r) p1[r] = __builtin_amdgcn_exp2f(p1[r]);
  float ps = 0;
#pragma unroll
  for (int r = 0; r < 16; ++r) ps += p0[r];
#pragma unroll
  for (int r = 0; r < 16; ++r) ps += p1[r];
  { auto rr = __builtin_amdgcn_permlane32_swap(__float_as_uint(ps), __float_as_uint(ps), false, false);
    ps = __uint_as_float(rr[0]) + __uint_as_float(rr[1]); }
  l_reg = l_reg * alpha + ps;
#define PK4(P, BASE, OUT) do { unsigned a0 = cvtpk(P[BASE + 0], P[BASE + 1]), a1 = cvtpk(P[BASE + 2], P[BASE + 3]);   \
    unsigned b0 = cvtpk(P[BASE + 4], P[BASE + 5]), b1 = cvtpk(P[BASE + 6], P[BASE + 7]);                              \
    auto r0 = __builtin_amdgcn_permlane32_swap(a0, b0, false, false); auto r1 = __builtin_amdgcn_permlane32_swap(a1, b1, false, false); \
    u32x4v w = {r0[0], r1[0], r0[1], r1[1]}; OUT = *reinterpret_cast<bf16x8*>(&w); } while (0)
  PK4(p0, 0, pa0); PK4(p0, 8, pa1); PK4(p1, 0, pa2); PK4(p1, 8, pa3);
#undef PK4
}
template <int ND0>
__device__ __forceinline__ void qkt(f32x16& p0, f32x16& p1, const lchar* Ks, const bf16x8* qr, int r32, int hi, int colx) {
  p0 = f32x16{}; p1 = f32x16{};
  int A = ND0 == 4 ? r32 * 128 + ((hi * 16) ^ ((r32 & 7) << 4)) : (r32 * 256 + ((hi * 16) ^ ((r32 & 7) << 4))) ^ colx; asm volatile("" : "+v"(A));
#pragma unroll
  for (int d0 = 0; d0 < ND0; ++d0) { const int off = A ^ (d0 * 32);
    bf16x8 b0 = *reinterpret_cast<const LAS bf16x8*>(Ks + off);
    bf16x8 b1 = *reinterpret_cast<const LAS bf16x8*>(Ks + off + (ND0 == 4 ? 4096 : 8192));
    p0 = __builtin_amdgcn_mfma_f32_32x32x16_bf16(b0, qr[d0], p0, 0, 0, 0);
    p1 = __builtin_amdgcn_mfma_f32_32x32x16_bf16(b1, qr[d0], p1, 0, 0, 0); }
}
__device__ __forceinline__ void mask_tile(f32x16& p0, f32x16& p1, int kp0, int qp, int hi) {
  const int dlt = kp0 - qp;
#pragma unroll
  for (int r = 0; r < 16; ++r) { const int k0 = dlt + crow(r, hi), k1 = k0 + 32;
    p0[r] = (k0 < -128 || k0 > 128) ? -1e30f : p0[r]; p1[r] = (k1 < -128 || k1 > 128) ? -1e30f : p1[r]; }
}
__device__ __forceinline__ int v_st(int k, int c) { const int kk = (k & ~0xC) | ((k & 4) << 1) | ((k & 8) >> 1); return ((kk >> 3) * 4 + (c >> 5)) * 512 + ((kk & 7) * 32 + (c & 31)) * 2; }
__device__ __forceinline__ int v_rd_base(int lane) { return ((lane & 3) << 3) | (((lane >> 2) & 3) << 6) | (((lane >> 4) & 1) << 5) | (((lane >> 5) & 1) << 8); }
constexpr int v_rd_off(int d0, int ks, int half) { return d0 * 512 + ks * 4096 + half * 2048; }
template <int OFF> __device__ __forceinline__ s16x4 tr_read(int vb) {
  s16x4 r; asm volatile("ds_read_b64_tr_b16 %0, %1 offset:%2" : "=&v"(r) : "v"(vb), "i"(OFF) : "memory"); return r;
}
template <int D0> __device__ __forceinline__ void pv_one(f32x16& od, int vb, bf16x8 pa0, bf16x8 pa1, bf16x8 pa2, bf16x8 pa3) {
  const s16x4 l0 = tr_read<v_rd_off(D0, 0, 0)>(vb), h0 = tr_read<v_rd_off(D0, 0, 1)>(vb), l1 = tr_read<v_rd_off(D0, 1, 0)>(vb), h1 = tr_read<v_rd_off(D0, 1, 1)>(vb);
  const s16x4 l2 = tr_read<v_rd_off(D0, 2, 0)>(vb), h2 = tr_read<v_rd_off(D0, 2, 1)>(vb), l3 = tr_read<v_rd_off(D0, 3, 0)>(vb), h3 = tr_read<v_rd_off(D0, 3, 1)>(vb);
  asm volatile("s_waitcnt lgkmcnt(0)" ::: "memory"); SBAR();
#define PK(L, H) (bf16x8){L[0], L[1], L[2], L[3], H[0], H[1], H[2], H[3]}
  od = __builtin_amdgcn_mfma_f32_32x32x16_bf16(pa0, PK(l0, h0), od, 0, 0, 0);
  od = __builtin_amdgcn_mfma_f32_32x32x16_bf16(pa1, PK(l1, h1), od, 0, 0, 0);
  od = __builtin_amdgcn_mfma_f32_32x32x16_bf16(pa2, PK(l2, h2), od, 0, 0, 0);
  od = __builtin_amdgcn_mfma_f32_32x32x16_bf16(pa3, PK(l3, h3), od, 0, 0, 0);
#undef PK
}
__device__ __forceinline__ void pv_d0(f32x16* o, int vb, bf16x8 pa0, bf16x8 pa1, bf16x8 pa2, bf16x8 pa3) {
  pv_one<0>(o[0], vb, pa0, pa1, pa2, pa3); pv_one<1>(o[1], vb, pa0, pa1, pa2, pa3); pv_one<2>(o[2], vb, pa0, pa1, pa2, pa3); pv_one<3>(o[3], vb, pa0, pa1, pa2, pa3);
}
template <int TYPE>
__device__ __forceinline__ void attn_run(const bf16* __restrict__ Qb, const bf16* __restrict__ Kh, const bf16* __restrict__ Vh,
                                         int NT, int gap, int qp, int bs, int comp, lchar* lds, f32x16 (&o)[4], float& m_reg, float& l_reg) {
  constexpr int ldq = ZM_LD, ldv = ZM_LD, ldk = ZM_LD, ND0 = TYPE == 0 ? 4 : 8, SD = TYPE == 0 ? 2 : 1; constexpr bool mask = TYPE == 1;
  constexpr float C = (TYPE == 0 ? 0.125f : 0.08838834764831845f) * LOG2E, thr = 8.0f * LOG2E / C;
  int tid = threadIdx.x; asm volatile("" : "+v"(tid));
  const int wid = tid >> 6, lane = tid & 63, r32 = lane & 31, hi = lane >> 5;
  lchar* V_lds = lds; lchar* K_lds = lds + 2 * SHM_V;
  LAS float* wsf = (LAS float*)(lds + 2 * SHM_V + 2 * SHM_K) + wid * 64; LAS float* al_l = wsf + 32;
  m_reg = -1e30f; l_reg = 0.f;
#pragma unroll
  for (int d = 0; d < 4; ++d) o[d] = f32x16{};
  bf16x8 qr[ND0];
  const unsigned qro = (unsigned)((wid * 32 + r32) * ldq + hi * 8) * 2u + (unsigned)(comp * 128);
#pragma unroll
  for (int d0 = 0; d0 < ND0; ++d0) qr[d0] = *reinterpret_cast<const bf16x8*>((const char*)Qb + qro + d0 * 32);
  const int colx = comp * 128;
  const int sr = tid >> 4, sc = (tid & 15) * 8, vst0 = v_st(sr, sc);
  const int kr = tid >> 3, kc = tid & 7;
  const int kst0 = TYPE == 0 ? kr * 128 + ((kc * 16) ^ ((kr & 7) << 4)) : KSWZ(sr, sc * 2);
  const int vb0 = (int)(unsigned)(uintptr_t)V_lds + v_rd_base(lane);
  const unsigned vro = (unsigned)(sr * ldv + sc) * 2u, kro = TYPE == 0 ? (unsigned)(kr * ldk + comp * 64 + kc * 8) * 2u : (unsigned)(sr * ldk + sc) * 2u;
  bf16x8 vsA0, vsA1, ksA0, ksA1, vsB0, vsB1, ksB0, ksB1;
#define KOFF(j) (64 * (j) + ((j) >= 4 ? gap : 0))
#define SLOAD(S, j) do { const size_t k0_ = (size_t)KOFF(j); const char* vb_ = (const char*)Vh + k0_ * (size_t)(ldv * 2); const char* kb_ = (const char*)Kh + k0_ * (size_t)(ldk * 2); \
    vs##S##0 = *reinterpret_cast<const bf16x8*>(vb_ + vro); vs##S##1 = *reinterpret_cast<const bf16x8*>(vb_ + (size_t)(32 * ldv * 2) + vro); \
    ks##S##0 = *reinterpret_cast<const bf16x8*>(kb_ + kro); if (TYPE == 1) ks##S##1 = *reinterpret_cast<const bf16x8*>(kb_ + (size_t)(32 * ldk * 2) + kro); } while (0)
#define SWRITE(b, S) do { *(LAS bf16x8*)(V_lds + (b) * SHM_V + vst0) = vs##S##0; *(LAS bf16x8*)(V_lds + (b) * SHM_V + vst0 + 8192) = vs##S##1; \
    *(LAS bf16x8*)(K_lds + (b) * SHM_K + kst0) = ks##S##0; if (TYPE == 1) *(LAS bf16x8*)(K_lds + (b) * SHM_K + kst0 + 8192) = ks##S##1; } while (0)
#define SWAIT() do { if constexpr (SD == 2) asm volatile("s_waitcnt vmcnt(3)" ::: "memory");   else asm volatile("s_waitcnt vmcnt(0)" ::: "memory"); } while (0)
#define RESC(a) do { if (__any((a) < 1.f)) { if (hi == 0) al_l[r32] = (a); asm volatile("s_waitcnt lgkmcnt(0)" ::: "memory"); \
    _Pragma("unroll") for (int d = 0; d < 4; ++d) _Pragma("unroll") for (int r = 0; r < 16; ++r) o[d][r] *= al_l[crow(r, hi)]; } } while (0)
#define MASKT(P0, P1, j) do { if (mask && (j) >= 4) mask_tile(P0, P1, bs + 64 * ((j) - 4), qp, hi); } while (0)
  f32x16 pA0, pA1, pB0, pB1; float mnA, mnB, alA, alB; bf16x8 pa0, pa1, pa2, pa3;
  SLOAD(A, 0); asm volatile("s_waitcnt vmcnt(0)" ::: "memory"); SWRITE(0, A); __syncthreads();
  qkt<ND0>(pA0, pA1, K_lds, qr, r32, hi, colx); partialSM(pA0, pA1, m_reg, mnA, alA, C, thr);
  if constexpr (SD == 2) { SLOAD(B, 1); if (2 < NT) SLOAD(A, 2); SWAIT(); SWRITE(1, B); } else { SLOAD(A, 1); SWAIT(); SWRITE(1, A); }
  __syncthreads();
  for (int j = 1; j + 1 < NT; j += 2) {
    SBAR(); qkt<ND0>(pB0, pB1, K_lds + SHM_K, qr, r32, hi, colx); MASKT(pB0, pB1, j);
    finishSM(pA0, pA1, alA, l_reg, pa0, pa1, pa2, pa3); SBAR();
    if constexpr (SD == 2) { SLOAD(B, j + 2); } else { SLOAD(A, j + 1); } SBAR();
    pv_d0(o, vb0, pa0, pa1, pa2, pa3); partialSM(pB0, pB1, m_reg, mnB, alB, C, thr);
    __syncthreads(); SWAIT(); SWRITE(0, A);
    RESC(alB); __syncthreads();
    SBAR(); qkt<ND0>(pA0, pA1, K_lds, qr, r32, hi, colx); MASKT(pA0, pA1, j + 1);
    finishSM(pB0, pB1, alB, l_reg, pa0, pa1, pa2, pa3); SBAR();
    if constexpr (SD == 2) { if (j + 3 < NT) SLOAD(A, j + 3); } else { SLOAD(A, j + 2); } SBAR();
    pv_d0(o, vb0 + SHM_V, pa0, pa1, pa2, pa3); partialSM(pA0, pA1, m_reg, mnA, alA, C, thr);
    __syncthreads(); SWAIT(); if constexpr (SD == 2) { SWRITE(1, B); } else { SWRITE(1, A); }
    RESC(alA); __syncthreads();
  }
  SBAR(); qkt<ND0>(pB0, pB1, K_lds + SHM_K, qr, r32, hi, colx); MASKT(pB0, pB1, NT - 1);
  finishSM(pA0, pA1, alA, l_reg, pa0, pa1, pa2, pa3); SBAR();
  pv_d0(o, vb0, pa0, pa1, pa2, pa3); partialSM(pB0, pB1, m_reg, mnB, alB, C, thr);
  __syncthreads(); RESC(alB);
  finishSM(pB0, pB1, alB, l_reg, pa0, pa1, pa2, pa3); SBAR();
  pv_d0(o, vb0 + SHM_V, pa0, pa1, pa2, pa3);
  (void)mnA; (void)mnB; (void)vsB0; (void)vsB1; (void)ksB0; (void)ksB1;
#undef KOFF
#undef SLOAD
#undef SWRITE
#undef SWAIT
#undef RESC
#undef MASKT
}
}

template <int TYPE>
__device__ __forceinline__ void attn_unit(Frame& F, int l, int bh, int qb) {
  using namespace att;
  lchar* lds = (lchar*)F.lds;
  const int tid = F.tid, wid = tid >> 6, lane = tid & 63, r32 = lane & 31, hi = lane >> 5;
  LAS float* li_l = (LAS float*)(lds + 2 * SHM_V + 2 * SHM_K) + wid * 64;
  LAS unsigned* stash = (LAS unsigned*)(lds + STASH_OFF);
  const int b = bh >> 3, hd = bh & 7;
  const size_t row0 = (size_t)b * TOK, rowq = row0 + (qb < 0 ? 0 : CTXL + 256 * qb);
  constexpr float C = (TYPE == 0 ? 0.125f : 0.08838834764831845f) * LOG2E;
#pragma unroll 1
  for (int pass = 0; pass < (TYPE == 0 ? 2 : 1); ++pass) {
    const bf16* Zm = (const bf16*)(wsptr() + WS_Z);
    const bf16 *Q, *K, *V; int NT, gap = 0, bs = 0;
    if (TYPE == 0) { Q = Zm + rowq * ZM_LD + ZB_Q + hd * 128; K = Zm + row0 * ZM_LD + ZB_K + hd * 128; V = Zm + row0 * ZM_LD + ZB_V + hd * 128; NT = qb < 0 ? 4 : TOK / 64; }
    else { const int g = hd >> 2; Q = Zm + rowq * ZM_LD + ZC_Q + hd * 128; K = Zm + row0 * ZM_LD + ZC_K + g * 128; V = Zm + row0 * ZM_LD + ZC_V + g * 128;
      if (qb < 0) NT = 4; else { bs = 256 * qb - 128; if (bs < 0) bs = 0; int be = 256 * qb + 384; if (be > SEQ) be = SEQ; NT = 4 + (be - bs) / 64; gap = bs; } }
    const int qp = 256 * qb + wid * 32 + r32;
    f32x16 o[4]; float m_reg, l_reg;
    attn_run<TYPE>(Q, K, V, NT, gap, qp, bs, TYPE == 0 ? pass : 0, lds, o, m_reg, l_reg);
    if (TYPE == 1) { const float sk = inptr(15)[l * 8 + hd]; l_reg += __builtin_amdgcn_exp2f(sk * LOG2E - m_reg * C); }
    if (hi == 0) li_l[r32] = l_reg;
    asm volatile("s_waitcnt lgkmcnt(0)" ::: "memory");
#pragma unroll
    for (int r = 0; r < 16; ++r) { const float rl = __builtin_amdgcn_rcpf(li_l[crow(r, hi)]);
#pragma unroll
      for (int d0 = 0; d0 < 4; ++d0) o[d0][r] *= rl; }
    if (TYPE == 0 && pass == 0) {
#pragma unroll
      for (int d0 = 0; d0 < 4; ++d0)
#pragma unroll
        for (int r = 0; r < 16; r += 2) stash[(d0 * 8 + (r >> 1)) * 512 + tid] = cvtpk(o[d0][r], o[d0][r + 1]);
    } else {
      __syncthreads();
      lchar* SG = lds + wid * 8192;
      if (TYPE == 0) { const float lam = ((const float*)(wsptr() + WS_LAM))[l];
#pragma unroll
        for (int d0 = 0; d0 < 4; ++d0)
#pragma unroll
          for (int r = 0; r < 16; r += 2) { const unsigned w = stash[(d0 * 8 + (r >> 1)) * 512 + tid]; o[d0][r] = bflo(w) - lam * o[d0][r]; o[d0][r + 1] = bfhi(w) - lam * o[d0][r + 1]; } }
#pragma unroll
      for (int r = 0; r < 16; ++r)
#pragma unroll
        for (int d0 = 0; d0 < 4; ++d0) *(LAS unsigned short*)(SG + crow(r, hi) * 256 + (d0 * 32 + r32) * 2) = (unsigned short)(cvtpk(o[d0][r], o[d0][r]) & 0xffffu);
      asm volatile("s_waitcnt lgkmcnt(0)" ::: "memory");
      const int cc = lane & 15;
      bf16* Ow = (bf16*)(wsptr() + WS_A) + (size_t)(TYPE == 0 ? 1 : 2) * M * BW + (rowq + wid * 32 + (lane >> 4)) * BW + hd * 128 + cc * 8;
      float gsc[8];
      if (TYPE == 0) { const float linit = 0.8f - 0.6f * __expf(-0.3f * (float)l); const float* sg = inptr(14) + (size_t)l * 128 + cc * 8;
#pragma unroll
        for (int j = 0; j < 8; ++j) gsc[j] = sg[j] * (1.0f - linit); }
#pragma unroll
      for (int i = 0; i < 8; ++i) {
        u32x4v v = *(const LAS u32x4v*)(SG + ((lane >> 4) + 4 * i) * 256 + cc * 16);
        if (TYPE == 0) { float f[8]; unpack8(v, f); float ss = 0.f;
#pragma unroll
          for (int j = 0; j < 8; ++j) ss += f[j] * f[j];
          ss += __shfl_xor(ss, 1); ss += __shfl_xor(ss, 2); ss += __shfl_xor(ss, 4); ss += __shfl_xor(ss, 8);
          const float rs = rsqrtf(ss * (1.f / 128.f) + EPS);
#pragma unroll
          for (int j = 0; j < 8; ++j) f[j] *= rs * gsc[j];
          v.x = cvtpk(f[0], f[1]); v.y = cvtpk(f[2], f[3]); v.z = cvtpk(f[4], f[5]); v.w = cvtpk(f[6], f[7]); }
        *(u32x4v*)(Ow + (size_t)(4 * i) * BW) = v;
      }
    }
    __syncthreads();
  }
}
__device__ __forceinline__ void attn_units(Frame& F, int l) {
  const int odd = F.vcu & 1, j = F.vcu >> 1;
#pragma unroll 1
  for (int k = 0; k < 5; ++k) {
    int bh, qb;
    if (k < 4) { const int U = k * 256 + F.vcu; bh = U >> 4; qb = U & 15; } else { if (!odd || j >= 64 || l == NL - 1) break; bh = j; qb = -1; }
#ifndef NO_AT0
    attn_unit<0>(F, l, bh, qb);
#endif
  }
  if (odd) {
#pragma unroll 1
    for (int k = 0; k < 9; ++k) {
      int bh, qb;
      if (k < 8) { const int U = k * 128 + j; bh = U >> 4; qb = U & 15; } else { if (j < 64 || l == NL - 1) break; bh = j - 64; qb = -1; }
#ifndef NO_AT1
      attn_unit<1>(F, l, bh, qb);
#endif
    }
  }
}

struct Args { const float* in[22]; float* out; unsigned char* ws; };
__global__ void __launch_bounds__(NWAVES * 64, 2) mk_fwd(Args args) {
    extern __shared__ __attribute__((aligned(16))) unsigned char lds[];
    LAS unsigned char* const ldsb = (LAS unsigned char*)lds;
    for (int u = threadIdx.x; u < (LDS_BYTES - LDSCTL_OFF) / 4; u += NWAVES * 64) ((LAS unsigned*)(ldsb + LDSCTL_OFF))[u] = 0u;
    __syncthreads();
    (void)xcd_barrier_post((unsigned*)(wsptr() + WS_CTL) + CW_BAR, (volatile LAS unsigned*)(ldsb + MISC_OFF) + 8);
#define GRID_BAR() do { XcdBarrier b_; b_.bar = (unsigned*)(wsptr() + WS_CTL) + CW_BAR; b_.x = xb_xcc_id(); b_.st = (volatile LAS unsigned*)(ldsb + MISC_OFF) + 8; xcd_barrier(b_); } while (0)
#define FRAME() Frame F = mkframe(ldsb)
#if PROBE_CLASS
#define PH_END(cls) do { if (threadIdx.x == 0) { volatile LAS unsigned long long* tw_ = (volatile LAS unsigned long long*)(ldsb + MISC_OFF + 64); const unsigned long long now_ = wall_clock64(); \
        if ((cls) == PROBE_CLASS || (PROBE_CLASS == 1 && (cls) >= 8 && (cls) <= 12) || (PROBE_CLASS == 40 && ((cls) == 3 || (cls) == 4 || (cls) == 7))) tw_[1] += now_ - tw_[0]; tw_[0] = now_; } } while (0)
#else
#define PH_END(cls) do { } while (0)
#endif
#define H    ((bf16*)(wsptr() + WS_H))
#define Zm   ((bf16*)(wsptr() + WS_Z))
#define Zg   ((bf16*)(wsptr() + WS_ZG))
#define BR   ((bf16*)(wsptr() + WS_A))
#define M2   ((bf16*)(wsptr() + WS_M2))
#define CX   ((float*)(wsptr() + WS_CX))
#define MIX  ((float*)(wsptr() + WS_Z))
#define UP   ((bf16*)(wsptr() + WS_Z))
#define ACT  ((bf16*)(wsptr() + WS_A))
#define mod  ((const float*)(wsptr() + WS_MOD))
#define WinT ((bf16*)(wsptr() + WS_W + W_IN))
#define WbT  ((bf16*)(wsptr() + WS_W + W_BR))
#define WoT  ((bf16*)(wsptr() + WS_W + W_OUT))
#define WupT ((bf16*)(wsptr() + WS_W + W_UP))
#define WdT  ((bf16*)(wsptr() + WS_W + W_DN))

#if PROBE_CLASS
    if (threadIdx.x == 0) { volatile LAS unsigned long long* tw_ = (volatile LAS unsigned long long*)(ldsb + MISC_OFF + 64); tw_[0] = wall_clock64(); tw_[1] = 0ull; }
#endif
    #ifndef NO_PRO
    { FRAME(); prologue_small(F); __syncthreads(); convert_weights(F, 0, 0, CVT_ALL, F.vcu * NWAVES + F.wave, GRID * NWAVES); }
#endif
    GRID_BAR();
    PH_END(7);
#ifndef NO_NORM
    { FRAME(); prenorm_phase(F, 0, inptr(0), inptr(2)); }
#endif
    GRID_BAR();
    PH_END(7);

    for (int l = 0; l < NL; ++l) {
#if !DBG_NO_MIX
#ifndef NO_G0
#if PROBE_CLASS == 20
        if (threadIdx.x == 0) { volatile LAS unsigned long long* tw_ = (volatile LAS unsigned long long*)(ldsb + MISC_OFF + 64); tw_[2] = clock64(); tw_[3] = wall_clock64(); }
#endif
        { FRAME(); pg8::Gemm g{H, WinT, M, ZM_LD, DM, 0, 0}; pg8::StaticOrder S; S.init(M, ZM_LD, F.G, (int)blockIdx.x);
          pg8::EpiZ E{Zm, Zg, (const float*)(wsptr() + WS_ROPE), (const float*)(wsptr() + WS_LB) + (size_t)l * 1024};
          pg8::gemm_phase<pg8::EpiZ, pg8::StaticOrder, true, true>(F.lds, g, S, E); }
        { FRAME(); pg8::Gemm g{(const bf16*)(wsptr() + WS_H8), (const bf16*)(wsptr() + WS_W + W_IN + W_G8), M, ZG_LD, DM / 2, 0, 0}; pg8::SubOrder S; S.base.init(M, ZG_LD, F.G, GRID - 1 - (int)blockIdx.x); S.lo = 0; S.hi = (M / 256) * (ZG_LD / 256) - G8_LATE;
          pg8::EpiG E{Zg, 1.0f / (H8_SCALE * W8_SCALE)};
          pg8::gemm_phase<pg8::EpiG, pg8::SubOrder, true, true, true>(F.lds, g, S, E); }
#endif
        GRID_BAR();
        PH_END(8);
#if PROBE_CLASS == 20
        if (threadIdx.x == 0) { volatile LAS unsigned long long* tw_ = (volatile LAS unsigned long long*)(ldsb + MISC_OFF + 64); const unsigned long long dc_ = clock64() - tw_[2], dw_ = wall_clock64() - tw_[3];
            if (l == 1) tw_[1] = (dc_ * 100ull / dw_) * 100ull; }
#endif
#if !DBG_NO_HGRN
        { FRAME(); if ((F.vcu & 1) == 0) { hgrn_unit(F, l, F.vcu >> 1); __syncthreads(); } }
        if (((int)blockIdx.x >> 3) & 1)
        { FRAME(); pg8::Gemm g{(const bf16*)(wsptr() + WS_H8), (const bf16*)(wsptr() + WS_W + W_IN + W_G8), M, ZG_LD, DM / 2, 0, 0}; pg8::SubOrder S; S.base.init(M, ZG_LD, F.G / 2, F.vcu >> 1); S.hi = (M / 256) * (ZG_LD / 256); S.lo = S.hi - G8_LATE;
          pg8::EpiG E{Zg, 1.0f / (H8_SCALE * W8_SCALE)};
          pg8::gemm_phase<pg8::EpiG, pg8::SubOrder, true, true, true>(F.lds, g, S, E); }
#else
        { FRAME(); const int gt = F.vcu * 512 + F.tid; u32x4v* p = (u32x4v*)(wsptr() + WS_H); for (size_t i = gt; i < (size_t)M * DM * 2 / 16; i += 256 * 512) p[i] = (u32x4v){0u, 0u, 0u, 0u}; }
#endif
#if !DBG_NO_ATTN
        { FRAME(); attn_units(F, l); }
#else
        { FRAME(); const int gt = F.vcu * 512 + F.tid; u32x4v* p = (u32x4v*)(wsptr() + WS_A + (size_t)M * BW * 2); for (size_t i = gt; i < (size_t)2 * M * BW * 2 / 16; i += 256 * 512) p[i] = (u32x4v){0u, 0u, 0u, 0u}; }
#endif
        GRID_BAR();
        PH_END(2);
#ifndef NO_FINA
        { FRAME(); finish_a_phase(F, l); }
#endif
        GRID_BAR();
        PH_END(4);
#ifndef NO_G1
        { FRAME(); pg8::Gemm g{BR, WbT, M, DM, BW, (size_t)M * BW * 2, (size_t)DM * BW * 2}; pg8::MergeOrder S; S.base.init(DM, l == NL - 1, F.G, (int)blockIdx.x);
          pg8::EpiMerge E{Zg, H};
          pg8::gemm_phase<pg8::EpiMerge, pg8::MergeOrder, true, true>(F.lds, g, S, E); }
#endif
        GRID_BAR();
        PH_END(9);
#ifndef NO_G2
        { FRAME(); pg8::Gemm g{H, WoT, M, DM, DM, 0, 0}; pg8::RowOrder S; S.init(DM, l == NL - 1, F.G, (int)blockIdx.x);
          pg8::EpiBf16<0> E{M2, DM, nullptr, 0, 0, 1.f};
          pg8::gemm_phase<pg8::EpiBf16<0>, pg8::RowOrder, true, true>(F.lds, g, S, E); }
#endif
        GRID_BAR();
        PH_END(10);
#endif
        { FRAME(); if (l == 0) post_pre_phase<true, 0>(F, l, false); else post_pre_phase<false, 0>(F, l, l == NL - 1); }
        GRID_BAR();
        PH_END(5);
#ifndef NO_G3
        { FRAME(); pg8::Gemm g{H, WupT, M, UP_LD, DM, 0, 0}; pg8::RowOrder S; S.init(UP_LD, l == NL - 1, F.G, (int)blockIdx.x);
          pg8::EpiConv E{ACT, (float*)(wsptr() + WS_Z), inptr(19) + (size_t)l * 3 * UP_LD, inptr(20) + (size_t)l * UP_LD};
          pg8::gemm_phase<pg8::EpiConv, pg8::RowOrder, true, true>(F.lds, g, S, E); }
#endif
        GRID_BAR();
        PH_END(11);
#ifndef NO_CONV
        { FRAME(); conv_fix_phase(F, l); }
#endif
        GRID_BAR();
        PH_END(6);
#ifndef NO_G4
        { FRAME(); pg8::Gemm g{ACT, WdT, M, DM, DFF, 0, 0}; pg8::RowOrder S; S.init(DM, l == NL - 1, F.G, (int)blockIdx.x);
          pg8::EpiBf16<0> E{H, DM, nullptr, 0, 0, 1.f};
          pg8::gemm_phase<pg8::EpiBf16<0>, pg8::RowOrder, true, true>(F.lds, g, S, E); }
#endif
        GRID_BAR();
        PH_END(12);
        { FRAME(); if (l == 0) post_pre_phase<true, 1>(F, l, false); else if (l + 1 < NL) post_pre_phase<false, 1>(F, l, false); else post_pre_phase<false, 3>(F, l, false);
          if (l + 1 < NL) { __syncthreads(); convert_weights(F, l + 1, 0, CVT_ALL, F.vcu * NWAVES + F.wave, GRID * NWAVES); } }
        GRID_BAR();
        PH_END(5);
    }
#if PROBE_CLASS
    if (blockIdx.x == 0 && threadIdx.x == 0) { volatile LAS unsigned long long* tw_ = (volatile LAS unsigned long long*)(ldsb + MISC_OFF + 64); const unsigned long long t0_ = wall_clock64(), d_ = tw_[1];
        while (wall_clock64() - t0_ < d_) __builtin_amdgcn_s_sleep(8); }
#endif
#undef GRID_BAR
#undef FRAME
#undef H
#undef Zm
#undef Zg
#undef BR
#undef M2
#undef CX
#undef MIX
#undef UP
#undef ACT
#undef mod
#undef WinT
#undef WbT
#undef WoT
#undef WupT
#undef WdT
}

extern "C" void kernel_launch(void* const* d_in, const int* in_sizes, int n_in, void* d_out, int out_size, void* d_ws, size_t ws_size, hipStream_t stream) {
    static int grid = 0;
    if (grid == 0) {
        if (n_in != 22 || in_sizes[0] != NB * SEQ * DM || out_size != NB * SEQ * DM || ws_size < WS_END) {
            fprintf(stderr, "kernel_launch: shape mismatch: n_in %d in0 %d out %d ws %zu (need %zu); nothing launched\n", n_in, n_in > 0 ? in_sizes[0] : -1, out_size, ws_size, (size_t)WS_END); grid = -1; return; }
        int dev = 0, cus = 0;
        if (hipGetDevice(&dev) != hipSuccess || hipDeviceGetAttribute(&cus, hipDeviceAttributeMultiprocessorCount, dev) != hipSuccess) { fprintf(stderr, "kernel_launch: device query failed\n"); grid = -1; return; }
        if (hipFuncSetAttribute((const void*)mk_fwd, hipFuncAttributeMaxDynamicSharedMemorySize, LDS_BYTES) != hipSuccess) { fprintf(stderr, "kernel_launch: hipFuncSetAttribute failed\n"); grid = -1; return; }
        int per_cu = 0;
        if (hipOccupancyMaxActiveBlocksPerMultiprocessor(&per_cu, (const void*)mk_fwd, NWAVES * 64, LDS_BYTES) != hipSuccess || per_cu < 1)
            fprintf(stderr, "kernel_launch: note: occupancy query reports %d workgroups per CU\n", per_cu);
        (void)hipGetLastError();
        if (cus < 256) { fprintf(stderr, "kernel_launch: needs 256 CUs (one resident workgroup each), device has %d; nothing launched\n", cus); grid = -1; return; }
        grid = 256;
    }
    if (grid < 0) return;
    if (hipMemsetAsync((char*)d_ws + WS_CTL, 0, CTL_ZERO_BYTES, stream) != hipSuccess) { fprintf(stderr, "kernel_launch: memset failed\n"); return; }
    Args a{};
    for (int i = 0; i < 22; ++i) a.in[i] = (const float*)d_in[i];
    a.out = (float*)d_out; a.ws = (unsigned char*)d_ws;
    hipLaunchKernelGGL(mk_fwd, dim3(grid), dim3(NWAVES * 64), LDS_BYTES, stream, a);
    const hipError_t le = hipPeekAtLastError();
    if (le != hipSuccess) fprintf(stderr, "kernel_launch: launch failed: %s\n", hipGetErrorName(le));
}
```

```cpp
#include <hip/hip_runtime.h>
#include <cstdio>
#include <cstdint>
#ifndef PROBE_CLASS
#define PROBE_CLASS 0
#endif
#ifndef DBG_NO_MIX
#define DBG_NO_MIX 0
#endif
#ifndef DBG_NO_HGRN
#define DBG_NO_HGRN 0
#endif
#ifndef DBG_NO_ATTN
#define DBG_NO_ATTN 0
#endif
#ifndef DBG_NO_FFN
#define DBG_NO_FFN 0
#endif
namespace pg8 {
#define PG8_LAS __attribute__((address_space(3)))
typedef unsigned short bf16_t;
typedef short bf16x8 __attribute__((ext_vector_type(8)));
typedef float f32x4 __attribute__((ext_vector_type(4)));
typedef unsigned u32x4 __attribute__((ext_vector_type(4)));
typedef int i32x4 __attribute__((ext_vector_type(4)));
typedef int i32x8 __attribute__((ext_vector_type(8)));
constexpr int BM = 256, BK = 64, HALF = 128, HTB = HALF * BK * 2  , STAGE_BYTES = 8 * HTB, NXCD = 8;

__host__ __device__ __forceinline__ int lds_byte(int r, int c) { const int st = (r >> 4) * 2 + (c >> 5), rr = r & 15, cc = c & 31, ob = rr * 64 + cc * 2; return st * 1024 + (ob ^ (((ob >> 9) & 1) << 5)); }
__host__ __device__ __forceinline__ void stage_rc(int b, int& R, int& C) { const int st = b / 1024, sb = b % 1024, swz = sb ^ (((sb >> 9) & 1) << 5); R = (st >> 1) * 16 + swz / 64; C = (st & 1) * 32 + (swz % 64) / 2; }
__host__ __device__ __forceinline__ int perm32(int rho) { const int n = rho >> 4, i = rho & 15; return 8 * (i >> 2) + 4 * n + (i & 3); }

struct Unit { int pm, pn, kz; };
struct Gemm { const bf16_t* A; const bf16_t* Bt; int M, N, K; size_t kzA, kzB; };

struct StaticOrder {
    int nM, nN, nwg, G, c, WGM;
    __host__ __device__ void init(int M, int N, int G_, int c_, int wgm = 4) { nM = M / BM; nN = N / BM; nwg = nM * nN; G = G_; c = c_; WGM = wgm; }
    __host__ __device__ bool next(int i, Unit& u) const { return at((long)i * G + c, u); }
    __host__ __device__ bool at(long L, Unit& u) const {
        if (L >= nwg) return false;
        int wgid = (int)L; { const int q = nwg / NXCD, r = nwg % NXCD, xcd = wgid % NXCD, off = wgid / NXCD; wgid = (xcd < r ? xcd * (q + 1) : r * (q + 1) + (xcd - r) * q) + off; }
        const int nig = WGM * nN, gid = wgid / nig, fm = gid * WGM, gsz = (nM - fm) < WGM ? (nM - fm) : WGM;
        u.pm = fm + ((wgid % nig) % gsz); u.pn = (wgid % nig) / gsz; u.kz = 0; return true;
    }
    __device__ __forceinline__ void a_ready(const Unit&) const {}
    __device__ __forceinline__ void done(const Unit&) const {}
};

struct SubOrder {
    StaticOrder base; int lo, hi;
    __device__ __forceinline__ bool next(int i, Unit& u) const { const long L = (long)lo + (long)i * base.G + base.c; if (L >= hi) return false; return base.at(L, u); }
    __device__ __forceinline__ void a_ready(const Unit&) const {}
    __device__ __forceinline__ void done(const Unit&) const {}
};

typedef float f32x2c_t __attribute__((ext_vector_type(2))); typedef __bf16 bf16x2c_t __attribute__((ext_vector_type(2)));
__device__ __forceinline__ unsigned cvt_pk_bf16(float lo, float hi) { f32x2c_t v = {lo, hi}; bf16x2c_t b = __builtin_convertvector(v, bf16x2c_t); return __builtin_bit_cast(unsigned, b); }
typedef float f32x2 __attribute__((ext_vector_type(2)));
__device__ __forceinline__ f32x2 gelu_pk(f32x2 v) {
    const f32x2 av = __builtin_elementwise_abs(v), d = av * 0.2316418882f + 1.0f;
    f32x2 t; t.x = __builtin_amdgcn_rcpf(d.x); t.y = __builtin_amdgcn_rcpf(d.y);
    f32x2 q = t * 0.5307027145f + (-0.7265760135f); q = q * t + 0.7107068705f; q = q * t + (-0.142248368f); q = q * t + 0.127414796f; q = q * t;
    const f32x2 s = (v * v) * (-0.72134752044f);
    f32x2 e; e.x = __builtin_amdgcn_exp2f(s.x); e.y = __builtin_amdgcn_exp2f(s.y);
    const f32x2 m = v * (q * e), r = v - m;
    f32x2 o; o.x = v.x < 0.f ? m.x : r.x; o.y = v.y < 0.f ? m.y : r.y; return o;
}

template <int ACT  > struct EpiBf16 {
    static constexpr bool PERM = true, AFTER_DRAIN = false; static_assert(ACT == 0 || ACT == 1, "EpiBf16: ACT is 0 (none) or 1 (gelu_pk)");
    bf16_t* O; int ldc; const float* bias; int split_cols; size_t split_stride; float scale0;
    __device__ __forceinline__ void operator()(const f32x4 (&acc)[2][2][4][2], const Unit& u, int wr, int wc, int fr, int fq) const {
        const int row0 = u.pm * BM + wr * 64 + fr; int colt = u.pn * BM; bf16_t* base = O;
        float sc = 1.f; if (split_cols) { const int t = colt / split_cols; base += (size_t)t * split_stride; colt -= t * split_cols; if (t == 0) sc = scale0; }
        const int col0 = colt + wc * 32 + 8 * fq, bcol0 = u.pn * BM + wc * 32 + 8 * fq;
        f32x4 bv[2][2];
#pragma unroll
        for (int bj = 0; bj < 2; ++bj)
#pragma unroll
            for (int n = 0; n < 2; ++n) bv[bj][n] = bias ? *(const f32x4*)(bias + bcol0 + bj * HALF + 4 * n) : (f32x4){0.f, 0.f, 0.f, 0.f};
#pragma unroll
        for (int ai = 0; ai < 2; ++ai)
#pragma unroll
            for (int m = 0; m < 4; ++m) { bf16_t* rowp = base + (size_t)(row0 + ai * HALF + m * 16) * ldc + col0;
#pragma unroll
                for (int bj = 0; bj < 2; ++bj) { f32x4 v0 = acc[ai][bj][m][0] + bv[bj][0], v1 = acc[ai][bj][m][1] + bv[bj][1];
                    if (ACT == 1) { f32x2 a = gelu_pk((f32x2){v0[0], v0[1]}), b = gelu_pk((f32x2){v0[2], v0[3]}), c = gelu_pk((f32x2){v1[0], v1[1]}), d = gelu_pk((f32x2){v1[2], v1[3]});
                        v0 = (f32x4){a.x, a.y, b.x, b.y}; v1 = (f32x4){c.x, c.y, d.x, d.y}; }
                    v0 = v0 * sc; v1 = v1 * sc; u32x4 w; w.x = cvt_pk_bf16(v0[0], v0[1]); w.y = cvt_pk_bf16(v0[2], v0[3]); w.z = cvt_pk_bf16(v1[0], v1[1]); w.w = cvt_pk_bf16(v1[2], v1[3]);
                    *(u32x4*)(rowp + bj * HALF) = w; } }
    }
};


__device__ __forceinline__ float sigmoid_f(float x) { return __builtin_amdgcn_rcpf(1.0f + __expf(-x)); }
__device__ __forceinline__ f32x4 ld_sc1_f32x4(const float* p) { f32x4 v; asm volatile("global_load_dwordx4 %0, %1, off sc1\n\ts_waitcnt vmcnt(0)" : "=v"(v) : "v"(p) : "memory"); return v; }
struct EpiZ {
    static constexpr bool PERM = true, AFTER_DRAIN = false;
    bf16_t* Zm; bf16_t* Zg; const float* rp; const float* lbl;
    __device__ __forceinline__ void operator()(const f32x4 (&acc)[2][2][4][2], const Unit& u, int wr, int wc, int fr, int fq) const {
        const int row0 = u.pm * BM + wr * 64 + fr;
        const bool mainz = u.pn < 38; bf16_t* base = mainz ? Zm : Zg; const int ldc = mainz ? 9728 : 6144; const int colt = (mainz ? u.pn : u.pn - 38) * BM;
        const int col0 = colt + wc * 32 + 8 * fq;
        const bool ropeb = (u.pn >= 20) && (u.pn < 28), ropec = (u.pn >= 32) && (u.pn < 37), rope = ropeb || ropec;
        const float sgn = fq < 2 ? -1.0f : 1.0f;
        const int tab = ropeb ? 0 : 2048, tsn = ropeb ? 1024 : 2048, tpitch = ropeb ? 16 : 32, ti = (ropeb ? 0 : 16 * (wc & 1)) + 8 * (fq & 1);
        const bool colpart = ropeb ? (wc & 1) : (wc >> 1);
#pragma unroll
        for (int ai = 0; ai < 2; ++ai)
#pragma unroll
            for (int m = 0; m < 4; ++m) { const int r = row0 + ai * HALF + m * 16; bf16_t* rowp = base + (size_t)r * ldc + col0;
                f32x4 cs0 = {1.f, 1.f, 1.f, 1.f}, cs1 = cs0, sn0 = {0.f, 0.f, 0.f, 0.f}, sn1 = sn0;
                if (rope) { const int bb = r / 4352, p = r - bb * 4352;
                    if (p >= 256) { const int n = p - 256, pos = colpart ? (n & 63) : (n >> 6); const float* t = rp + tab + pos * tpitch + ti;
                        cs0 = *(const f32x4*)t; cs1 = *(const f32x4*)(t + 4); sn0 = *(const f32x4*)(t + tsn) * sgn; sn1 = *(const f32x4*)(t + tsn + 4) * sgn; } }
#pragma unroll
                for (int bj = 0; bj < 2; ++bj) { f32x4 v0 = acc[ai][bj][m][0], v1 = acc[ai][bj][m][1];
                    if (u.pn < 4) {
#pragma unroll
                        for (int j = 0; j < 4; ++j) { v0[j] = v0[j] * sigmoid_f(v0[j]); v1[j] = v1[j] * sigmoid_f(v1[j]); } }
                    if (u.pn >= 4 && u.pn < 12) {
                        const int cc = colt + wc * 32 + 8 * fq + bj * HALF - 1024, dir = cc >> 10; const float* lp = lbl + dir * (4 * 1024) + (cc & 1023);
                        const f32x4 l0 = *(const f32x4*)lp, l1 = *(const f32x4*)(lp + 4);
#pragma unroll
                        for (int j = 0; j < 4; ++j) { v0[j] = l0[j] + (1.0f - l0[j]) * sigmoid_f(v0[j]); v1[j] = l1[j] + (1.0f - l1[j]) * sigmoid_f(v1[j]); } }
                    if (rope) { f32x4 p0, p1;
#pragma unroll
                        for (int j = 0; j < 4; ++j) { p0[j] = __shfl_xor(v0[j], 32); p1[j] = __shfl_xor(v1[j], 32); }
                        v0 = v0 * cs0 + p0 * sn0; v1 = v1 * cs1 + p1 * sn1; }
                    u32x4 w; w.x = cvt_pk_bf16(v0[0], v0[1]); w.y = cvt_pk_bf16(v0[2], v0[3]); w.z = cvt_pk_bf16(v1[0], v1[1]); w.w = cvt_pk_bf16(v1[2], v1[3]);
                    *(u32x4*)(rowp + bj * HALF) = w; } }
    }
};
struct EpiG {
    static constexpr bool PERM = true, AFTER_DRAIN = false;
    bf16_t* Zg; float sc;
    __device__ __forceinline__ void operator()(const f32x4 (&acc)[2][2][4][2], const Unit& u, int wr, int wc, int fr, int fq) const {
        const int row0 = u.pm * BM + wr * 64 + fr, col0 = u.pn * BM + wc * 32 + 8 * fq;
#pragma unroll
        for (int ai = 0; ai < 2; ++ai)
#pragma unroll
            for (int m = 0; m < 4; ++m) { bf16_t* rowp = Zg + (size_t)(row0 + ai * HALF + m * 16) * 6144 + col0;
#pragma unroll
                for (int bj = 0; bj < 2; ++bj) { const f32x4 v0 = acc[ai][bj][m][0] * sc, v1 = acc[ai][bj][m][1] * sc;
                    u32x4 w; w.x = cvt_pk_bf16(v0[0], v0[1]); w.y = cvt_pk_bf16(v0[2], v0[3]); w.z = cvt_pk_bf16(v1[0], v1[1]); w.w = cvt_pk_bf16(v1[2], v1[3]);
                    *(u32x4*)(rowp + bj * HALF) = w; } }
    }
};
struct EpiMerge {
    static constexpr bool PERM = true, AFTER_DRAIN = false;
    const bf16_t* Zg; bf16_t* out;
    __device__ __forceinline__ void operator()(const f32x4 (&acc)[2][2][4][2], const Unit& u, int wr, int wc, int fr, int fq) const {
        const int row0 = u.pm * BM + wr * 64 + fr, col0 = u.pn * BM + wc * 32 + 8 * fq, n = u.kz;
        u32x4 gA0, gA1, pA0 = {0u, 0u, 0u, 0u}, pA1 = pA0, gB0, gB1, pB0 = pA0, pB1 = pA0;
#define EM_LOAD(HP, S, AI, MM) do { const size_t row_ = (size_t)(row0 + (AI) * HALF + (MM) * 16); const bf16_t* gp_ = Zg + row_ * 6144 + (size_t)n * 2048 + col0; const bf16_t* op_ = out + row_ * 2048 + col0; \
        asm volatile("global_load_dwordx4 %0, %1, off" : "=v"(g##S##0) : "v"(gp_) : "memory"); asm volatile("global_load_dwordx4 %0, %1, off offset:256" : "=v"(g##S##1) : "v"(gp_) : "memory"); \
        if (HP) { asm volatile("global_load_dwordx4 %0, %1, off sc1" : "=v"(p##S##0) : "v"(op_) : "memory"); asm volatile("global_load_dwordx4 %0, %1, off offset:256 sc1" : "=v"(p##S##1) : "v"(op_) : "memory"); } } while (0)
#define EM_WAIT(HP, S, LASTG) do { if (HP) { if (LASTG) asm volatile("s_waitcnt vmcnt(0)" : "+v"(g##S##0), "+v"(g##S##1), "+v"(p##S##0), "+v"(p##S##1) :: "memory"); \
                                              else asm volatile("s_waitcnt vmcnt(4)" : "+v"(g##S##0), "+v"(g##S##1), "+v"(p##S##0), "+v"(p##S##1) :: "memory"); } \
        else { if (LASTG) asm volatile("s_waitcnt vmcnt(0)" : "+v"(g##S##0), "+v"(g##S##1) :: "memory"); else asm volatile("s_waitcnt vmcnt(2)" : "+v"(g##S##0), "+v"(g##S##1) :: "memory"); } } while (0)
#define EM_PROC(HP, S, AI, MM) do { const size_t row_ = (size_t)(row0 + (AI) * HALF + (MM) * 16); bf16_t* op_ = out + row_ * 2048 + col0; \
        _Pragma("unroll") for (int bj = 0; bj < 2; ++bj) { const u32x4 gw = bj ? g##S##1 : g##S##0, pp = bj ? p##S##1 : p##S##0; \
            f32x4 g0, g1; \
            g0[0] = sigmoid_f(__uint_as_float(gw.x << 16)); g0[1] = sigmoid_f(__uint_as_float(gw.x & 0xffff0000u)); \
            g0[2] = sigmoid_f(__uint_as_float(gw.y << 16)); g0[3] = sigmoid_f(__uint_as_float(gw.y & 0xffff0000u)); \
            g1[0] = sigmoid_f(__uint_as_float(gw.z << 16)); g1[1] = sigmoid_f(__uint_as_float(gw.z & 0xffff0000u)); \
            g1[2] = sigmoid_f(__uint_as_float(gw.w << 16)); g1[3] = sigmoid_f(__uint_as_float(gw.w & 0xffff0000u)); \
            f32x4 v0 = acc[AI][bj][MM][0] * g0, v1 = acc[AI][bj][MM][1] * g1; \
            if (HP) { v0[0] += __uint_as_float(pp.x << 16); v0[1] += __uint_as_float(pp.x & 0xffff0000u); v0[2] += __uint_as_float(pp.y << 16); v0[3] += __uint_as_float(pp.y & 0xffff0000u); \
                      v1[0] += __uint_as_float(pp.z << 16); v1[1] += __uint_as_float(pp.z & 0xffff0000u); v1[2] += __uint_as_float(pp.w << 16); v1[3] += __uint_as_float(pp.w & 0xffff0000u); } \
            u32x4 w; w.x = cvt_pk_bf16(v0[0], v0[1]); w.y = cvt_pk_bf16(v0[2], v0[3]); w.z = cvt_pk_bf16(v1[0], v1[1]); w.w = cvt_pk_bf16(v1[2], v1[3]); \
            *(u32x4*)(op_ + bj * HALF) = w; } \
        asm volatile("" ::: "memory"); } while (0)
#define EM_SEQ(HP) do { \
        EM_LOAD(HP, A, 0, 0); \
        EM_LOAD(HP, B, 0, 1); EM_WAIT(HP, A, 0); EM_PROC(HP, A, 0, 0); \
        EM_LOAD(HP, A, 0, 2); EM_WAIT(HP, B, 0); EM_PROC(HP, B, 0, 1); \
        EM_LOAD(HP, B, 0, 3); EM_WAIT(HP, A, 0); EM_PROC(HP, A, 0, 2); \
        EM_LOAD(HP, A, 1, 0); EM_WAIT(HP, B, 0); EM_PROC(HP, B, 0, 3); \
        EM_LOAD(HP, B, 1, 1); EM_WAIT(HP, A, 0); EM_PROC(HP, A, 1, 0); \
        EM_LOAD(HP, A, 1, 2); EM_WAIT(HP, B, 0); EM_PROC(HP, B, 1, 1); \
        EM_LOAD(HP, B, 1, 3); EM_WAIT(HP, A, 0); EM_PROC(HP, A, 1, 2); \
        EM_WAIT(HP, B, 1); EM_PROC(HP, B, 1, 3); } while (0)
        if (n > 0) EM_SEQ(1); else EM_SEQ(0);
#undef EM_SEQ
#undef EM_LOAD
#undef EM_WAIT
#undef EM_PROC
    }
};
struct RowOrder {
    StaticOrder base; int lat;
    __device__ __forceinline__ void init(int N, int lat_, int G, int c, int wgm = 4) { lat = lat_; base.init(lat_ ? 32768 : 34816, N, G, c, wgm); }
    __device__ __forceinline__ bool next(int i, Unit& u) const { if (!base.next(i, u)) return false; if (lat) u.pm += u.pm / 16 + 1; return true; }
    __device__ __forceinline__ void a_ready(const Unit&) const {}
    __device__ __forceinline__ void done(const Unit&) const {}
};
struct MergeOrder {
    RowOrder base;
    __device__ __forceinline__ bool next(int i, Unit& u) const { const int ti = i / 3; if (!base.next(ti, u)) return false; u.kz = i - 3 * ti; return true; }
    __device__ __forceinline__ void a_ready(const Unit&) const {}
    __device__ __forceinline__ void done(const Unit&) const {}
};


template <int CTRL> __device__ __forceinline__ float dppf(float old, float src) { return __builtin_bit_cast(float, __builtin_amdgcn_update_dpp(__builtin_bit_cast(int, old), __builtin_bit_cast(int, src), CTRL, 0xf, 0xf, false)); }
__device__ __forceinline__ f32x4 row_next(const f32x4 cur, const f32x4 nreg) {
    f32x4 r;
#pragma unroll
    for (int e = 0; e < 4; ++e) { const float y = dppf<0x11F>(0.f, nreg[e]); r[e] = dppf<0x101>(y, cur[e]); }
    return r; }
__device__ __forceinline__ f32x4 row_prev(const f32x4 cur, const f32x4 preg) {
    f32x4 r;
#pragma unroll
    for (int e = 0; e < 4; ++e) { const float y = dppf<0x10F>(0.f, preg[e]); r[e] = dppf<0x111>(y, cur[e]); }
    return r; }
struct EpiConv {
    static constexpr bool PERM = true, AFTER_DRAIN = false;
    bf16_t* ACT; float* SB; const float* cw; const float* cb;
    __device__ __forceinline__ void operator()(const f32x4 (&acc)[2][2][4][2], const Unit& u, int wr, int wc, int fr, int fq) const {
        const int ch0 = u.pn * 128 + wc * 32 + 8 * fq; const f32x4 z4 = {0.f, 0.f, 0.f, 0.f};
#pragma unroll
        for (int n = 0; n < 2; ++n) { const int ch = ch0 + 4 * n;
            const f32x4 wa0 = *(const f32x4*)(cw + ch), wa1 = *(const f32x4*)(cw + 11264 + ch), wa2 = *(const f32x4*)(cw + 22528 + ch), ba = *(const f32x4*)(cb + ch);
            const f32x4 wv0 = *(const f32x4*)(cw + 5632 + ch), wv1 = *(const f32x4*)(cw + 11264 + 5632 + ch), wv2 = *(const f32x4*)(cw + 22528 + 5632 + ch), bv = *(const f32x4*)(cb + 5632 + ch);
#pragma unroll
            for (int ai = 0; ai < 2; ++ai) { const int gb = 4 * u.pm + 2 * ai + wr;
#pragma unroll
                for (int m = 0; m < 4; ++m) {
                    const f32x4 A = acc[ai][0][m][n], V = acc[ai][1][m][n];
                    const f32x4 An = m < 3 ? acc[ai][0][m < 3 ? m + 1 : 3][n] : z4, Ap = m > 0 ? acc[ai][0][m > 0 ? m - 1 : 0][n] : z4;
                    const f32x4 Vn = m < 3 ? acc[ai][1][m < 3 ? m + 1 : 3][n] : z4, Vp = m > 0 ? acc[ai][1][m > 0 ? m - 1 : 0][n] : z4;
                    const f32x4 cA = wa0 * row_prev(A, Ap) + wa1 * A + wa2 * row_next(A, An) + ba;
                    const f32x4 cV = wv0 * row_prev(V, Vp) + wv1 * V + wv2 * row_next(V, Vn) + bv;
                    const bool e0 = (m == 0) && (fr == 0), e1 = (m == 3) && (fr == 15);
                    if (e0 || e1) { float* sb = SB + ((size_t)(gb * 2 + (e1 ? 1 : 0)) * 4) * 5632 + ch;
                        *(f32x4*)sb = A; *(f32x4*)(sb + 5632) = V; *(f32x4*)(sb + 2 * 5632) = cA; *(f32x4*)(sb + 3 * 5632) = cV; }
                    else { f32x4 o;
#pragma unroll
                        for (int e2 = 0; e2 < 4; ++e2) o[e2] = cA[e2] * sigmoid_f(cA[e2]) * cV[e2];
                        *(unsigned long long*)(ACT + (size_t)(64 * gb + 16 * m + fr) * 5632 + ch) = (unsigned long long)cvt_pk_bf16(o[0], o[1]) | ((unsigned long long)cvt_pk_bf16(o[2], o[3]) << 32); } } } }
    }
};

template <class Epi, class Sched, bool ALIGN_EPI = false, bool SP2 = false, bool FP8 = false>
__device__ __forceinline__ void gemm_phase(PG8_LAS unsigned char* lds, const Gemm g, const Sched& S, const Epi& E) {
    int tid = threadIdx.x; asm volatile("" : "+v"(tid));
    const int wid = __builtin_amdgcn_readfirstlane(tid >> 6), lane = tid & 63, wr = wid >> 2, wc = wid & 3, fr = lane & 15, fq = lane >> 4;
    const int K = g.K, nt = K / BK;
    unsigned voffA[2], voffB[2];
#pragma unroll
    for (int i = 0; i < 2; ++i) { int R, C; stage_rc(tid * 16 + i * 8192, R, C); const int Rb = Epi::PERM ? ((R & ~31) + perm32(R & 31)) : R;
        voffA[i] = (unsigned)(R * K + C) * 2u; voffB[i] = (unsigned)(Rb * K + C) * 2u; }
    const size_t kstep = (size_t)(BK * 2);
    const size_t hstep = (size_t)HALF * K * 2;
    const size_t tstep = 2 * hstep;
    const unsigned ldsw = (unsigned)wid * 1024u;
    const int aoff = lds_byte(wr * 64 + fr, fq * 8), boff = lds_byte(wc * 32 + fr, fq * 8);
#define PG8_SA(b, h) (((b) * 2 + (h)) * HTB)
#define PG8_SB(b, h) ((4 + (b) * 2 + (h)) * HTB)
#define PG8_STAGE(bufoff, gbase, voff) do { _Pragma("unroll") for (int _i = 0; _i < 2; ++_i) \
        __builtin_amdgcn_global_load_lds((const unsigned*)((const char*)(gbase) + (voff)[_i]), (PG8_LAS unsigned*)(lds + (bufoff) + ldsw + _i * 8192), 16, 0, 0); } while (0)
#define PG8_LD2(p) __builtin_shufflevector(*(const PG8_LAS i32x4*)(p), *(const PG8_LAS i32x4*)((p) + 1024), 0, 1, 2, 3, 4, 5, 6, 7)
#define PG8_LDA(dst, b, h) do { _Pragma("unroll") for (int m = 0; m < 4; ++m) dst[m] = PG8_LD2(lds + PG8_SA(b, h) + aoff + m * 2048); } while (0)
#define PG8_LDB(dst, b, h) do { _Pragma("unroll") for (int n = 0; n < 2; ++n) dst[n] = PG8_LD2(lds + PG8_SB(b, h) + boff + n * 2048); } while (0)
#define PG8_LOH(v) __builtin_bit_cast(bf16x8, __builtin_shufflevector(v, v, 0, 1, 2, 3))
#define PG8_HIH(v) __builtin_bit_cast(bf16x8, __builtin_shufflevector(v, v, 4, 5, 6, 7))
#define PG8_MMA(ai, bj, At, Bt) do { __builtin_amdgcn_s_setprio(1); \
        if constexpr (FP8) { _Pragma("unroll") for (int m = 0; m < 4; ++m) _Pragma("unroll") for (int n = 0; n < 2; ++n) \
            asm("v_mfma_scale_f32_16x16x128_f8f6f4 %0, %1, %2, %0, %3, %3 op_sel_hi:[0,0,0]" : "+v"(acc[ai][bj][m][n]) : "v"(Bt[n]), "v"(At[m]), "v"(sc8)); } \
        else { _Pragma("unroll") for (int m = 0; m < 4; ++m) _Pragma("unroll") for (int n = 0; n < 2; ++n) { \
            acc[ai][bj][m][n] = __builtin_amdgcn_mfma_f32_16x16x32_bf16(PG8_LOH(Bt[n]), PG8_LOH(At[m]), acc[ai][bj][m][n], 0, 0, 0); \
            acc[ai][bj][m][n] = __builtin_amdgcn_mfma_f32_16x16x32_bf16(PG8_HIH(Bt[n]), PG8_HIH(At[m]), acc[ai][bj][m][n], 0, 0, 0); } } \
        __builtin_amdgcn_s_setprio(0); } while (0)
#define PG8_WAIT_V(n) asm volatile("s_waitcnt vmcnt(" #n ")" ::: "memory")
#define PG8_WAIT_L(n) asm volatile("s_waitcnt lgkmcnt(" #n ")" ::: "memory")
#define PG8_BAR __builtin_amdgcn_s_barrier()
#define PG8_SCHED __builtin_amdgcn_sched_barrier(0)
    Unit cur, nxt; int ui = 0;
    if (!S.next(0, cur)) return;
    f32x4 acc[2][2][4][2];
#pragma unroll
    for (int a = 0; a < 2; ++a)
#pragma unroll
        for (int b = 0; b < 2; ++b)
#pragma unroll
            for (int m = 0; m < 4; ++m)
#pragma unroll
                for (int n = 0; n < 2; ++n) acc[a][b][m][n] = (f32x4){0.f, 0.f, 0.f, 0.f};
    const int sc8 = 0x7F7F7F7F;
    i32x8 At[4], B0[2], B1[2];
    const char* cA = (const char*)g.A + (size_t)cur.pm * tstep + (size_t)cur.kz * g.kzA; const char* cB = (const char*)g.Bt + (size_t)cur.pn * tstep + (size_t)cur.kz * g.kzB;
    S.a_ready(cur);
    if constexpr (SP2) {
        PG8_STAGE(PG8_SB(0, 0), cB, voffB); PG8_STAGE(PG8_SB(0, 1), cB + hstep, voffB); PG8_STAGE(PG8_SA(0, 0), cA, voffA); PG8_STAGE(PG8_SA(0, 1), cA + hstep, voffA);
        if (wr == 1) PG8_BAR;
        PG8_WAIT_V(2); PG8_BAR;
        PG8_STAGE(PG8_SB(1, 0), cB + kstep, voffB); PG8_STAGE(PG8_SA(1, 0), cA + kstep, voffA); PG8_STAGE(PG8_SB(1, 1), cB + hstep + kstep, voffB);
        PG8_WAIT_V(6); PG8_BAR;
    } else {
        PG8_STAGE(PG8_SB(0, 0), cB, voffB); PG8_STAGE(PG8_SA(0, 0), cA, voffA); PG8_STAGE(PG8_SB(0, 1), cB + hstep, voffB); PG8_STAGE(PG8_SA(0, 1), cA + hstep, voffA);
        if (wr == 1) PG8_BAR;
        PG8_WAIT_V(4); PG8_BAR;
        PG8_STAGE(PG8_SB(1, 0), cB + kstep, voffB); PG8_STAGE(PG8_SA(1, 0), cA + kstep, voffA); PG8_STAGE(PG8_SB(1, 1), cB + hstep + kstep, voffB);
        PG8_WAIT_V(6); PG8_BAR;
    }
    for (;;) {
        const bool has_next = S.next(ui + 1, nxt);
        const char* nA = has_next ? (const char*)g.A + (size_t)nxt.pm * tstep + (size_t)nxt.kz * g.kzA : cA; const char* nB = has_next ? (const char*)g.Bt + (size_t)nxt.pn * tstep + (size_t)nxt.kz * g.kzB : cB;
        for (int t = 0; t < nt; t += 2) {
            const bool last = (t == nt - 2);
            const char* a1 = cA + (size_t)(t + 1) * kstep;
            const char* a2 = last ? nA : cA + (size_t)(t + 2) * kstep; const char* b2 = last ? nB : cB + (size_t)(t + 2) * kstep;
            const char* a3 = a2 + kstep; const char* b3 = b2 + kstep;
            if (last && has_next) S.a_ready(nxt);
            if constexpr (SP2) {
            PG8_LDB(B0, 0, 0); PG8_LDB(B1, 0, 1); PG8_SCHED; PG8_LDA(At, 0, 0); PG8_STAGE(PG8_SA(1, 1), a1 + hstep, voffA);
            PG8_WAIT_V(8); PG8_WAIT_L(0); PG8_BAR; PG8_MMA(0, 0, At, B0); PG8_MMA(0, 1, At, B1); PG8_BAR; PG8_SCHED;
            PG8_LDA(At, 0, 1); PG8_STAGE(PG8_SB(0, 0), b2, voffB); PG8_STAGE(PG8_SB(0, 1), b2 + hstep, voffB); PG8_STAGE(PG8_SA(0, 0), a2, voffA);
            PG8_WAIT_V(8); PG8_WAIT_L(0); PG8_BAR; PG8_MMA(1, 0, At, B0); PG8_MMA(1, 1, At, B1); PG8_BAR; PG8_SCHED;
            PG8_LDB(B0, 1, 0); PG8_LDB(B1, 1, 1); PG8_SCHED; PG8_LDA(At, 1, 0); PG8_STAGE(PG8_SA(0, 1), a2 + hstep, voffA);
            PG8_WAIT_V(8); PG8_WAIT_L(0); PG8_BAR; PG8_MMA(0, 0, At, B0); PG8_MMA(0, 1, At, B1); PG8_BAR; PG8_SCHED;
            PG8_LDA(At, 1, 1); PG8_STAGE(PG8_SB(1, 0), b3, voffB); PG8_STAGE(PG8_SB(1, 1), b3 + hstep, voffB); PG8_STAGE(PG8_SA(1, 0), a3, voffA);
            PG8_WAIT_V(8); PG8_WAIT_L(0); PG8_BAR; PG8_MMA(1, 0, At, B0); PG8_MMA(1, 1, At, B1); PG8_BAR; PG8_SCHED;
            } else {
            PG8_LDB(B0, 0, 0); PG8_SCHED; PG8_LDA(At, 0, 0); PG8_STAGE(PG8_SA(1, 1), a1 + hstep, voffA);
            PG8_WAIT_L(8); PG8_BAR; PG8_WAIT_L(0); PG8_MMA(0, 0, At, B0); PG8_BAR; PG8_SCHED;
            PG8_LDB(B1, 0, 1); PG8_STAGE(PG8_SB(0, 0), b2, voffB);
            PG8_BAR; PG8_WAIT_L(0); PG8_MMA(0, 1, At, B1); PG8_BAR;
            PG8_LDA(At, 0, 1); PG8_STAGE(PG8_SA(0, 0), a2, voffA);
            PG8_BAR; PG8_WAIT_L(0); PG8_MMA(1, 0, At, B0); PG8_BAR; PG8_SCHED;
            PG8_STAGE(PG8_SB(0, 1), b2 + hstep, voffB);
            PG8_WAIT_V(6); PG8_BAR; PG8_MMA(1, 1, At, B1); PG8_BAR;
            PG8_LDB(B0, 1, 0); PG8_SCHED; PG8_LDA(At, 1, 0); PG8_STAGE(PG8_SA(0, 1), a2 + hstep, voffA);
            PG8_WAIT_L(8); PG8_BAR; PG8_WAIT_L(0); PG8_MMA(0, 0, At, B0); PG8_BAR; PG8_SCHED;
            PG8_LDB(B1, 1, 1); PG8_STAGE(PG8_SB(1, 0), b3, voffB);
            PG8_BAR; PG8_WAIT_L(0); PG8_MMA(0, 1, At, B1); PG8_BAR;
            PG8_LDA(At, 1, 1); PG8_STAGE(PG8_SA(1, 0), a3, voffA);
            PG8_BAR; PG8_WAIT_L(0); PG8_MMA(1, 0, At, B0); PG8_BAR; PG8_SCHED;
            PG8_STAGE(PG8_SB(1, 1), b3 + hstep, voffB);
            PG8_WAIT_V(6); PG8_BAR; PG8_MMA(1, 1, At, B1); PG8_BAR;
            }
        }
        if constexpr (ALIGN_EPI) { if (wr == 0) PG8_BAR; }
        if constexpr (FP8) asm volatile("s_nop 15\n\ts_nop 15" ::: "memory");
        if constexpr (!Epi::AFTER_DRAIN) { E(acc, cur, wr, wc, fr, fq); S.done(cur); }
        if (!has_next) break;
#pragma unroll
        for (int a = 0; a < 2; ++a)
#pragma unroll
            for (int b = 0; b < 2; ++b)
#pragma unroll
                for (int m = 0; m < 4; ++m)
#pragma unroll
                    for (int n = 0; n < 2; ++n) acc[a][b][m][n] = (f32x4){0.f, 0.f, 0.f, 0.f};
        cur = nxt; cA = nA; cB = nB; ++ui;
        if constexpr (ALIGN_EPI) { if (wr == 1) PG8_BAR; }
    }
    PG8_WAIT_V(0);
    if constexpr (!ALIGN_EPI) { if (wr == 0) PG8_BAR; }
    PG8_BAR;
    if constexpr (Epi::AFTER_DRAIN) { E.fused(acc, cur, wr, wc, fr, fq, lds, wid, lane); S.done(cur); }
#undef PG8_SA
#undef PG8_SB
#undef PG8_STAGE
#undef PG8_LDA
#undef PG8_LDB
#undef PG8_MMA
#undef PG8_LOH
#undef PG8_HIH
#undef PG8_LD2
#undef PG8_WAIT_V
#undef PG8_WAIT_L
#undef PG8_BAR
#undef PG8_SCHED
}
}


#define GAS __attribute__((address_space(1)))
#define LAS __attribute__((address_space(3)))
typedef unsigned short bf16;
typedef unsigned v4u __attribute__((ext_vector_type(4)));
typedef float f32x4 __attribute__((ext_vector_type(4)));
typedef short bf16x8 __attribute__((ext_vector_type(8)));
typedef GAS unsigned gu32;
typedef GAS unsigned long long gu64;
#define RLX_AGENT __ATOMIC_RELAXED, __HIP_MEMORY_SCOPE_AGENT
#define LDS_WAIT() asm volatile("s_waitcnt lgkmcnt(0)" ::: "memory")
#define VM_WAIT() asm volatile("s_waitcnt vmcnt(0)" ::: "memory")
__device__ __forceinline__ unsigned long long rt() { return __builtin_amdgcn_s_memrealtime(); }
__device__ __forceinline__ unsigned f2bf(float f) { unsigned u = __builtin_bit_cast(unsigned, f); return (u + 0x7fffu + ((u >> 16) & 1u)) >> 16; }
__device__ __forceinline__ unsigned pk2(float lo, float hi) { return f2bf(lo) | (f2bf(hi) << 16); }

#define XB_TMO      128
#define XB_XCNT(j)  (256  + 64 * (j))
#define XB_XSUB(j)  (1280 + 64 * (j))
#define XB_XGEN(j)  (2304 + 64 * (j))
#define XB_TOP      3328
#define XB_TOPGEN   3392
#define XCD_BAR_WORDS 3456
#define XB_SPIN_CAP (1u << 18)

__device__ __forceinline__ unsigned xb_ld(unsigned* p)              { return __hip_atomic_load(p, __ATOMIC_RELAXED, __HIP_MEMORY_SCOPE_AGENT); }
__device__ __forceinline__ unsigned xb_add(unsigned* p, unsigned v) { return __hip_atomic_fetch_add(p, v, __ATOMIC_RELAXED, __HIP_MEMORY_SCOPE_AGENT); }
__device__ __forceinline__ unsigned xb_xcc_id() { return (unsigned)__builtin_amdgcn_s_getreg((3 << 11) | 20) & 0xFu; }
#define XB_SPIN(cond, bar) do { unsigned _sp = 0; while (cond) { __builtin_amdgcn_s_sleep(1); \
    if ((++_sp & 255u) == 0u) { if (xb_ld(&(bar)[XB_TMO])) break; if (_sp > XB_SPIN_CAP) { atomicAdd(&(bar)[XB_TMO], 1u); break; } } } } while (0)

struct XcdBarrier {
    unsigned* bar; unsigned x;
    volatile LAS unsigned* st;
};

__device__ __forceinline__ XcdBarrier xcd_barrier_post(unsigned* bar, volatile LAS unsigned* st) {
    XcdBarrier b; b.bar = bar; b.x = xb_xcc_id(); b.st = st;
    if (threadIdx.x == 0) (void)xb_add(&bar[XB_XCNT(b.x)], 1u);
    return b;
}
__device__ __forceinline__ void xcd_barrier_complete(unsigned* bar, unsigned x, unsigned& nloc, unsigned& nx) {
    const unsigned G = gridDim.x * gridDim.y * gridDim.z;
    unsigned sum, cnt, mine, sp = 0u;
    for (;;) {
        sum = 0u; cnt = 0u; mine = 0u;
#pragma unroll
        for (unsigned j = 0; j < 16; ++j) { const unsigned c = xb_ld(&bar[XB_XCNT(j)]); sum += c; cnt += (c > 0u) ? 1u : 0u; mine = (j == x) ? c : mine; }
        if (sum == G) break;
        __builtin_amdgcn_s_sleep(1);
        if ((++sp & 255u) == 0u) { if (xb_ld(&bar[XB_TMO])) break; if (sp > XB_SPIN_CAP) { atomicAdd(&bar[XB_TMO], 1u); break; } }
    }
    nloc = mine > 0u ? mine : 1u; nx = cnt > 0u ? cnt : 1u;
}

__device__ __forceinline__ void xcd_barrier(const XcdBarrier& b) {
    asm volatile("s_waitcnt vmcnt(0)" ::: "memory");
    __syncthreads();
    if (threadIdx.x == 0) {
        unsigned* bar = b.bar;
        __builtin_amdgcn_s_waitcnt(0);
        unsigned nloc = b.st[0], nx = b.st[1];
        if (nloc == 0u) { xcd_barrier_complete(bar, b.x, nloc, nx); b.st[0] = nloc; b.st[1] = nx; }
        const unsigned old = xb_add(&bar[XB_XSUB(b.x)], 1u);
        const unsigned gen = old / nloc;
        if (old + 1u == (gen + 1u) * nloc) {
            __builtin_amdgcn_fence(__ATOMIC_RELEASE, "agent");
            asm volatile("s_waitcnt vmcnt(0)" ::: "memory");
            const unsigned og = xb_add(&bar[XB_TOP], 1u);
            const unsigned tg = og / nx;
            if (og + 1u == (tg + 1u) * nx) xb_add(&bar[XB_TOPGEN], 1u);
            else XB_SPIN(xb_ld(&bar[XB_TOPGEN]) == tg, bar);
            __builtin_amdgcn_fence(__ATOMIC_ACQUIRE, "agent");
            xb_add(&bar[XB_XGEN(b.x)], 1u);
            asm volatile("s_waitcnt vmcnt(0)" ::: "memory");
        } else {
            XB_SPIN(xb_ld(&bar[XB_XGEN(b.x)]) == gen, bar);
            __builtin_amdgcn_fence(__ATOMIC_ACQUIRE, "agent");
            asm volatile("s_waitcnt vmcnt(0)" ::: "memory");
        }
    }
    __syncthreads();
}


typedef unsigned u32x4v __attribute__((ext_vector_type(4)));
constexpr int NWAVES = 8, GRID_C = 256;
constexpr int NB = 8, SEQ = 4096, CTXL = 256, TOK = SEQ + CTXL, M = NB * TOK, DM = 2048, NL = 4;
constexpr int ZM_LD = 9728, ZG_LD = 6144, NIN = 15872, DFF = 5632, UP_LD = 2 * DFF, BW = 1024;
constexpr int ZA_Q = 0, ZA_FF = 1024, ZA_FB = 2048, ZA_V = 3072, ZA_G = 4096, ZB_Q = 5120, ZB_K = 6144, ZB_V = 7168, ZC_Q = 8192, ZC_K = 9216, ZC_V = 9472;
constexpr float EPS = 1e-6f, LOG2E = 1.4426950408889634f;
constexpr size_t MiB = 1u << 20;
constexpr size_t WS_CTL = 0, CTL_ZERO_BYTES = 1 * MiB;
constexpr size_t WS_MOD = 1 * MiB;
constexpr size_t WS_LB = 3 * MiB;
constexpr size_t WS_LAM = 3 * MiB + 65536;
constexpr size_t WS_ROPE = 3 * MiB + 131072;
constexpr size_t WS_W = 5 * MiB;
constexpr size_t W_IN = 0, W_BR = 62 * MiB, W_OUT = 74 * MiB, W_UP = 82 * MiB, W_DN = 126 * MiB;
constexpr size_t WS_Z = 153 * MiB;
constexpr size_t WS_ZG = WS_Z + 646 * MiB;
constexpr size_t WS_H = 1207 * MiB;
constexpr size_t WS_A = 1343 * MiB;
constexpr size_t WS_KP = WS_A + 204 * MiB;
constexpr size_t WS_H8 = WS_KP;
constexpr size_t W_G8 = (size_t)9728 * 2048 * 2;
constexpr float H8_SCALE = 16.0f, W8_SCALE = 512.0f;
constexpr size_t WS_M2 = 1717 * MiB;
constexpr size_t WS_CX = 1853 * MiB;
constexpr size_t WS_END = 1869 * MiB;
static_assert((size_t)M * ZM_LD * 2 == 646 * MiB && (size_t)M * ZG_LD * 2 == 408 * MiB && (size_t)M * DM * 2 == 136 * MiB && (size_t)3 * M * BW * 2 == 204 * MiB && (size_t)M * DFF * 2 == 374 * MiB, "ws map");
static_assert((size_t)NIN * DM * 2 == 62 * MiB && (size_t)UP_LD * DM * 2 == 44 * MiB && (size_t)DM * DFF * 2 == 22 * MiB, "w map");
constexpr int G8_LATE = 4 * (GRID_C / 2);
constexpr int CW_BAR = 4096;

constexpr int RING_BYTES = 139264;
constexpr int LDSCTL_OFF = RING_BYTES, MISC_OFF = LDSCTL_OFF + 320;
constexpr int LDS_BYTES = 147456;

struct Frame {
    LAS unsigned char* lds;
    volatile LAS unsigned* MISC;
    int tid, lane, wave, vcu, G;
};
typedef __attribute__((address_space(4))) const unsigned char kchar_t;
__device__ __forceinline__ kchar_t* kargs() { kchar_t* k = (kchar_t*)__builtin_amdgcn_kernarg_segment_ptr(); asm volatile("" : "+s"(k)); return k; }
__device__ __forceinline__ const float* inptr(int i) { return *(const float* __attribute__((address_space(4)))*)(kargs() + 8 * i); }
__device__ __forceinline__ float* outptr() { return *(float* __attribute__((address_space(4)))*)(kargs() + 176); }
__device__ __forceinline__ unsigned char* wsptr() { return *(unsigned char* __attribute__((address_space(4)))*)(kargs() + 184); }
constexpr int GRID = 256;
__device__ __forceinline__ Frame mkframe(LAS unsigned char* lds) {
    Frame F; int t = threadIdx.x; asm volatile("" : "+v"(t)); int bx = blockIdx.x; asm volatile("" : "+s"(bx));
    F.lds = lds; F.MISC = (volatile LAS unsigned*)(lds + MISC_OFF);
    F.tid = t; F.lane = t & 63; F.wave = __builtin_amdgcn_readfirstlane(t >> 6); F.G = GRID; F.vcu = (bx & 7) * (GRID / 8) + (bx >> 3);
    return F;
}
__device__ __forceinline__ float wave_sum(float v) {
#pragma unroll
    for (int o = 1; o < 64; o <<= 1) v += __shfl_xor(v, o);
    return v;
}
__device__ __forceinline__ float bf2f(unsigned short b) { return __uint_as_float(((unsigned)b) << 16); }
__device__ __forceinline__ float bflo(unsigned w) { return __uint_as_float(w << 16); }
__device__ __forceinline__ float bfhi(unsigned w) { return __uint_as_float(w & 0xffff0000u); }
__device__ __forceinline__ unsigned pkbf(float lo, float hi) { return pg8::cvt_pk_bf16(lo, hi); }
__device__ __forceinline__ unsigned pk4_fp8(float a, float b, float c, float d) { int w = __builtin_amdgcn_cvt_pk_fp8_f32(a, b, 0, false); w = __builtin_amdgcn_cvt_pk_fp8_f32(c, d, w, true); return (unsigned)w; }
__device__ __forceinline__ float silu_f(float x) { return x * __builtin_amdgcn_rcpf(1.0f + __expf(-x)); }

__device__ __forceinline__ int permc(int n) { if (n < ZC_Q || n >= ZC_V) return n; const int d = n & 127, rc = d >> 6, half = (d >> 5) & 1, i = d & 31; return (n & ~127) + 32 * (2 * rc + (i >> 4)) + 16 * half + (i & 15); }
__device__ __forceinline__ int permu(int n) { const int v = n >= DFF, r = v ? n - DFF : n; return 256 * (r >> 7) + 128 * v + (r & 127); }
__device__ __forceinline__ void transpose_item(const float* W, int K, int N, bf16* WT, LAS float* scr, int item, int lane, int pc = 0) {
    const int nblk = N / 32, kb = item / nblk, nb = item % nblk, k0 = 64 * kb, n0 = 32 * nb;
    float wv[32];
#pragma unroll
    for (int i = 0; i < 32; ++i) { const int kk = 2 * i + (lane >> 5); wv[i] = W[(size_t)(k0 + kk) * N + n0 + (lane & 31)]; }
#pragma unroll
    for (int i = 0; i < 32; ++i) { const int kk = 2 * i + (lane >> 5); scr[kk * 33 + (lane & 31)] = wv[i]; }
    LDS_WAIT(); asm volatile("" ::: "memory");
    const int c = lane & 7;
#pragma unroll
    for (int j = 0; j < 4; ++j) { const int n = (lane >> 3) + 8 * j; const LAS float* s = scr + (8 * c) * 33 + n;
        v4u o; o.x = pkbf(s[0 * 33], s[1 * 33]); o.y = pkbf(s[2 * 33], s[3 * 33]); o.z = pkbf(s[4 * 33], s[5 * 33]); o.w = pkbf(s[6 * 33], s[7 * 33]);
        *(GAS v4u*)(WT + (size_t)(pc == 1 ? permc(n0 + n) : (pc == 2 ? permu(n0 + n) : n0 + n)) * K + k0 + 8 * c) = o; }
    LDS_WAIT(); asm volatile("" ::: "memory");
}
__device__ __forceinline__ void transpose_item8(const float* W, int K, int N, unsigned char* WT, int nsub, float sc, LAS float* scr, int item, int lane) {
    const int nblk = N / 32, kb = item / nblk, nb = item % nblk, k0 = 64 * kb, n0 = 32 * nb;
    float wv[32];
#pragma unroll
    for (int i = 0; i < 32; ++i) { const int kk = 2 * i + (lane >> 5); wv[i] = W[(size_t)(k0 + kk) * N + n0 + (lane & 31)]; }
#pragma unroll
    for (int i = 0; i < 32; ++i) { const int kk = 2 * i + (lane >> 5); scr[kk * 33 + (lane & 31)] = wv[i]; }
    LDS_WAIT(); asm volatile("" ::: "memory");
#pragma unroll
    for (int i = 0; i < 2; ++i) { const int t = lane + 64 * i, n = t >> 2, ch = t & 3; const LAS float* s = scr + (16 * ch) * 33 + n;
        v4u o; o.x = pk4_fp8(s[0 * 33] * sc, s[1 * 33] * sc, s[2 * 33] * sc, s[3 * 33] * sc); o.y = pk4_fp8(s[4 * 33] * sc, s[5 * 33] * sc, s[6 * 33] * sc, s[7 * 33] * sc);
        o.z = pk4_fp8(s[8 * 33] * sc, s[9 * 33] * sc, s[10 * 33] * sc, s[11 * 33] * sc); o.w = pk4_fp8(s[12 * 33] * sc, s[13 * 33] * sc, s[14 * 33] * sc, s[15 * 33] * sc);
        *(GAS v4u*)(WT + (size_t)(n0 - nsub + n) * K + k0 + 16 * ch) = o; }
    LDS_WAIT(); asm volatile("" ::: "memory");
}
constexpr int CVT_I_IN = (DM / 64) * (NIN / 32), CVT_ALL = CVT_I_IN + 3 * (BW / 64) * (DM / 32) + (DM / 64) * (DM / 32) + (DM / 64) * (UP_LD / 32) + (DFF / 64) * (DM / 32);
__device__ __forceinline__ void convert_weights(Frame& F, int l, int lo, int hi, int gw, int NGW) {
    LAS float* scr = (LAS float*)(F.lds + F.wave * 16384);
    constexpr int I_IN = (DM / 64) * (NIN / 32), I_BR = (BW / 64) * (DM / 32), I_OUT = (DM / 64) * (DM / 32), I_UP = (DM / 64) * (UP_LD / 32), I_DN = (DFF / 64) * (DM / 32);
    constexpr int NITEMS = I_IN + 3 * I_BR + I_OUT + I_UP + I_DN; static_assert(NITEMS == CVT_ALL && I_IN == CVT_I_IN, "conversion list");
    unsigned char* wb = wsptr() + WS_W;
    for (int it = lo + gw; it < hi; it += NGW) {
        int r = it;
        if (r < I_IN) { if ((r % (NIN / 32)) * 32 < ZM_LD) transpose_item(inptr(10) + (size_t)l * DM * NIN, DM, NIN, (bf16*)(wb + W_IN), scr, r, F.lane, 1);
                        else transpose_item8(inptr(10) + (size_t)l * DM * NIN, DM, NIN, wb + W_IN + W_G8, ZM_LD, W8_SCALE, scr, r, F.lane); continue; } r -= I_IN;
        if (r < 3 * I_BR) { const int n = r / I_BR; transpose_item(inptr(16) + ((size_t)l * 3 + n) * BW * DM, BW, DM, (bf16*)(wb + W_BR) + (size_t)n * DM * BW, scr, r - n * I_BR, F.lane); continue; } r -= 3 * I_BR;
        if (r < I_OUT) { transpose_item(inptr(17) + (size_t)l * DM * DM, DM, DM, (bf16*)(wb + W_OUT), scr, r, F.lane); continue; } r -= I_OUT;
        if (r < I_UP) { transpose_item(inptr(18) + (size_t)l * DM * UP_LD, DM, UP_LD, (bf16*)(wb + W_UP), scr, r, F.lane, 2); continue; } r -= I_UP;
        transpose_item(inptr(21) + (size_t)l * DFF * DM, DFF, DM, (bf16*)(wb + W_DN), scr, r, F.lane);
    }
}
__device__ __forceinline__ void prologue_small(Frame& F) {
    LAS float* sv = (LAS float*)F.lds;
    LAS f32x4* red = (LAS f32x4*)F.lds;
    static_assert(NL * 48 <= GRID && 9 * 2048 * 4 <= RING_BYTES && 8 * 9 * 64 * 16 <= RING_BYTES, "prologue LDS");
    for (int i = F.tid; i < 9 * 2048; i += NWAVES * 64) { const int j = i >> 11, k = i & 2047; const float c = j < 8 ? inptr(1)[j * DM + k] : inptr(3)[k]; sv[i] = silu_f(c); }
    __syncthreads();
    float* mod = (float*)(wsptr() + WS_MOD);
    for (int it = F.vcu; it < NL * 48; it += F.G) {
        const int l = it / 48, cg = it - l * 48, n = cg * 256 + F.lane * 4;
        const float* W = inptr(4) + (size_t)l * DM * (6 * DM) + n;
        f32x4 a[9];
#pragma unroll
        for (int j = 0; j < 9; ++j) a[j] = (f32x4){0.f, 0.f, 0.f, 0.f};
        const int kb = F.wave * 256;
#pragma unroll 8
        for (int k = 0; k < 256; ++k) { const f32x4 w = *(const f32x4*)(W + (size_t)(kb + k) * (6 * DM));
#pragma unroll
            for (int j = 0; j < 9; ++j) a[j] += sv[j * 2048 + kb + k] * w; }
        __syncthreads();
#pragma unroll
        for (int j = 0; j < 9; ++j) red[(F.wave * 9 + j) * 64 + F.lane] = a[j];
        __syncthreads();
        for (int o = F.tid; o < 9 * 64; o += NWAVES * 64) { const int j = o >> 6, ln = o & 63; f32x4 s = (f32x4){0.f, 0.f, 0.f, 0.f};
#pragma unroll
            for (int w = 0; w < 8; ++w) s += red[(w * 9 + j) * 64 + ln];
            const int nn = cg * 256 + ln * 4; const f32x4 bb = *(const f32x4*)(inptr(5) + (size_t)l * (6 * DM) + nn);
            *(f32x4*)(mod + ((size_t)l * 9 + j) * (6 * DM) + nn) = s + bb; }
        __syncthreads();
    }
    const int gt = F.vcu * NWAVES * 64 + F.tid, NGT = F.G * NWAVES * 64;
    float* lb = (float*)(wsptr() + WS_LB);
    for (int i = gt; i < 2 * 1024; i += NGT) { const int dir = i >> 10, c = i & 1023; float lg[NL], mx = -1e30f;
#pragma unroll
        for (int l = 0; l < NL; ++l) { lg[l] = inptr(11)[((size_t)dir * NL + l) * 1024 + c]; mx = fmaxf(mx, lg[l]); }
        float s = 0.f;
#pragma unroll
        for (int l = 0; l < NL; ++l) { lg[l] = expf(lg[l] - mx); s += lg[l]; }
        float cum = 0.f;
#pragma unroll
        for (int l = 0; l < NL; ++l) { if (l > 0) cum += lg[l] / s; lb[((size_t)dir * NL + l) * 1024 + c] = cum; } }
    if (gt < NL) { const float* lv = inptr(13) + (size_t)gt * 4 * 64; float s1 = 0.f, s2 = 0.f;
        for (int i = 0; i < 64; ++i) { s1 += lv[i] * lv[64 + i]; s2 += lv[128 + i] * lv[192 + i]; }
        ((float*)(wsptr() + WS_LAM))[gt] = expf(s1) - expf(s2) + (0.8f - 0.6f * expf(-0.3f * (float)gt)); }
    float* rp = (float*)(wsptr() + WS_ROPE);
    for (int i = gt; i < 64 * 16; i += NGT) { const int pos = i >> 4, k = i & 15; const float inv = powf(10000.0f, -(float)k / 16.0f), ang = (float)pos * inv; rp[i] = cosf(ang); rp[1024 + i] = sinf(ang); }
    for (int i = gt; i < 64 * 32; i += NGT) { const int pos = i >> 5, k = i & 31; const float inv = powf(10000.0f, -(float)k / 32.0f), ang = (float)pos * inv; rp[2048 + i] = cosf(ang); rp[4096 + i] = sinf(ang); }
}
__device__ __forceinline__ const float* row_src(int b, int p, const float* lat, const float* ctx) { return p < CTXL ? ctx + (size_t)(b * CTXL + p) * DM : lat + (size_t)(b * SEQ + p - CTXL) * DM; }

__device__ __forceinline__ void prenorm_phase(Frame& F, int l, const float* xlat, const float* xctx) {
    const int gw = F.vcu * NWAVES + F.wave, NGW = F.G * NWAVES;
    const float* mod = (const float*)(wsptr() + WS_MOD) + (size_t)l * 9 * (6 * DM);
    const float* g = inptr(6) + (size_t)l * DM;
    bf16* H = (bf16*)(wsptr() + WS_H);
    for (int r = gw; r < M; r += NGW) {
        const int b = r / TOK, p = r - b * TOK; const float* xr = row_src(b, p, xlat, xctx); const float* mr = mod + (size_t)(p < CTXL ? 8 : b) * (6 * DM);
        f32x4 v[8]; float ss = 0.f;
#pragma unroll
        for (int j = 0; j < 8; ++j) { v[j] = *(const f32x4*)(xr + 4 * (64 * j + F.lane)); ss += (v[j].x * v[j].x + v[j].y * v[j].y) + (v[j].z * v[j].z + v[j].w * v[j].w); }
        const float rstd = rsqrtf(wave_sum(ss) * (1.f / DM) + EPS);
#pragma unroll
        for (int j = 0; j < 8; ++j) { const int c = 4 * (64 * j + F.lane); const f32x4 gg = *(const f32x4*)(g + c), sh = *(const f32x4*)(mr + c), sc = *(const f32x4*)(mr + DM + c);
            const f32x4 hv = (v[j] * rstd * gg) * (1.0f + sc) + sh;
            *(unsigned long long*)(H + (size_t)r * DM + c) = (unsigned long long)pkbf(hv.x, hv.y) | ((unsigned long long)pkbf(hv.z, hv.w) << 32);
            *(unsigned*)(wsptr() + WS_H8 + (size_t)r * DM + c) = pk4_fp8(hv.x * H8_SCALE, hv.y * H8_SCALE, hv.z * H8_SCALE, hv.w * H8_SCALE); }
    }
}
constexpr size_t WS_XM = WS_Z + 512 * MiB;
template <bool XF32, int MODE>
__device__ __forceinline__ void post_pre_phase(Frame& F, int l, bool wxm) {
    static_assert(M == 136 * GRID && TOK % 136 == 0, "row deal");
    constexpr bool XS32 = XF32 || MODE == 3;
    LAS f32x4* L4 = (LAS f32x4*)F.lds;
    const int b = (F.vcu * 136) / TOK;
    { const float* ml = (const float*)(wsptr() + WS_MOD) + (size_t)l * 9 * (6 * DM);
      const int ln = MODE == 0 ? l : (l + 1 < NL ? l + 1 : l);
      const float* modp = MODE == 0 ? ml + 3 * DM : (const float*)(wsptr() + WS_MOD) + (size_t)ln * 9 * (6 * DM);
      const float* gpre = MODE == 0 ? inptr(8) + (size_t)l * DM : inptr(6) + (size_t)ln * DM;
      for (int i = F.tid; i < 2 * 512; i += NWAVES * 64) { const int s = i >> 9, q = i & 511, c = q * 4; const size_t mo = (size_t)(s ? 8 : b) * (6 * DM) + c;
          if (MODE != 3) L4[s * 512 + q] = *(const f32x4*)(ml + 2 * DM + mo) * *(const f32x4*)(inptr(7) + (size_t)l * DM + c);
          if (MODE != 0) L4[(6 + s) * 512 + q] = *(const f32x4*)(ml + 5 * DM + mo) * *(const f32x4*)(inptr(9) + (size_t)l * DM + c);
          if (MODE != 3) { const f32x4 g2 = *(const f32x4*)(gpre + c), sh = *(const f32x4*)(modp + mo), sc = *(const f32x4*)(modp + mo + DM);
              L4[(2 + s) * 512 + q] = g2 * (1.0f + sc); L4[(4 + s) * 512 + q] = sh; } } }
    __syncthreads();
    const int rbase = F.vcu * 136 + F.wave;
    f32x4 xfA[8], xfB[8]; unsigned long long xbA[8], xbB[8], mA[8], mB[8], fA[8], fB[8];
#define PP_XOFF(p_) ((p_) < CTXL ? (size_t)(b * CTXL + (p_)) * DM : (size_t)(b * SEQ + (p_) - CTXL) * DM)
#define PP_LOAD(S, r) do { const int p_ = (r) - b * TOK; if (MODE != 3 || p_ >= CTXL) { \
        const float* xf_ = MODE == 3 ? (const float*)(wsptr() + WS_XM) + (size_t)(r) * DM : (p_ < CTXL ? inptr(2) : inptr(0)) + PP_XOFF(p_); \
        const bf16* xb_ = (p_ < CTXL ? (const bf16*)(wsptr() + WS_CX) : (const bf16*)outptr()) + PP_XOFF(p_); \
        const bf16* mr_ = (const bf16*)(wsptr() + WS_M2) + (size_t)(r) * DM; const bf16* fr_ = (const bf16*)(wsptr() + WS_H) + (size_t)(r) * DM; \
        _Pragma("unroll") for (int j = 0; j < 8; ++j) { const int c_ = 4 * (64 * j + F.lane); \
            if (XS32) xf##S[j] = *(const f32x4*)(xf_ + c_); else xb##S[j] = *(const unsigned long long*)(xb_ + c_); \
            if (MODE != 3) m##S[j] = *(const unsigned long long*)(mr_ + c_); \
            if (MODE != 0) f##S[j] = *(const unsigned long long*)(fr_ + c_); } } } while (0)
#define PP_UNPK(w_) (f32x4){bflo((unsigned)(w_)), bfhi((unsigned)(w_)), bflo((unsigned)((w_) >> 32)), bfhi((unsigned)((w_) >> 32))}
#define PP_SQ(v_) (((v_).x * (v_).x + (v_).y * (v_).y) + ((v_).z * (v_).z + (v_).w * (v_).w))
#define PP_PROC(S, r) do { const int p_ = (r) - b * TOK, s_ = (p_ < CTXL) ? 1 : 0; if (MODE != 3 || p_ >= CTXL) { \
        f32x4 xv_[8]; float ssm_ = 0.f, ssf_ = 0.f; \
        _Pragma("unroll") for (int j = 0; j < 8; ++j) { if (XS32) xv_[j] = xf##S[j]; else xv_[j] = PP_UNPK(xb##S[j]); \
            if (MODE != 3) { const f32x4 t_ = PP_UNPK(m##S[j]); ssm_ += PP_SQ(t_); } \
            if (MODE != 0) { const f32x4 t_ = PP_UNPK(f##S[j]); ssf_ += PP_SQ(t_); } } \
        float rsm_ = 0.f, rsf_ = 0.f; \
        if (MODE != 3) rsm_ = rsqrtf(wave_sum(ssm_) * (1.f / DM) + EPS); \
        if (MODE != 0) rsf_ = rsqrtf(wave_sum(ssf_) * (1.f / DM) + EPS); \
        float sx_ = 0.f; \
        _Pragma("unroll") for (int j = 0; j < 8; ++j) { const int q_ = 64 * j + F.lane; f32x4 xn_ = xv_[j]; \
            if (MODE != 3) { const f32x4 t_ = PP_UNPK(m##S[j]); xn_ = xn_ + L4[s_ * 512 + q_] * (t_ * rsm_); } \
            if (MODE == 0 && wxm) *(f32x4*)((float*)(wsptr() + WS_XM) + (size_t)(r) * DM + 4 * q_) = xn_; \
            if (MODE != 0) { const f32x4 t_ = PP_UNPK(f##S[j]); xn_ = xn_ + L4[(6 + s_) * 512 + q_] * (t_ * rsf_); } \
            if (MODE == 1) *(unsigned long long*)((p_ < CTXL ? (bf16*)(wsptr() + WS_CX) : (bf16*)outptr()) + PP_XOFF(p_) + 4 * q_) = (unsigned long long)pkbf(xn_.x, xn_.y) | ((unsigned long long)pkbf(xn_.z, xn_.w) << 32); \
            if (MODE == 3) *(f32x4*)(outptr() + PP_XOFF(p_) + 4 * q_) = xn_; \
            xv_[j] = xn_; sx_ += PP_SQ(xn_); } \
        if (MODE != 3) { const float rs2_ = rsqrtf(wave_sum(sx_) * (1.f / DM) + EPS); \
            _Pragma("unroll") for (int j = 0; j < 8; ++j) { const int q_ = 64 * j + F.lane; const f32x4 a2_ = L4[(2 + s_) * 512 + q_], sh_ = L4[(4 + s_) * 512 + q_]; \
                const f32x4 hv_ = (xv_[j] * rs2_) * a2_ + sh_; \
                *(unsigned long long*)((bf16*)(wsptr() + WS_H) + (size_t)(r) * DM + 4 * q_) = (unsigned long long)pkbf(hv_.x, hv_.y) | ((unsigned long long)pkbf(hv_.z, hv_.w) << 32); \
                if (MODE == 1) *(unsigned*)(wsptr() + WS_H8 + (size_t)(r) * DM + 4 * q_) = pk4_fp8(hv_.x * H8_SCALE, hv_.y * H8_SCALE, hv_.z * H8_SCALE, hv_.w * H8_SCALE); } } } } while (0)
    PP_LOAD(A, rbase);
#pragma unroll 1
    for (int i = 0; i < 17; i += 2) {
        if (i + 1 < 17) PP_LOAD(B, rbase + 8 * (i + 1));
        PP_PROC(A, rbase + 8 * i);
        if (i + 2 < 17) PP_LOAD(A, rbase + 8 * (i + 2));
        if (i + 1 < 17) PP_PROC(B, rbase + 8 * (i + 1));
    }
#undef PP_LOAD
#undef PP_PROC
#undef PP_UNPK
#undef PP_SQ
#undef PP_XOFF
    __syncthreads();
}

__device__ __forceinline__ void rope8(const u32x4v a, const u32x4v b, const float* cs, const float* sn, u32x4v& oa, u32x4v& ob) {
    const f32x4 c0 = *(const f32x4*)cs, c1 = *(const f32x4*)(cs + 4), s0 = *(const f32x4*)sn, s1 = *(const f32x4*)(sn + 4);
    const float x1[8] = {bflo(a.x), bfhi(a.x), bflo(a.y), bfhi(a.y), bflo(a.z), bfhi(a.z), bflo(a.w), bfhi(a.w)};
    const float x2[8] = {bflo(b.x), bfhi(b.x), bflo(b.y), bfhi(b.y), bflo(b.z), bfhi(b.z), bflo(b.w), bfhi(b.w)};
    const float cc[8] = {c0.x, c0.y, c0.z, c0.w, c1.x, c1.y, c1.z, c1.w}, ss[8] = {s0.x, s0.y, s0.z, s0.w, s1.x, s1.y, s1.z, s1.w};
    float o1[8], o2[8];
#pragma unroll
    for (int j = 0; j < 8; ++j) { o1[j] = x1[j] * cc[j] - x2[j] * ss[j]; o2[j] = x2[j] * cc[j] + x1[j] * ss[j]; }
    oa.x = pkbf(o1[0], o1[1]); oa.y = pkbf(o1[2], o1[3]); oa.z = pkbf(o1[4], o1[5]); oa.w = pkbf(o1[6], o1[7]);
    ob.x = pkbf(o2[0], o2[1]); ob.y = pkbf(o2[2], o2[3]); ob.z = pkbf(o2[4], o2[5]); ob.w = pkbf(o2[6], o2[7]);
}
__device__ __forceinline__ void rope_prep_phase(Frame& F) {
    const int gw = F.vcu * NWAVES + F.wave, NGW = F.G * NWAVES, t = F.lane;
    bf16* Zm = (bf16*)(wsptr() + WS_Z);
    const float* rp = (const float*)(wsptr() + WS_ROPE);
#pragma unroll 2
    for (int rl = gw; rl < NB * SEQ; rl += NGW) {
        const int b = rl >> 12, n = rl & (SEQ - 1); bf16* zr = Zm + (size_t)(b * TOK + CTXL + n) * ZM_LD;
        const bool lat = true; const int prow = n >> 6, pcol = n & 63;
        if (lat) {
            { const int hd = t >> 3, sub = t & 7, rc = sub >> 2, q8 = sub & 3, off = ZC_Q + hd * 128 + rc * 64 + q8 * 8, pos = rc ? pcol : prow;
              const float* cs = rp + 2048 + pos * 32 + q8 * 8; const float* sn = rp + 4096 + pos * 32 + q8 * 8;
              u32x4v a = *(const u32x4v*)(zr + off), bb = *(const u32x4v*)(zr + off + 32), oa, ob; rope8(a, bb, cs, sn, oa, ob);
              *(u32x4v*)(zr + off) = oa; *(u32x4v*)(zr + off + 32) = ob; }
            if (t < 16) { const int hd = t >> 3, sub = t & 7, rc = sub >> 2, q8 = sub & 3, off = ZC_K + hd * 128 + rc * 64 + q8 * 8, pos = rc ? pcol : prow;
              const float* cs = rp + 2048 + pos * 32 + q8 * 8; const float* sn = rp + 4096 + pos * 32 + q8 * 8;
              u32x4v a = *(const u32x4v*)(zr + off), bb = *(const u32x4v*)(zr + off + 32), oa, ob; rope8(a, bb, cs, sn, oa, ob);
              *(u32x4v*)(zr + off) = oa; *(u32x4v*)(zr + off + 32) = ob; }
        }
    }
}
__device__ __forceinline__ void finish_a_phase(Frame& F, int l) {
    const int gw = F.vcu * NWAVES + F.wave, NGW = F.G * NWAVES;
    const bf16* OF = (const bf16*)(wsptr() + WS_H); const bf16* OB = OF + (size_t)M * BW; const bf16* Zm = (const bf16*)(wsptr() + WS_Z); bf16* BR = (bf16*)(wsptr() + WS_A);
    const float* ng = inptr(12) + (size_t)l * 128;
#pragma unroll 2
    for (int it = gw; it < 2 * M; it += NGW) {
        const int r = it >> 1, hh = it & 1, col = (hh * 4 + (F.lane >> 4)) * 128 + (F.lane & 15) * 8, e0 = (F.lane & 15) * 8;
        const u32x4v a = *(const u32x4v*)(OF + (size_t)r * BW + col), bb = *(const u32x4v*)(OB + (size_t)r * BW + col), gz = *(const u32x4v*)(Zm + (size_t)r * ZM_LD + ZA_G + col);
        float o[8] = {bflo(a.x) + bflo(bb.x), bfhi(a.x) + bfhi(bb.x), bflo(a.y) + bflo(bb.y), bfhi(a.y) + bfhi(bb.y), bflo(a.z) + bflo(bb.z), bfhi(a.z) + bfhi(bb.z), bflo(a.w) + bflo(bb.w), bfhi(a.w) + bfhi(bb.w)};
        const float g[8] = {bflo(gz.x), bfhi(gz.x), bflo(gz.y), bfhi(gz.y), bflo(gz.z), bfhi(gz.z), bflo(gz.w), bfhi(gz.w)};
        float ss = 0.f;
#pragma unroll
        for (int j = 0; j < 8; ++j) ss += o[j] * o[j];
        ss += __shfl_xor(ss, 1); ss += __shfl_xor(ss, 2); ss += __shfl_xor(ss, 4); ss += __shfl_xor(ss, 8);
        const float rstd = rsqrtf(ss * (1.f / 128.f) + EPS);
        const f32x4 n0 = *(const f32x4*)(ng + e0), n1 = *(const f32x4*)(ng + e0 + 4); const float nn[8] = {n0.x, n0.y, n0.z, n0.w, n1.x, n1.y, n1.z, n1.w};
#pragma unroll
        for (int j = 0; j < 8; ++j) o[j] = o[j] * rstd * nn[j] * silu_f(g[j]);
        u32x4v w; w.x = pkbf(o[0], o[1]); w.y = pkbf(o[2], o[3]); w.z = pkbf(o[4], o[5]); w.w = pkbf(o[6], o[7]);
        *(u32x4v*)(BR + (size_t)r * BW + col) = w;
    }
}
__device__ __forceinline__ void unpack8(const u32x4v w, float (&f)[8]) { f[0] = bflo(w.x); f[1] = bfhi(w.x); f[2] = bflo(w.y); f[3] = bfhi(w.y); f[4] = bflo(w.z); f[5] = bfhi(w.z); f[6] = bflo(w.w); f[7] = bfhi(w.w); }
__device__ __forceinline__ void conv_act_phase(Frame& F, int l) {
    const bf16* U = (const bf16*)(wsptr() + WS_Z); bf16* ACT = (bf16*)(wsptr() + WS_A);
    const float* cw = inptr(19) + (size_t)l * 3 * UP_LD; const float* cb = inptr(20) + (size_t)l * UP_LD;
    constexpr int NCG = DFF / 8, NRS = M / 16;
    const int gt = F.vcu * NWAVES * 64 + F.tid, NGT = F.G * NWAVES * 64;
    for (int idx = gt; idx < NCG * NRS; idx += NGT) {
        const int rs = idx / NCG, cg = idx - rs * NCG, c = cg * 8, r0 = rs * 16, p0 = r0 % TOK;
        float wa[3][8], wv[3][8], ba[8], bv[8];
#pragma unroll
        for (int k = 0; k < 3; ++k)
#pragma unroll
            for (int h = 0; h < 2; ++h) { const f32x4 t0 = *(const f32x4*)(cw + (size_t)k * UP_LD + c + 4 * h), t1 = *(const f32x4*)(cw + (size_t)k * UP_LD + DFF + c + 4 * h);
                wa[k][4 * h] = t0.x; wa[k][4 * h + 1] = t0.y; wa[k][4 * h + 2] = t0.z; wa[k][4 * h + 3] = t0.w; wv[k][4 * h] = t1.x; wv[k][4 * h + 1] = t1.y; wv[k][4 * h + 2] = t1.z; wv[k][4 * h + 3] = t1.w; }
#pragma unroll
        for (int h = 0; h < 2; ++h) { const f32x4 t0 = *(const f32x4*)(cb + c + 4 * h), t1 = *(const f32x4*)(cb + DFF + c + 4 * h);
            ba[4 * h] = t0.x; ba[4 * h + 1] = t0.y; ba[4 * h + 2] = t0.z; ba[4 * h + 3] = t0.w; bv[4 * h] = t1.x; bv[4 * h + 1] = t1.y; bv[4 * h + 2] = t1.z; bv[4 * h + 3] = t1.w; }
        float pa[8], pv[8], ca[8], cv[8], na[8], nv[8];
        const u32x4v zz = {0u, 0u, 0u, 0u};
        { const bool ok = (p0 != 0) && (p0 != CTXL); const bf16* up = U + (size_t)(ok ? r0 - 1 : r0) * UP_LD + c; u32x4v x = *(const u32x4v*)up, y = *(const u32x4v*)(up + DFF); if (!ok) { x = zz; y = zz; } unpack8(x, pa); unpack8(y, pv); }
        { const bf16* up = U + (size_t)r0 * UP_LD + c; unpack8(*(const u32x4v*)up, ca); unpack8(*(const u32x4v*)(up + DFF), cv); }
#pragma unroll 4
        for (int i = 0; i < 16; ++i) {
            const int r = r0 + i, p = p0 + i; const bool ok = (p != CTXL - 1) && (p != TOK - 1);
            { const bf16* up = U + (size_t)(ok ? r + 1 : r) * UP_LD + c; u32x4v x = *(const u32x4v*)up, y = *(const u32x4v*)(up + DFF); if (!ok) { x = zz; y = zz; } unpack8(x, na); unpack8(y, nv); }
            float o[8];
#pragma unroll
            for (int j = 0; j < 8; ++j) { const float a = pa[j] * wa[0][j] + ca[j] * wa[1][j] + na[j] * wa[2][j] + ba[j], v = pv[j] * wv[0][j] + cv[j] * wv[1][j] + nv[j] * wv[2][j] + bv[j];
                o[j] = silu_f(a) * v; pa[j] = ca[j]; pv[j] = cv[j]; ca[j] = na[j]; cv[j] = nv[j]; }
            u32x4v w; w.x = pkbf(o[0], o[1]); w.y = pkbf(o[2], o[3]); w.z = pkbf(o[4], o[5]); w.w = pkbf(o[6], o[7]);
            *(u32x4v*)(ACT + (size_t)r * DFF + c) = w;
        }
    }
}

__device__ __forceinline__ void conv_fix_phase(Frame& F, int l) {
    const float* SB = (const float*)(wsptr() + WS_Z); bf16* ACT = (bf16*)(wsptr() + WS_A);
    const float* cw = inptr(19) + (size_t)l * 3 * UP_LD;
    constexpr int NE = (M / 64) * 2, NC4 = DFF / 4;
    const int gt = F.vcu * NWAVES * 64 + F.tid, NGT = F.G * NWAVES * 64;
    for (int idx = gt; idx < NE * NC4; idx += NGT) {
        const int E = idx / NC4, ch = (idx - E * NC4) * 4, gb = E >> 1, edge = E & 1, r = 64 * gb + (edge ? 63 : 0), p = r % TOK;
        const bool has = edge ? !(p == CTXL - 1 || p == TOK - 1) : !(p == 0 || p == CTXL);
        const float* sb = SB + ((size_t)E * 4) * DFF + ch;
        f32x4 a = *(const f32x4*)(sb + 2 * DFF), v = *(const f32x4*)(sb + 3 * DFF);
        if (has) { const float* nb = SB + ((size_t)(edge ? E + 1 : E - 1) * 4) * DFF + ch; const float* w = cw + (size_t)(edge ? 2 : 0) * UP_LD + ch;
            a += *(const f32x4*)w * *(const f32x4*)nb; v += *(const f32x4*)(w + DFF) * *(const f32x4*)(nb + DFF); }
        f32x4 o;
#pragma unroll
        for (int e2 = 0; e2 < 4; ++e2) o[e2] = silu_f(a[e2]) * v[e2];
        *(unsigned long long*)(ACT + (size_t)r * DFF + ch) = (unsigned long long)pkbf(o[0], o[1]) | ((unsigned long long)pkbf(o[2], o[3]) << 32);
    }
}

typedef float f32x2v __attribute__((ext_vector_type(2)));
namespace hg {
constexpr int QT = 0, KT = 17408, QH = 34816, KHT = 52224, VT = 70656, PP = 89088, ST = 98304, SEG = 133120, DEC = 137216, END = 137728;
static_assert(END <= RING_BYTES, "HGRN LDS");
constexpr int LDR = 272, LDS_ = 144;
__device__ __forceinline__ int tok_of(int dir, int i) { return dir == 0 ? i : (i < CTXL ? (CTXL - 1 - i) : (TOK + CTXL - 1 - i)); }
}
__device__ __forceinline__ void hgrn_unit(Frame& F, int l, int unit) {
    using namespace hg;
    const int b = unit >> 4, h = (unit >> 1) & 7, dir = unit & 1;
    LAS unsigned char* L = F.lds;
    const int tid = F.tid, lane = F.lane, w = F.wave, l15 = lane & 15, kq = lane >> 4;
    const int dp = lane, d0 = 2 * lane;
    const bf16* Zb = (const bf16*)(wsptr() + WS_Z) + (size_t)b * TOK * ZM_LD;
    bf16* Od = (bf16*)(wsptr() + WS_H) + (size_t)dir * M * BW + (size_t)b * TOK * BW + h * 128;
    const int cq = ZA_Q + h * 128 + d0, cf = (dir ? ZA_FB : ZA_FF) + h * 128 + d0;
    const int vs = tid >> 3, ve16 = (tid & 7) * 16, cv = ZA_V + h * 128 + ve16;
    for (int i = tid; i < 128 * LDR / 4; i += NWAVES * 64) ((LAS unsigned*)(L + ST))[i] = 0u;
    f32x4 S[8];
#pragma unroll
    for (int j = 0; j < 8; ++j) S[j] = (f32x4){0.f, 0.f, 0.f, 0.f};
    unsigned zq[8], zf[8]; u32x4v vv, vw;
#define HG_LOAD(c) do { _Pragma("unroll") for (int i_ = 0; i_ < 8; ++i_) { const bf16* rp_ = Zb + (size_t)tok_of(dir, 64 * (c) + 8 * w + i_) * ZM_LD; zq[i_] = *(const unsigned*)(rp_ + cq); zf[i_] = *(const unsigned*)(rp_ + cf); } \
        { const bf16* vp_ = Zb + (size_t)tok_of(dir, 64 * (c) + vs) * ZM_LD + cv; vv = *(const u32x4v*)vp_; vw = *(const u32x4v*)(vp_ + 8); } } while (0)
    float pl0[8], pl1[8], qv0[8], qv1[8], kv0[8], kv1[8];
#define HG_GATES() do { float prod0 = 1.0f, prod1 = 1.0f; \
        _Pragma("unroll") for (int i = 0; i < 8; ++i) { const float f0 = bflo(zf[i]), f1 = bfhi(zf[i]); \
            prod0 *= f0; pl0[i] = prod0; kv0[i] = 1.0f - f0; qv0[i] = bflo(zq[i]); \
            prod1 *= f1; pl1[i] = prod1; kv1[i] = 1.0f - f1; qv1[i] = bfhi(zq[i]); } \
        *(LAS f32x2v*)(L + SEG + (w * 128 + d0) * 4) = (f32x2v){prod0, prod1}; } while (0)
    HG_LOAD(0);
    HG_GATES();
    __syncthreads();
    for (int c = 0; c < TOK / 64; ++c) {
        { const unsigned ww[8] = {vv.x, vv.y, vv.z, vv.w, vw.x, vw.y, vw.z, vw.w};
#pragma unroll
          for (int j = 0; j < 8; ++j) { *(LAS unsigned short*)(L + VT + (ve16 + 2 * j) * LDS_ + vs * 2) = (unsigned short)(ww[j] & 0xffffu); *(LAS unsigned short*)(L + VT + (ve16 + 2 * j + 1) * LDS_ + vs * 2) = (unsigned short)(ww[j] >> 16); } }
        if (c + 1 < TOK / 64) HG_LOAD(c + 1);
        { f32x2v sgp[8];
#pragma unroll
          for (int j = 0; j < 8; ++j) sgp[j] = *(const LAS f32x2v*)(L + SEG + (j * 128 + d0) * 4);
          const f32x2v cmid = (sgp[0] * sgp[1]) * (sgp[2] * sgp[3]), cend = (sgp[4] * sgp[5]) * (sgp[6] * sgp[7]);
          f32x2v fac = (f32x2v){1.0f, 1.0f};
          if (w < 4) {
#pragma unroll
              for (int j = 0; j < 4; ++j) if (j >= w) fac = fac * sgp[j];
              fac = (f32x2v){__builtin_amdgcn_rcpf(fac.x), __builtin_amdgcn_rcpf(fac.y)}; }
          else {
#pragma unroll
              for (int j = 4; j < 8; ++j) if (j < w) fac = fac * sgp[j]; }
          if (w == 0) *(LAS f32x2v*)(L + DEC + d0 * 4) = cmid * cend;
          float kf0[8], kf1[8];
#pragma unroll
          for (int i = 0; i < 8; ++i) { const int t = 8 * w + i;
              const float e0 = pl0[i] * fac.x, e1 = pl1[i] * fac.y, r0 = __builtin_amdgcn_rcpf(e0), r1 = __builtin_amdgcn_rcpf(e1);
              const float qt0 = qv0[i] * e0, qt1 = qv1[i] * e1, kt0 = kv0[i] * r0, kt1 = kv1[i] * r1;
              *(LAS unsigned*)(L + QT + t * LDR + d0 * 2) = pkbf(qt0, qt1);
              *(LAS unsigned*)(L + QH + t * LDR + d0 * 2) = pkbf(qt0 * cmid.x, qt1 * cmid.y);
              *(LAS unsigned*)(L + KT + t * LDR + d0 * 2) = pkbf(kt0, kt1);
              kf0[i] = kt0 * cend.x; kf1[i] = kt1 * cend.y; }
          const unsigned kh0[4] = {pkbf(kf0[0], kf0[1]), pkbf(kf0[2], kf0[3]), pkbf(kf0[4], kf0[5]), pkbf(kf0[6], kf0[7])}, kh1[4] = {pkbf(kf1[0], kf1[1]), pkbf(kf1[2], kf1[3]), pkbf(kf1[4], kf1[5]), pkbf(kf1[6], kf1[7])};
          *(LAS u32x4v*)(L + KHT + d0 * LDS_ + w * 16) = (u32x4v){kh0[0], kh0[1], kh0[2], kh0[3]}; *(LAS u32x4v*)(L + KHT + (d0 + 1) * LDS_ + w * 16) = (u32x4v){kh1[0], kh1[1], kh1[2], kh1[3]}; }
        __syncthreads();
        { const int st = w & 3, tt0 = (w >> 2) * 2; bf16x8 a[4];
#pragma unroll
          for (int k = 0; k < 4; ++k) a[k] = *(const LAS bf16x8*)(L + KT + (st * 16 + l15) * LDR + (k * 32 + kq * 8) * 2);
#pragma unroll
          for (int u = 0; u < 2; ++u) { const int tt = tt0 + u; f32x4 acc = (f32x4){0.f, 0.f, 0.f, 0.f};
#pragma unroll
              for (int k = 0; k < 4; ++k) { const bf16x8 bq = *(const LAS bf16x8*)(L + QT + (tt * 16 + l15) * LDR + (k * 32 + kq * 8) * 2); acc = __builtin_amdgcn_mfma_f32_16x16x32_bf16(a[k], bq, acc, 0, 0, 0); }
              const int tabs = tt * 16 + l15, s0 = st * 16 + 4 * kq;
              const float p0 = (s0 + 0 <= tabs) ? acc[0] : 0.f, p1 = (s0 + 1 <= tabs) ? acc[1] : 0.f, p2 = (s0 + 2 <= tabs) ? acc[2] : 0.f, p3 = (s0 + 3 <= tabs) ? acc[3] : 0.f;
              *(LAS unsigned long long*)(L + PP + tabs * LDS_ + s0 * 2) = (unsigned long long)pkbf(p0, p1) | ((unsigned long long)pkbf(p2, p3) << 32); } }
        __syncthreads();
        { const int tt0 = (w & 1) * 2, et0 = (w >> 1) * 2;
          bf16x8 bp[2][2], bqh[2][4];
#pragma unroll
          for (int v = 0; v < 2; ++v) {
#pragma unroll
            for (int k = 0; k < 2; ++k) bp[v][k] = *(const LAS bf16x8*)(L + PP + ((tt0 + v) * 16 + l15) * LDS_ + (k * 32 + kq * 8) * 2);
#pragma unroll
            for (int k = 0; k < 4; ++k) bqh[v][k] = *(const LAS bf16x8*)(L + QH + ((tt0 + v) * 16 + l15) * LDR + (k * 32 + kq * 8) * 2); }
          bf16* orow0 = Od + (size_t)tok_of(dir, 64 * c + tt0 * 16 + l15) * BW; bf16* orow1 = Od + (size_t)tok_of(dir, 64 * c + (tt0 + 1) * 16 + l15) * BW;
#pragma unroll
          for (int u = 0; u < 2; ++u) { const int et = et0 + u; bf16x8 av[2], as[4];
#pragma unroll
              for (int k = 0; k < 2; ++k) av[k] = *(const LAS bf16x8*)(L + VT + (et * 16 + l15) * LDS_ + (k * 32 + kq * 8) * 2);
#pragma unroll
              for (int k = 0; k < 4; ++k) as[k] = *(const LAS bf16x8*)(L + ST + (et * 16 + l15) * LDR + (k * 32 + kq * 8) * 2);
#pragma unroll
              for (int v = 0; v < 2; ++v) { f32x4 acc = (f32x4){0.f, 0.f, 0.f, 0.f};
#pragma unroll
                  for (int k = 0; k < 2; ++k) acc = __builtin_amdgcn_mfma_f32_16x16x32_bf16(av[k], bp[v][k], acc, 0, 0, 0);
#pragma unroll
                  for (int k = 0; k < 4; ++k) acc = __builtin_amdgcn_mfma_f32_16x16x32_bf16(as[k], bqh[v][k], acc, 0, 0, 0);
                  *(unsigned long long*)((v ? orow1 : orow0) + et * 16 + 4 * kq) = (unsigned long long)pkbf(acc[0], acc[1]) | ((unsigned long long)pkbf(acc[2], acc[3]) << 32); } } }
        __syncthreads();
        if (c + 1 < TOK / 64) HG_GATES();
        { const int dt0 = (w >> 1) * 2, eq0 = (w & 1) * 4;
          bf16x8 ak[2][2], bv[4][2]; f32x4 dcv[2];
#pragma unroll
          for (int dt = 0; dt < 2; ++dt) { dcv[dt] = *(const LAS f32x4*)(L + DEC + (16 * (dt0 + dt) + 4 * kq) * 4);
#pragma unroll
              for (int k = 0; k < 2; ++k) ak[dt][k] = *(const LAS bf16x8*)(L + KHT + (16 * (dt0 + dt) + l15) * LDS_ + (k * 32 + kq * 8) * 2); }
#pragma unroll
          for (int et = 0; et < 4; ++et)
#pragma unroll
              for (int k = 0; k < 2; ++k) bv[et][k] = *(const LAS bf16x8*)(L + VT + ((eq0 + et) * 16 + l15) * LDS_ + (k * 32 + kq * 8) * 2);
#pragma unroll
          for (int dt = 0; dt < 2; ++dt)
#pragma unroll
              for (int et = 0; et < 4; ++et) { f32x4 acc = S[4 * dt + et] * dcv[dt];
#pragma unroll
                  for (int k = 0; k < 2; ++k) acc = __builtin_amdgcn_mfma_f32_16x16x32_bf16(ak[dt][k], bv[et][k], acc, 0, 0, 0);
                  S[4 * dt + et] = acc;
                  *(LAS unsigned long long*)(L + ST + ((eq0 + et) * 16 + l15) * LDR + (16 * (dt0 + dt) + 4 * kq) * 2) = (unsigned long long)pkbf(acc[0], acc[1]) | ((unsigned long long)pkbf(acc[2], acc[3]) << 32); } }
        __syncthreads();
    }
#undef HG_LOAD
#undef HG_GATES
}

namespace att {
using s16x4  = __attribute__((ext_vector_type(4))) short;
using f32x16 = __attribute__((ext_vector_type(16))) float;
typedef LAS char lchar;
constexpr int SHM_V = 64 * 128 * 2, SHM_K = 64 * 128 * 2, SHM_ATTN = 2 * SHM_V + 2 * SHM_K + NWAVES * 64 * 4  , STASH_OFF = SHM_ATTN, STASH_BYTES = 32 * 512 * 4;
static_assert(STASH_OFF + STASH_BYTES <= RING_BYTES, "attention LDS");
#define KSWZ(row, colB) ((row) * 256 + ((colB) ^ (((row) & 7) << 4)))
#define SBAR() __builtin_amdgcn_sched_barrier(0)
__device__ __forceinline__ int crow(int r, int hi) { return (r & 3) + 8 * (r >> 2) + 4 * hi; }
__device__ __forceinline__ unsigned cvtpk(float lo, float hi) { return pg8::cvt_pk_bf16(lo, hi); }
__device__ __forceinline__ void partialSM(f32x16& p0, f32x16& p1, float& m_reg, float& mn, float& alpha, float C, float thr) {
  float pmax = p0[0];
#pragma unroll
  for (int r = 1; r < 16; ++r) pmax = fmaxf(pmax, p0[r]);
#pragma unroll
  for (int r = 0; r < 16; ++r) pmax = fmaxf(pmax, p1[r]);
  { auto rr = __builtin_amdgcn_permlane32_swap(__float_as_uint(pmax), __float_as_uint(pmax), false, false);
    pmax = fmaxf(__uint_as_float(rr[0]), __uint_as_float(rr[1])); }
  if (__builtin_expect(__all(pmax - m_reg <= thr), 1)) { mn = m_reg; alpha = 1.f; }
  else { mn = fmaxf(m_reg, pmax); alpha = __builtin_amdgcn_exp2f((m_reg - mn) * C); m_reg = mn; }
  float mnC = -mn * C;
#pragma unroll
  for (int r = 0; r < 16; ++r) p0[r] = fmaf(p0[r], C, mnC);
#pragma unroll
  for (int r = 0; r < 16; ++r) p1[r] = fmaf(p1[r], C, mnC);
#pragma unroll
  for (int r = 0; r < 16; ++r) p0[r] = __builtin_amdgcn_exp2f(p0[r]);
}
__device__ __forceinline__ void finishSM(f32x16& p0, f32x16& p1, float alpha, float& l_reg, bf16x8& pa0, bf16x8& pa1, bf16x8& pa2, bf16x8& pa3) {
#pragma unroll
  for (int r = 0; r < 16; ++r) p1[r] = __builtin_amdgcn_exp2f(p1[r]);
  float ps = 0;
#pragma unroll
  for (int r = 0; r < 16; ++r) ps += p0[r];
#pragma unroll
  for (int r = 0; r < 16; ++r) ps += p1[r];
  { auto rr = __builtin_amdgcn_permlane32_swap(__float_as_uint(ps), __float_as_uint(ps), false, false);
    ps = __uint_as_float(rr[0]) + __uint_as_float(rr[1]); }
  l_reg = l_reg * alpha + ps;
#define PK4(P, BASE, OUT) do { unsigned a0 = cvtpk(P[BASE + 0], P[BASE + 1]), a1 = cvtpk(P[BASE + 2], P[BASE + 3]);   \
    unsigned b0 = cvtpk(P[BASE + 4], P[BASE + 5]), b1 = cvtpk(P[BASE + 6], P[BASE + 7]);                              \
    auto r0 = __builtin_amdgcn_permlane32_swap(a0, b0, false, false); auto r1 = __builtin_amdgcn_permlane32_swap(a1, b1, false, false); \
    u32x4v w = {r0[0], r1[0], r0[1], r1[1]}; OUT = *reinterpret_cast<bf16x8*>(&w); } while (0)
  PK4(p0, 0, pa0); PK4(p0, 8, pa1); PK4(p1, 0, pa2); PK4(p1, 8, pa3);
#undef PK4
}
template <int ND0>
__device__ __forceinline__ void qkt(f32x16& p0, f32x16& p1, const lchar* Ks, const bf16x8* qr, int r32, int hi, int colx) {
  p0 = f32x16{}; p1 = f32x16{};
  int A = ND0 == 4 ? r32 * 128 + ((hi * 16) ^ ((r32 & 7) << 4)) : (r32 * 256 + ((hi * 16) ^ ((r32 & 7) << 4))) ^ colx; asm volatile("" : "+v"(A));
#pragma unroll
  for (int d0 = 0; d0 < ND0; ++d0) { const int off = A ^ (d0 * 32);
    bf16x8 b0 = *reinterpret_cast<const LAS bf16x8*>(Ks + off);
    bf16x8 b1 = *reinterpret_cast<const LAS bf16x8*>(Ks + off + (ND0 == 4 ? 4096 : 8192));
    p0 = __builtin_amdgcn_mfma_f32_32x32x16_bf16(b0, qr[d0], p0, 0, 0, 0);
    p1 = __builtin_amdgcn_mfma_f32_32x32x16_bf16(b1, qr[d0], p1, 0, 0, 0); }
}
__device__ __forceinline__ void mask_tile(f32x16& p0, f32x16& p1, int kp0, int qp, int hi) {
  const int dlt = kp0 - qp;
#pragma unroll
  for (int r = 0; r < 16; ++r) { const int k0 = dlt + crow(r, hi), k1 = k0 + 32;
    p0[r] = (k0 < -128 || k0 > 128) ? -1e30f : p0[r]; p1[r] = (k1 < -128 || k1 > 128) ? -1e30f : p1[r]; }
}
__device__ __forceinline__ int v_st(int k, int c) { const int kk = (k & ~0xC) | ((k & 4) << 1) | ((k & 8) >> 1); return ((kk >> 3) * 4 + (c >> 5)) * 512 + ((kk & 7) * 32 + (c & 31)) * 2; }
__device__ __forceinline__ int v_rd_base(int lane) { return ((lane & 3) << 3) | (((lane >> 2) & 3) << 6) | (((lane >> 4) & 1) << 5) | (((lane >> 5) & 1) << 8); }
constexpr int v_rd_off(int d0, int ks, int half) { return d0 * 512 + ks * 4096 + half * 2048; }
template <int OFF> __device__ __forceinline__ s16x4 tr_read(int vb) {
  s16x4 r; asm volatile("ds_read_b64_tr_b16 %0, %1 offset:%2" : "=&v"(r) : "v"(vb), "i"(OFF) : "memory"); return r;
}
template <int D0> __device__ __forceinline__ void pv_one(f32x16& od, int vb, bf16x8 pa0, bf16x8 pa1, bf16x8 pa2, bf16x8 pa3) {
  const s16x4 l0 = tr_read<v_rd_off(D0, 0, 0)>(vb), h0 = tr_read<v_rd_off(D0, 0, 1)>(vb), l1 = tr_read<v_rd_off(D0, 1, 0)>(vb), h1 = tr_read<v_rd_off(D0, 1, 1)>(vb);
  const s16x4 l2 = tr_read<v_rd_off(D0, 2, 0)>(vb), h2 = tr_read<v_rd_off(D0, 2, 1)>(vb), l3 = tr_read<v_rd_off(D0, 3, 0)>(vb), h3 = tr_read<v_rd_off(D0, 3, 1)>(vb);
  asm volatile("s_waitcnt lgkmcnt(0)" ::: "memory"); SBAR();
#define PK(L, H) (bf16x8){L[0], L[1], L[2], L[3], H[0], H[1], H[2], H[3]}
  od = __builtin_amdgcn_mfma_f32_32x32x16_bf16(pa0, PK(l0, h0), od, 0, 0, 0);
  od = __builtin_amdgcn_mfma_f32_32x32x16_bf16(pa1, PK(l1, h1), od, 0, 0, 0);
  od = __builtin_amdgcn_mfma_f32_32x32x16_bf16(pa2, PK(l2, h2), od, 0, 0, 0);
  od = __builtin_amdgcn_mfma_f32_32x32x16_bf16(pa3, PK(l3, h3), od, 0, 0, 0);
#undef PK
}
__device__ __forceinline__ void pv_d0(f32x16* o, int vb, bf16x8 pa0, bf16x8 pa1, bf16x8 pa2, bf16x8 pa3) {
  pv_one<0>(o[0], vb, pa0, pa1, pa2, pa3); pv_one<1>(o[1], vb, pa0, pa1, pa2, pa3); pv_one<2>(o[2], vb, pa0, pa1, pa2, pa3); pv_one<3>(o[3], vb, pa0, pa1, pa2, pa3);
}
template <int TYPE>
__device__ __forceinline__ void attn_run(const bf16* __restrict__ Qb, const bf16* __restrict__ Kh, const bf16* __restrict__ Vh,
                                         int NT, int gap, int qp, int bs, int comp, lchar* lds, f32x16 (&o)[4], float& m_reg, float& l_reg) {
  constexpr int ldq = ZM_LD, ldv = ZM_LD, ldk = ZM_LD, ND0 = TYPE == 0 ? 4 : 8, SD = TYPE == 0 ? 2 : 1; constexpr bool mask = TYPE == 1;
  constexpr float C = (TYPE == 0 ? 0.125f : 0.08838834764831845f) * LOG2E, thr = 8.0f * LOG2E / C;
  int tid = threadIdx.x; asm volatile("" : "+v"(tid));
  const int wid = tid >> 6, lane = tid & 63, r32 = lane & 31, hi = lane >> 5;
  lchar* V_lds = lds; lchar* K_lds = lds + 2 * SHM_V;
  LAS float* wsf = (LAS float*)(lds + 2 * SHM_V + 2 * SHM_K) + wid * 64; LAS float* al_l = wsf + 32;
  m_reg = -1e30f; l_reg = 0.f;
#pragma unroll
  for (int d = 0; d < 4; ++d) o[d] = f32x16{};
  bf16x8 qr[ND0];
  const unsigned qro = (unsigned)((wid * 32 + r32) * ldq + hi * 8) * 2u + (unsigned)(comp * 128);
#pragma unroll
  for (int d0 = 0; d0 < ND0; ++d0) qr[d0] = *reinterpret_cast<const bf16x8*>((const char*)Qb + qro + d0 * 32);
  const int colx = comp * 128;
  const int sr = tid >> 4, sc = (tid & 15) * 8, vst0 = v_st(sr, sc);
  const int kr = tid >> 3, kc = tid & 7;
  const int kst0 = TYPE == 0 ? kr * 128 + ((kc * 16) ^ ((kr & 7) << 4)) : KSWZ(sr, sc * 2);
  const int vb0 = (int)(unsigned)(uintptr_t)V_lds + v_rd_base(lane);
  const unsigned vro = (unsigned)(sr * ldv + sc) * 2u, kro = TYPE == 0 ? (unsigned)(kr * ldk + comp * 64 + kc * 8) * 2u : (unsigned)(sr * ldk + sc) * 2u;
  bf16x8 vsA0, vsA1, ksA0, ksA1, vsB0, vsB1, ksB0, ksB1;
#define KOFF(j) (64 * (j) + ((j) >= 4 ? gap : 0))
#define SLOAD(S, j) do { const size_t k0_ = (size_t)KOFF(j); const char* vb_ = (const char*)Vh + k0_ * (size_t)(ldv * 2); const char* kb_ = (const char*)Kh + k0_ * (size_t)(ldk * 2); \
    vs##S##0 = *reinterpret_cast<const bf16x8*>(vb_ + vro); vs##S##1 = *reinterpret_cast<const bf16x8*>(vb_ + (size_t)(32 * ldv * 2) + vro); \
    ks##S##0 = *reinterpret_cast<const bf16x8*>(kb_ + kro); if (TYPE == 1) ks##S##1 = *reinterpret_cast<const bf16x8*>(kb_ + (size_t)(32 * ldk * 2) + kro); } while (0)
#define SWRITE(b, S) do { *(LAS bf16x8*)(V_lds + (b) * SHM_V + vst0) = vs##S##0; *(LAS bf16x8*)(V_lds + (b) * SHM_V + vst0 + 8192) = vs##S##1; \
    *(LAS bf16x8*)(K_lds + (b) * SHM_K + kst0) = ks##S##0; if (TYPE == 1) *(LAS bf16x8*)(K_lds + (b) * SHM_K + kst0 + 8192) = ks##S##1; } while (0)
#define SWAIT() do { if constexpr (SD == 2) asm volatile("s_waitcnt vmcnt(3)" ::: "memory");   else asm volatile("s_waitcnt vmcnt(0)" ::: "memory"); } while (0)
#define RESC(a) do { if (__any((a) < 1.f)) { if (hi == 0) al_l[r32] = (a); asm volatile("s_waitcnt lgkmcnt(0)" ::: "memory"); \
    _Pragma("unroll") for (int d = 0; d < 4; ++d) _Pragma("unroll") for (int r = 0; r < 16; ++r) o[d][r] *= al_l[crow(r, hi)]; } } while (0)
#define MASKT(P0, P1, j) do { if (mask && (j) >= 4) mask_tile(P0, P1, bs + 64 * ((j) - 4), qp, hi); } while (0)
  f32x16 pA0, pA1, pB0, pB1; float mnA, mnB, alA, alB; bf16x8 pa0, pa1, pa2, pa3;
  SLOAD(A, 0); asm volatile("s_waitcnt vmcnt(0)" ::: "memory"); SWRITE(0, A); __syncthreads();
  qkt<ND0>(pA0, pA1, K_lds, qr, r32, hi, colx); partialSM(pA0, pA1, m_reg, mnA, alA, C, thr);
  if constexpr (SD == 2) { SLOAD(B, 1); if (2 < NT) SLOAD(A, 2); SWAIT(); SWRITE(1, B); } else { SLOAD(A, 1); SWAIT(); SWRITE(1, A); }
  __syncthreads();
  for (int j = 1; j + 1 < NT; j += 2) {
    SBAR(); qkt<ND0>(pB0, pB1, K_lds + SHM_K, qr, r32, hi, colx); MASKT(pB0, pB1, j);
    finishSM(pA0, pA1, alA, l_reg, pa0, pa1, pa2, pa3); SBAR();
    if constexpr (SD == 2) { SLOAD(B, j + 2); } else { SLOAD(A, j + 1); } SBAR();
    pv_d0(o, vb0, pa0, pa1, pa2, pa3); partialSM(pB0, pB1, m_reg, mnB, alB, C, thr);
    __syncthreads(); SWAIT(); SWRITE(0, A);
    RESC(alB); __syncthreads();
    SBAR(); qkt<ND0>(pA0, pA1, K_lds, qr, r32, hi, colx); MASKT(pA0, pA1, j + 1);
    finishSM(pB0, pB1, alB, l_reg, pa0, pa1, pa2, pa3); SBAR();
    if constexpr (SD == 2) { if (j + 3 < NT) SLOAD(A, j + 3); } else { SLOAD(A, j + 2); } SBAR();
    pv_d0(o, vb0 + SHM_V, pa0, pa1, pa2, pa3); partialSM(pA0, pA1, m_reg, mnA, alA, C, thr);
    __syncthreads(); SWAIT(); if constexpr (SD == 2) { SWRITE(1, B); } else { SWRITE(1, A); }
    RESC(alA); __syncthreads();
  }
  SBAR(); qkt<ND0>(pB0, pB1, K_lds + SHM_K, qr, r32, hi, colx); MASKT(pB0, pB1, NT - 1);
  finishSM(pA0, pA1, alA, l_reg, pa0, pa1, pa2, pa3); SBAR();
  pv_d0(o, vb0, pa0, pa1, pa2, pa3); partialSM(pB0, pB1, m_reg, mnB, alB, C, thr);
  __syncthreads(); RESC(alB);
  finishSM(pB0, pB1, alB, l_reg, pa0, pa1, pa2, pa3); SBAR();
  pv_d0(o, vb0 + SHM_V, pa0, pa1, pa2, pa3);
  (void)mnA; (void)mnB; (void)vsB0; (void)vsB1; (void)ksB0; (void)ksB1;
#undef KOFF
#undef SLOAD
#undef SWRITE
#undef SWAIT
#undef RESC
#undef MASKT
}
}

template <int TYPE>
__device__ __forceinline__ void attn_unit(Frame& F, int l, int bh, int qb) {
  using namespace att;
  lchar* lds = (lchar*)F.lds;
  const int tid = F.tid, wid = tid >> 6, lane = tid & 63, r32 = lane & 31, hi = lane >> 5;
  LAS float* li_l = (LAS float*)(lds + 2 * SHM_V + 2 * SHM_K) + wid * 64;
  LAS unsigned* stash = (LAS unsigned*)(lds + STASH_OFF);
  const int b = bh >> 3, hd = bh & 7;
  const size_t row0 = (size_t)b * TOK, rowq = row0 + (qb < 0 ? 0 : CTXL + 256 * qb);
  constexpr float C = (TYPE == 0 ? 0.125f : 0.08838834764831845f) * LOG2E;
#pragma unroll 1
  for (int pass = 0; pass < (TYPE == 0 ? 2 : 1); ++pass) {
    const bf16* Zm = (const bf16*)(wsptr() + WS_Z);
    const bf16 *Q, *K, *V; int NT, gap = 0, bs = 0;
    if (TYPE == 0) { Q = Zm + rowq * ZM_LD + ZB_Q + hd * 128; K = Zm + row0 * ZM_LD + ZB_K + hd * 128; V = Zm + row0 * ZM_LD + ZB_V + hd * 128; NT = qb < 0 ? 4 : TOK / 64; }
    else { const int g = hd >> 2; Q = Zm + rowq * ZM_LD + ZC_Q + hd * 128; K = Zm + row0 * ZM_LD + ZC_K + g * 128; V = Zm + row0 * ZM_LD + ZC_V + g * 128;
      if (qb < 0) NT = 4; else { bs = 256 * qb - 128; if (bs < 0) bs = 0; int be = 256 * qb + 384; if (be > SEQ) be = SEQ; NT = 4 + (be - bs) / 64; gap = bs; } }
    const int qp = 256 * qb + wid * 32 + r32;
    f32x16 o[4]; float m_reg, l_reg;
    attn_run<TYPE>(Q, K, V, NT, gap, qp, bs, TYPE == 0 ? pass : 0, lds, o, m_reg, l_reg);
    if (TYPE == 1) { const float sk = inptr(15)[l * 8 + hd]; l_reg += __builtin_amdgcn_exp2f(sk * LOG2E - m_reg * C); }
    if (hi == 0) li_l[r32] = l_reg;
    asm volatile("s_waitcnt lgkmcnt(0)" ::: "memory");
#pragma unroll
    for (int r = 0; r < 16; ++r) { const float rl = __builtin_amdgcn_rcpf(li_l[crow(r, hi)]);
#pragma unroll
      for (int d0 = 0; d0 < 4; ++d0) o[d0][r] *= rl; }
    if (TYPE == 0 && pass == 0) {
#pragma unroll
      for (int d0 = 0; d0 < 4; ++d0)
#pragma unroll
        for (int r = 0; r < 16; r += 2) stash[(d0 * 8 + (r >> 1)) * 512 + tid] = cvtpk(o[d0][r], o[d0][r + 1]);
    } else {
      __syncthreads();
      lchar* SG = lds + wid * 8192;
      if (TYPE == 0) { const float lam = ((const float*)(wsptr() + WS_LAM))[l];
#pragma unroll
        for (int d0 = 0; d0 < 4; ++d0)
#pragma unroll
          for (int r = 0; r < 16; r += 2) { const unsigned w = stash[(d0 * 8 + (r >> 1)) * 512 + tid]; o[d0][r] = bflo(w) - lam * o[d0][r]; o[d0][r + 1] = bfhi(w) - lam * o[d0][r + 1]; } }
#pragma unroll
      for (int r = 0; r < 16; ++r)
#pragma unroll
        for (int d0 = 0; d0 < 4; ++d0) *(LAS unsigned short*)(SG + crow(r, hi) * 256 + (d0 * 32 + r32) * 2) = (unsigned short)(cvtpk(o[d0][r], o[d0][r]) & 0xffffu);
      asm volatile("s_waitcnt lgkmcnt(0)" ::: "memory");
      const int cc = lane & 15;
      bf16* Ow = (bf16*)(wsptr() + WS_A) + (size_t)(TYPE == 0 ? 1 : 2) * M * BW + (rowq + wid * 32 + (lane >> 4)) * BW + hd * 128 + cc * 8;
      float gsc[8];
      if (TYPE == 0) { const float linit = 0.8f - 0.6f * __expf(-0.3f * (float)l); const float* sg = inptr(14) + (size_t)l * 128 + cc * 8;
#pragma unroll
        for (int j = 0; j < 8; ++j) gsc[j] = sg[j] * (1.0f - linit); }
#pragma unroll
      for (int i = 0; i < 8; ++i) {
        u32x4v v = *(const LAS u32x4v*)(SG + ((lane >> 4) + 4 * i) * 256 + cc * 16);
        if (TYPE == 0) { float f[8]; unpack8(v, f); float ss = 0.f;
#pragma unroll
          for (int j = 0; j < 8; ++j) ss += f[j] * f[j];
          ss += __shfl_xor(ss, 1); ss += __shfl_xor(ss, 2); ss += __shfl_xor(ss, 4); ss += __shfl_xor(ss, 8);
          const float rs = rsqrtf(ss * (1.f / 128.f) + EPS);
#pragma unroll
          for (int j = 0; j < 8; ++j) f[j] *= rs * gsc[j];
          v.x = cvtpk(f[0], f[1]); v.y = cvtpk(f[2], f[3]); v.z = cvtpk(f[4], f[5]); v.w = cvtpk(f[6], f[7]); }
        *(u32x4v*)(Ow + (size_t)(4 * i) * BW) = v;
      }
    }
    __syncthreads();
  }
}
__device__ __forceinline__ void attn_units(Frame& F, int l) {
  const int odd = F.vcu & 1, j = F.vcu >> 1;
#pragma unroll 1
  for (int k = 0; k < 5; ++k) {
    int bh, qb;
    if (k < 4) { const int U = k * 256 + F.vcu; bh = U >> 4; qb = U & 15; } else { if (!odd || j >= 64 || l == NL - 1) break; bh = j; qb = -1; }
#ifndef NO_AT0
    attn_unit<0>(F, l, bh, qb);
#endif
  }
  if (odd) {
#pragma unroll 1
    for (int k = 0; k < 9; ++k) {
      int bh, qb;
      if (k < 8) { const int U = k * 128 + j; bh = U >> 4; qb = U & 15; } else { if (j < 64 || l == NL - 1) break; bh = j - 64; qb = -1; }
#ifndef NO_AT1
      attn_unit<1>(F, l, bh, qb);
#endif
    }
  }
}

struct Args { const float* in[22]; float* out; unsigned char* ws; };
__global__ void __launch_bounds__(NWAVES * 64, 2) mk_fwd(Args args) {
    extern __shared__ __attribute__((aligned(16))) unsigned char lds[];
    LAS unsigned char* const ldsb = (LAS unsigned char*)lds;
    for (int u = threadIdx.x; u < (LDS_BYTES - LDSCTL_OFF) / 4; u += NWAVES * 64) ((LAS unsigned*)(ldsb + LDSCTL_OFF))[u] = 0u;
    __syncthreads();
    (void)xcd_barrier_post((unsigned*)(wsptr() + WS_CTL) + CW_BAR, (volatile LAS unsigned*)(ldsb + MISC_OFF) + 8);
#define GRID_BAR() do { XcdBarrier b_; b_.bar = (unsigned*)(wsptr() + WS_CTL) + CW_BAR; b_.x = xb_xcc_id(); b_.st = (volatile LAS unsigned*)(ldsb + MISC_OFF) + 8; xcd_barrier(b_); } while (0)
#define FRAME() Frame F = mkframe(ldsb)
#if PROBE_CLASS
#define PH_END(cls) do { if (threadIdx.x == 0) { volatile LAS unsigned long long* tw_ = (volatile LAS unsigned long long*)(ldsb + MISC_OFF + 64); const unsigned long long now_ = wall_clock64(); \
        if ((cls) == PROBE_CLASS || (PROBE_CLASS == 1 && (cls) >= 8 && (cls) <= 12) || (PROBE_CLASS == 40 && ((cls) == 3 || (cls) == 4 || (cls) == 7))) tw_[1] += now_ - tw_[0]; tw_[0] = now_; } } while (0)
#else
#define PH_END(cls) do { } while (0)
#endif
#define H    ((bf16*)(wsptr() + WS_H))
#define Zm   ((bf16*)(wsptr() + WS_Z))
#define Zg   ((bf16*)(wsptr() + WS_ZG))
#define BR   ((bf16*)(wsptr() + WS_A))
#define M2   ((bf16*)(wsptr() + WS_M2))
#define CX   ((float*)(wsptr() + WS_CX))
#define MIX  ((float*)(wsptr() + WS_Z))
#define UP   ((bf16*)(wsptr() + WS_Z))
#define ACT  ((bf16*)(wsptr() + WS_A))
#define mod  ((const float*)(wsptr() + WS_MOD))
#define WinT ((bf16*)(wsptr() + WS_W + W_IN))
#define WbT  ((bf16*)(wsptr() + WS_W + W_BR))
#define WoT  ((bf16*)(wsptr() + WS_W + W_OUT))
#define WupT ((bf16*)(wsptr() + WS_W + W_UP))
#define WdT  ((bf16*)(wsptr() + WS_W + W_DN))

#if PROBE_CLASS
    if (threadIdx.x == 0) { volatile LAS unsigned long long* tw_ = (volatile LAS unsigned long long*)(ldsb + MISC_OFF + 64); tw_[0] = wall_clock64(); tw_[1] = 0ull; }
#endif
    #ifndef NO_PRO
    { FRAME(); prologue_small(F); __syncthreads(); convert_weights(F, 0, 0, CVT_ALL, F.vcu * NWAVES + F.wave, GRID * NWAVES); }
#endif
    GRID_BAR();
    PH_END(7);
#ifndef NO_NORM
    { FRAME(); prenorm_phase(F, 0, inptr(0), inptr(2)); }
#endif
    GRID_BAR();
    PH_END(7);

    for (int l = 0; l < NL; ++l) {
#if !DBG_NO_MIX
#ifndef NO_G0
#if PROBE_CLASS == 20
        if (threadIdx.x == 0) { volatile LAS unsigned long long* tw_ = (volatile LAS unsigned long long*)(ldsb + MISC_OFF + 64); tw_[2] = clock64(); tw_[3] = wall_clock64(); }
#endif
        { FRAME(); pg8::Gemm g{H, WinT, M, ZM_LD, DM, 0, 0}; pg8::StaticOrder S; S.init(M, ZM_LD, F.G, (int)blockIdx.x);
          pg8::EpiZ E{Zm, Zg, (const float*)(wsptr() + WS_ROPE), (const float*)(wsptr() + WS_LB) + (size_t)l * 1024};
          pg8::gemm_phase<pg8::EpiZ, pg8::StaticOrder, true, true>(F.lds, g, S, E); }
        { FRAME(); pg8::Gemm g{(const bf16*)(wsptr() + WS_H8), (const bf16*)(wsptr() + WS_W + W_IN + W_G8), M, ZG_LD, DM / 2, 0, 0}; pg8::SubOrder S; S.base.init(M, ZG_LD, F.G, GRID - 1 - (int)blockIdx.x); S.lo = 0; S.hi = (M / 256) * (ZG_LD / 256) - G8_LATE;
          pg8::EpiG E{Zg, 1.0f / (H8_SCALE * W8_SCALE)};
          pg8::gemm_phase<pg8::EpiG, pg8::SubOrder, true, true, true>(F.lds, g, S, E); }
#endif
        GRID_BAR();
        PH_END(8);
#if PROBE_CLASS == 20
        if (threadIdx.x == 0) { volatile LAS unsigned long long* tw_ = (volatile LAS unsigned long long*)(ldsb + MISC_OFF + 64); const unsigned long long dc_ = clock64() - tw_[2], dw_ = wall_clock64() - tw_[3];
            if (l == 1) tw_[1] = (dc_ * 100ull / dw_) * 100ull; }
#endif
#if !DBG_NO_HGRN
        { FRAME(); if ((F.vcu & 1) == 0) { hgrn_unit(F, l, F.vcu >> 1); __syncthreads(); } }
        if (((int)blockIdx.x >> 3) & 1)
        { FRAME(); pg8::Gemm g{(const bf16*)(wsptr() + WS_H8), (const bf16*)(wsptr() + WS_W + W_IN + W_G8), M, ZG_LD, DM / 2, 0, 0}; pg8::SubOrder S; S.base.init(M, ZG_LD, F.G / 2, F.vcu >> 1); S.hi = (M / 256) * (ZG_LD / 256); S.lo = S.hi - G8_LATE;
          pg8::EpiG E{Zg, 1.0f / (H8_SCALE * W8_SCALE)};
          pg8::gemm_phase<pg8::EpiG, pg8::SubOrder, true, true, true>(F.lds, g, S, E); }
#else
        { FRAME(); const int gt = F.vcu * 512 + F.tid; u32x4v* p = (u32x4v*)(wsptr() + WS_H); for (size_t i = gt; i < (size_t)M * DM * 2 / 16; i += 256 * 512) p[i] = (u32x4v){0u, 0u, 0u, 0u}; }
#endif
#if !DBG_NO_ATTN
        { FRAME(); attn_units(F, l); }
#else
        { FRAME(); const int gt = F.vcu * 512 + F.tid; u32x4v* p = (u32x4v*)(wsptr() + WS_A + (size_t)M * BW * 2); for (size_t i = gt; i < (size_t)2 * M * BW * 2 / 16; i += 256 * 512) p[i] = (u32x4v){0u, 0u, 0u, 0u}; }
#endif
        GRID_BAR();
        PH_END(2);
#ifndef NO_FINA
        { FRAME(); finish_a_phase(F, l); }
#endif
        GRID_BAR();
        PH_END(4);
#ifndef NO_G1
        { FRAME(); pg8::Gemm g{BR, WbT, M, DM, BW, (size_t)M * BW * 2, (size_t)DM * BW * 2}; pg8::MergeOrder S; S.base.init(DM, l == NL - 1, F.G, (int)blockIdx.x);
          pg8::EpiMerge E{Zg, H};
          pg8::gemm_phase<pg8::EpiMerge, pg8::MergeOrder, true, true>(F.lds, g, S, E); }
#endif
        GRID_BAR();
        PH_END(9);
#ifndef NO_G2
        { FRAME(); pg8::Gemm g{H, WoT, M, DM, DM, 0, 0}; pg8::RowOrder S; S.init(DM, l == NL - 1, F.G, (int)blockIdx.x);
          pg8::EpiBf16<0> E{M2, DM, nullptr, 0, 0, 1.f};
          pg8::gemm_phase<pg8::EpiBf16<0>, pg8::RowOrder, true, true>(F.lds, g, S, E); }
#endif
        GRID_BAR();
        PH_END(10);
#endif
        { FRAME(); if (l == 0) post_pre_phase<true, 0>(F, l, false); else post_pre_phase<false, 0>(F, l, l == NL - 1); }
        GRID_BAR();
        PH_END(5);
#ifndef NO_G3
        { FRAME(); pg8::Gemm g{H, WupT, M, UP_LD, DM, 0, 0}; pg8::RowOrder S; S.init(UP_LD, l == NL - 1, F.G, (int)blockIdx.x);
          pg8::EpiConv E{ACT, (float*)(wsptr() + WS_Z), inptr(19) + (size_t)l * 3 * UP_LD, inptr(20) + (size_t)l * UP_LD};
          pg8::gemm_phase<pg8::EpiConv, pg8::RowOrder, true, true>(F.lds, g, S, E); }
#endif
        GRID_BAR();
        PH_END(11);
#ifndef NO_CONV
        { FRAME(); conv_fix_phase(F, l); }
#endif
        GRID_BAR();
        PH_END(6);
#ifndef NO_G4
        { FRAME(); pg8::Gemm g{ACT, WdT, M, DM, DFF, 0, 0}; pg8::RowOrder S; S.init(DM, l == NL - 1, F.G, (int)blockIdx.x);
          pg8::EpiBf16<0> E{H, DM, nullptr, 0, 0, 1.f};
          pg8::gemm_phase<pg8::EpiBf16<0>, pg8::RowOrder, true, true>(F.lds, g, S, E); }
#endif
        GRID_BAR();
        PH_END(12);
        { FRAME(); if (l == 0) post_pre_phase<true, 1>(F, l, false); else if (l + 1 < NL) post_pre_phase<false, 1>(F, l, false); else post_pre_phase<false, 3>(F, l, false);
          if (l + 1 < NL) { __syncthreads(); convert_weights(F, l + 1, 0, CVT_ALL, F.vcu * NWAVES + F.wave, GRID * NWAVES); } }
        GRID_BAR();
        PH_END(5);
    }
#if PROBE_CLASS
    if (blockIdx.x == 0 && threadIdx.x == 0) { volatile LAS unsigned long long* tw_ = (volatile LAS unsigned long long*)(ldsb + MISC_OFF + 64); const unsigned long long t0_ = wall_clock64(), d_ = tw_[1];
        while (wall_clock64() - t0_ < d_) __builtin_amdgcn_s_sleep(8); }
#endif
#undef GRID_BAR
#undef FRAME
#undef H
#undef Zm
#undef Zg
#undef BR
#undef M2
#undef CX
#undef MIX
#undef UP
#undef ACT
#undef mod
#undef WinT
#undef WbT
#undef WoT
#undef WupT
#undef WdT
}

extern "C" void kernel_launch(void* const* d_in, const int* in_sizes, int n_in, void* d_out, int out_size, void* d_ws, size_t ws_size, hipStream_t stream) {
    static int grid = 0;
    if (grid == 0) {
        if (n_in != 22 || in_sizes[0] != NB * SEQ * DM || out_size != NB * SEQ * DM || ws_size < WS_END) {
            fprintf(stderr, "kernel_launch: shape mismatch: n_in %d in0 %d out %d ws %zu (need %zu); nothing launched\n", n_in, n_in > 0 ? in_sizes[0] : -1, out_size, ws_size, (size_t)WS_END); grid = -1; return; }
        int dev = 0, cus = 0;
        if (hipGetDevice(&dev) != hipSuccess || hipDeviceGetAttribute(&cus, hipDeviceAttributeMultiprocessorCount, dev) != hipSuccess) { fprintf(stderr, "kernel_launch: device query failed\n"); grid = -1; return; }
        if (hipFuncSetAttribute((const void*)mk_fwd, hipFuncAttributeMaxDynamicSharedMemorySize, LDS_BYTES) != hipSuccess) { fprintf(stderr, "kernel_launch: hipFuncSetAttribute failed\n"); grid = -1; return; }
        int per_cu = 0;
        if (hipOccupancyMaxActiveBlocksPerMultiprocessor(&per_cu, (const void*)mk_fwd, NWAVES * 64, LDS_BYTES) != hipSuccess || per_cu < 1)
            fprintf(stderr, "kernel_launch: note: occupancy query reports %d workgroups per CU\n", per_cu);
        (void)hipGetLastError();
        if (cus < 256) { fprintf(stderr, "kernel_launch: needs 256 CUs (one resident workgroup each), device has %d; nothing launched\n", cus); grid = -1; return; }
        grid = 256;
    }
    if (grid < 0) return;
    if (hipMemsetAsync((char*)d_ws + WS_CTL, 0, CTL_ZERO_BYTES, stream) != hipSuccess) { fprintf(stderr, "kernel_launch: memset failed\n"); return; }
    Args a{};
    for (int i = 0; i < 22; ++i) a.in[i] = (const float*)d_in[i];
    a.out = (float*)d_out; a.ws = (unsigned char*)d_ws;
    hipLaunchKernelGGL(mk_fwd, dim3(grid), dim3(NWAVES * 64), LDS_BYTES, stream, a);
    const hipError_t le = hipPeekAtLastError();
    if (le != hipSuccess) fprintf(stderr, "kernel_launch: launch failed: %s\n", hipGetErrorName(le));
}
```
